# Optimizing an MI355X kernel written in HIP

```python
import math
import jax, jax.numpy as jnp
from jax import lax
import numpy as np

D_MODEL = 1024
BATCH = 4
SEQ = 8192
DEPTH = 2

MLA_HEADS = 8
MLA_NOPE = 64
MLA_ROPE = 32
MLA_QK = MLA_NOPE + MLA_ROPE
MLA_V = 64
MLA_Q_RANK = 384
MLA_KV_RANK = 256
ROPE_BASE = 10000.0
Q_BLOCK = 128

GLA_HEADS = 4
GLA_DK = 64
GLA_DV = 128
GLA_GATE_RANK = 16
GLA_TAU = 16.0
GLA_CHUNK = 64

S5_CH = 512
S5_GROUP = 16
S5_GROUPS = S5_CH // S5_GROUP
S5_STATE = 64
S5_DT_MIN = 0.001
S5_DT_MAX = 0.1

N_BRANCH = 3
BRANCH_W = 512
D_FF = 4 * D_MODEL
EPS = 1e-6

IN_SIZES = (MLA_Q_RANK, MLA_KV_RANK, MLA_ROPE,
            GLA_HEADS * GLA_DK, GLA_HEADS * GLA_DK, GLA_HEADS * GLA_DV, GLA_GATE_RANK, GLA_HEADS * GLA_DV,
            S5_CH,
            N_BRANCH * D_MODEL)
D_IN = sum(IN_SIZES)

kernel_name = 'hybrid_mla_gla_s5_gated_block'


def rms_norm(x, g):
    xf = x.astype(jnp.float32)
    y = xf * lax.rsqrt(jnp.mean(xf * xf, axis=-1, keepdims=True) + EPS)
    return (y * g.astype(jnp.float32)).astype(x.dtype)


def rope(x, cos, sin):
    x1, x2 = jnp.split(x, 2, axis=-1)
    return jnp.concatenate([x1 * cos - x2 * sin, x1 * sin + x2 * cos], axis=-1)


def split_in(z):
    idx = []
    acc = 0
    for s in IN_SIZES[:-1]:
        acc += s
        idx.append(acc)
    return jnp.split(z, idx, axis=-1)


def mla_mixer(h_cq, h_ckv, k_pe, q_norm_g, w_uq, kv_norm_g, w_ukv, q_head_g, k_head_g, cos, sin):
    B, L, _ = h_cq.shape
    dt = h_cq.dtype
    q = (rms_norm(h_cq, q_norm_g) @ w_uq).reshape(B, L, MLA_HEADS, MLA_QK)
    kv = (rms_norm(h_ckv, kv_norm_g) @ w_ukv).reshape(B, L, MLA_HEADS, MLA_NOPE + MLA_V)
    k_nope, v = kv[..., :MLA_NOPE], kv[..., MLA_NOPE:]
    k = jnp.concatenate([k_nope, jnp.broadcast_to(k_pe[:, :, None, :], (B, L, MLA_HEADS, MLA_ROPE))], axis=-1)
    q = rms_norm(q, q_head_g)
    k = rms_norm(k, k_head_g)
    c4, s4 = cos[:, None, :].astype(dt), sin[:, None, :].astype(dt)
    q = jnp.concatenate([q[..., :MLA_NOPE], rope(q[..., MLA_NOPE:], c4, s4)], axis=-1)
    k = jnp.concatenate([k[..., :MLA_NOPE], rope(k[..., MLA_NOPE:], c4, s4)], axis=-1)
    q = q.transpose(0, 2, 1, 3)
    k = k.transpose(0, 2, 1, 3)
    v = v.transpose(0, 2, 1, 3)
    n_blk = L // Q_BLOCK
    qb = q.reshape(B, MLA_HEADS, n_blk, Q_BLOCK, MLA_QK).transpose(2, 0, 1, 3, 4)
    key_pos = jnp.arange(L)
    scale = MLA_QK ** -0.5

    def attend(args):
        qi, blk = args
        s = jnp.einsum('bhqd,bhkd->bhqk', qi, k).astype(jnp.float32) * scale
        q_pos = blk * Q_BLOCK + jnp.arange(Q_BLOCK)
        mask = key_pos[None, :] <= q_pos[:, None]
        s = jnp.where(mask, s, jnp.finfo(jnp.float32).min)
        p = jax.nn.softmax(s, axis=-1)
        return jnp.einsum('bhqk,bhkd->bhqd', p.astype(v.dtype), v)

    o = lax.map(attend, (qb, jnp.arange(n_blk)))
    return o.transpose(1, 0, 3, 2, 4).reshape(B, L, MLA_HEADS * MLA_V)


def gla_mixer(q, k, v, g_lr, r, w_gate, b_gate, out_g):
    B, L, _ = q.shape
    dt = q.dtype
    n_ch = L // GLA_CHUNK
    f32 = jnp.float32

    def chunks(t, d):
        return t.astype(f32).reshape(B, n_ch, GLA_CHUNK, GLA_HEADS, d).transpose(0, 3, 1, 2, 4)

    log_a = jax.nn.log_sigmoid(g_lr.astype(f32) @ w_gate.astype(f32) + b_gate.astype(f32)) / GLA_TAU
    qc = chunks(q, GLA_DK) * (GLA_DK ** -0.5)
    kc = chunks(k, GLA_DK)
    vc = chunks(v, GLA_DV)
    bc = jnp.cumsum(chunks(log_a, GLA_DK), axis=3)
    b_last = bc[..., -1:, :]
    q_t = qc * jnp.exp(bc)
    k_t = kc * jnp.exp(-bc)
    k_end = kc * jnp.exp(b_last - bc)
    causal = jnp.tril(jnp.ones((GLA_CHUNK, GLA_CHUNK), dtype=bool))
    a_intra = jnp.where(causal, jnp.einsum('bhncd,bhnsd->bhncs', q_t, k_t), 0.0)
    o_intra = jnp.einsum('bhncs,bhnse->bhnce', a_intra, vc)
    d_state = jnp.einsum('bhncd,bhnce->bhnde', k_end, vc)
    decay = jnp.exp(b_last[..., 0, :])

    def step(S, inp):
        dS_n, dec_n = inp
        return dec_n[..., None] * S + dS_n, S

    S0 = jnp.zeros((B, GLA_HEADS, GLA_DK, GLA_DV), f32)
    _, S_prev = lax.scan(step, S0, (jnp.moveaxis(d_state, 2, 0), jnp.moveaxis(decay, 2, 0)))
    S_prev = jnp.moveaxis(S_prev, 0, 2)
    o = o_intra + jnp.einsum('bhncd,bhnde->bhnce', q_t, S_prev)
    o = o.transpose(0, 2, 3, 1, 4).reshape(B, L, GLA_HEADS, GLA_DV)
    o = rms_norm(o, out_g) * jax.nn.silu(r.astype(f32)).reshape(B, L, GLA_HEADS, GLA_DV)
    return o.reshape(B, L, GLA_HEADS * GLA_DV).astype(dt)


def diag_combine(e1, e2):
    a1, b1 = e1
    a2, b2 = e2
    return a1 * a2, a2 * b1 + b2


def s5_mixer(u, lam_re, lam_im, b_re, b_im, c_re, c_im, d, log_dt, w_glu, b_glu):
    B, L, _ = u.shape
    f32 = jnp.float32
    uf = u.astype(f32).reshape(B, L, S5_GROUPS, S5_GROUP)
    lam = lax.complex(jnp.minimum(lam_re.astype(f32), -1e-4), lam_im.astype(f32))
    step = jnp.exp(log_dt.astype(f32))[:, None]
    lam_bar = jnp.exp(lam * step)
    b_bar = ((lam_bar - 1.0) / lam)[..., None] * lax.complex(b_re.astype(f32), b_im.astype(f32))
    bu = lax.complex(jnp.einsum('blgi,gpi->blgp', uf, jnp.real(b_bar)),
                     jnp.einsum('blgi,gpi->blgp', uf, jnp.imag(b_bar)))
    a = jnp.broadcast_to(lam_bar, bu.shape)
    _, states = lax.associative_scan(diag_combine, (a, bu), axis=1)
    y = (jnp.einsum('blgp,gip->blgi', jnp.real(states), c_re.astype(f32))
         - jnp.einsum('blgp,gip->blgi', jnp.imag(states), c_im.astype(f32))
         + d.astype(f32) * uf)
    y = jax.nn.gelu(y.reshape(B, L, S5_CH))
    y = y * jax.nn.sigmoid(y @ w_glu.astype(f32) + b_glu.astype(f32))
    return y.astype(u.dtype)


def setup_inputs(seed: int = 0) -> dict:
    key = jax.random.key(seed)
    ks = iter(jax.random.split(key, 40))
    f32 = jnp.float32

    def nrm(shape, scale):
        return jax.random.normal(next(ks), shape, f32) * scale

    def gain(shape):
        return 1.0 + 0.02 * jax.random.normal(next(ks), shape, f32)

    n_idx = jnp.arange(S5_STATE, dtype=f32)
    return {
        'x': nrm((BATCH, SEQ, D_MODEL), 1.0),
        'norm1_g': gain((DEPTH, D_MODEL)),
        'w_in': nrm((DEPTH, D_MODEL, D_IN), D_MODEL ** -0.5),
        'mla_q_norm_g': gain((DEPTH, MLA_Q_RANK)),
        'mla_w_uq': nrm((DEPTH, MLA_Q_RANK, MLA_HEADS * MLA_QK), MLA_Q_RANK ** -0.5),
        'mla_kv_norm_g': gain((DEPTH, MLA_KV_RANK)),
        'mla_w_ukv': nrm((DEPTH, MLA_KV_RANK, MLA_HEADS * (MLA_NOPE + MLA_V)), MLA_KV_RANK ** -0.5),
        'mla_q_head_g': gain((DEPTH, MLA_QK)),
        'mla_k_head_g': gain((DEPTH, MLA_QK)),
        'gla_w_gate': nrm((DEPTH, GLA_GATE_RANK, GLA_HEADS * GLA_DK), GLA_GATE_RANK ** -0.5),
        'gla_b_gate': nrm((DEPTH, GLA_HEADS * GLA_DK), 0.1),
        'gla_out_g': gain((DEPTH, GLA_DV)),
        's5_lam_re': -0.5 + nrm((DEPTH, S5_GROUPS, S5_STATE), 0.01),
        's5_lam_im': jnp.pi * n_idx + nrm((DEPTH, S5_GROUPS, S5_STATE), 0.01),
        's5_b_re': nrm((DEPTH, S5_GROUPS, S5_STATE, S5_GROUP), (2 * S5_GROUP) ** -0.5),
        's5_b_im': nrm((DEPTH, S5_GROUPS, S5_STATE, S5_GROUP), (2 * S5_GROUP) ** -0.5),
        's5_c_re': nrm((DEPTH, S5_GROUPS, S5_GROUP, S5_STATE), S5_STATE ** -0.5),
        's5_c_im': nrm((DEPTH, S5_GROUPS, S5_GROUP, S5_STATE), S5_STATE ** -0.5),
        's5_d': nrm((DEPTH, S5_GROUPS, S5_GROUP), 1.0),
        's5_log_dt': jax.random.uniform(next(ks), (DEPTH, S5_GROUPS), f32,
                                        minval=math.log(S5_DT_MIN), maxval=math.log(S5_DT_MAX)),
        's5_w_glu': nrm((DEPTH, S5_CH, S5_CH), S5_CH ** -0.5),
        's5_b_glu': nrm((DEPTH, S5_CH), 0.01),
        'w_br_mla': nrm((DEPTH, BRANCH_W, D_MODEL), BRANCH_W ** -0.5),
        'w_br_gla': nrm((DEPTH, BRANCH_W, D_MODEL), BRANCH_W ** -0.5),
        'w_br_s5': nrm((DEPTH, BRANCH_W, D_MODEL), BRANCH_W ** -0.5),
        'gate_b': nrm((DEPTH, N_BRANCH * D_MODEL), 0.01),
        'w_out': nrm((DEPTH, D_MODEL, D_MODEL), D_MODEL ** -0.5),
        'norm2_g': gain((DEPTH, D_MODEL)),
        'w_ff1': nrm((DEPTH, D_MODEL, D_FF), D_MODEL ** -0.5),
        'w_ff2': nrm((DEPTH, D_FF, D_MODEL), D_FF ** -0.5),
    }


def reference(x, norm1_g, w_in, mla_q_norm_g, mla_w_uq, mla_kv_norm_g, mla_w_ukv, mla_q_head_g,
              mla_k_head_g, gla_w_gate, gla_b_gate, gla_out_g, s5_lam_re, s5_lam_im, s5_b_re, s5_b_im,
              s5_c_re, s5_c_im, s5_d, s5_log_dt, s5_w_glu, s5_b_glu, w_br_mla, w_br_gla, w_br_s5, gate_b,
              w_out, norm2_g, w_ff1, w_ff2):
    B, L, D = x.shape
    pos = jnp.arange(L, dtype=jnp.float32)
    inv_freq = ROPE_BASE ** (-jnp.arange(0, MLA_ROPE, 2, dtype=jnp.float32) / MLA_ROPE)
    ang = pos[:, None] * inv_freq[None, :]
    cos, sin = jnp.cos(ang), jnp.sin(ang)
    for l in range(DEPTH):
        h = rms_norm(x, norm1_g[l])
        z = h @ w_in[l]
        (cq, ckv, kpe, gq, gk, gv, glr, gr, su, gates) = split_in(z)
        kpe = rope(kpe, cos.astype(kpe.dtype), sin.astype(kpe.dtype)) * 1.0 if False else kpe
        o_a = mla_mixer(cq, ckv, kpe, mla_q_norm_g[l], mla_w_uq[l], mla_kv_norm_g[l], mla_w_ukv[l],
                        mla_q_head_g[l], mla_k_head_g[l], cos, sin)
        o_b = gla_mixer(gq, gk, gv, glr, gr, gla_w_gate[l], gla_b_gate[l], gla_out_g[l])
        o_c = s5_mixer(su, s5_lam_re[l], s5_lam_im[l], s5_b_re[l], s5_b_im[l], s5_c_re[l], s5_c_im[l],
                       s5_d[l], s5_log_dt[l], s5_w_glu[l], s5_b_glu[l])
        g = jax.nn.sigmoid(gates + gate_b[l]).reshape(B, L, N_BRANCH, D)
        merged = (g[:, :, 0] * (o_a @ w_br_mla[l])
                  + g[:, :, 1] * (o_b @ w_br_gla[l])
                  + g[:, :, 2] * (o_c @ w_br_s5[l]))
        x = x + merged @ w_out[l]
        h2 = rms_norm(x, norm2_g[l])
        x = x + jnp.square(jax.nn.relu(h2 @ w_ff1[l])) @ w_ff2[l]
    return x
```

```cpp
#include <hip/hip_runtime.h>
#include <hip/hip_cooperative_groups.h>
#include <cstdio>
#include <cstdint>
namespace cg = cooperative_groups;

#define DI __device__ __forceinline__
typedef unsigned short bf16_t;
typedef short bf16x8 __attribute__((ext_vector_type(8)));
typedef short s16x4 __attribute__((ext_vector_type(4)));
typedef float f32x4 __attribute__((ext_vector_type(4)));
typedef float f32x16 __attribute__((ext_vector_type(16)));

constexpr int T_ = 32768, L_ = 8192, D_ = 1024, DIN = 5808, DFF = 4096;
constexpr int ZLD = 2736;
constexpr int C_CQ = 0, C_CKV = 384, C_KPE = 640, C_GQ = 672, C_GK = 928, C_GV = 1184, C_GLR = 1696, C_GR = 1712, C_SU = 2224;
constexpr float EPS = 1e-6f;
constexpr int NTHR = 512;
constexpr int LDS_BYTES = 147456;
constexpr int LDS_UNIT_OFF = LDS_BYTES - 16;

constexpr size_t OFF_Z = 0;
constexpr size_t OFF_QRAW = 179306496;
constexpr size_t OFF_KVRAW = OFF_QRAW + 50331648;
constexpr size_t OFF_KPE2 = OFF_KVRAW + 67108864;
constexpr size_t OFF_EOA = OFF_KPE2 + 16777216;
constexpr size_t OFF_H = OFF_EOA + 33554432;
constexpr size_t OFF_GS = OFF_H + 67108864;
constexpr size_t OFF_UA = OFF_GS + 33554432;
constexpr size_t OFF_W = OFF_UA + 50331648;
constexpr size_t W_IN = 0, W_UQ = W_IN + (size_t)DIN * 1024, W_UKV = W_UQ + 768 * 384, W_GLU = W_UKV + 1024 * 256,
                 W_BR = W_GLU + 512 * 512, W_OUT = W_BR + 3 * 1024 * 512, W_END = W_OUT + 1024 * 1024;
constexpr size_t OFF_MATS = OFF_W + ((W_END * 2 + 255) / 256) * 256;
constexpr size_t OFF_MY = OFF_MATS + 32 * 256 * 256 * 2;
constexpr size_t OFF_ROPE = OFF_MY + 32 * 256 * 384 * 2;
constexpr size_t OFF_GDEC = OFF_ROPE + 2 * 8192 * 16 * 4;
constexpr size_t OFF_CTL = OFF_GDEC + 2048 * 64 * 4;
constexpr size_t WS_END = OFF_CTL + 4096;
constexpr size_t OFF_FFH = OFF_Z;
constexpr size_t OFF_MERGED = OFF_QRAW;
constexpr size_t OFF_SCR = OFF_GS;
constexpr size_t OFF_WFF1 = OFF_UA, OFF_WFF2 = OFF_UA + (size_t)4096 * 1024 * 2;
static_assert(WS_END <= 536870912ull, "workspace");
static_assert((size_t)T_ * 4096 * 2 <= OFF_KPE2, "ffh overlay");

struct Params { const float* in[30]; float* out; unsigned char* ws; int ph_lo, ph_hi; };

struct Ctx {
  const Params& P;
  const float* const* in; float* out; unsigned char* ws;
  int layer;
  DI const float* inp(int i, size_t per_layer) const { return P.in[i] + (size_t)layer * per_layer; }
};

DI bf16_t f2bf(float x) { unsigned u = __float_as_uint(x); u += 0x7fffu + ((u >> 16) & 1u); return (bf16_t)(u >> 16); }
DI float bf2f(bf16_t b) { return __uint_as_float(((unsigned)b) << 16); }
DI unsigned pack2(float lo, float hi) { return (unsigned)f2bf(lo) | ((unsigned)f2bf(hi) << 16); }
DI float wave_sum(float v) {
#pragma unroll
  for (int o = 32; o; o >>= 1) v += __shfl_xor(v, o);
  return v;
}
DI float sigmoidf_(float x) { return 1.f / (1.f + __expf(-x)); }
DI void store4bf(bf16_t* p, const f32x4& v) { uint2 w; w.x = pack2(v[0], v[1]); w.y = pack2(v[2], v[3]); *(uint2*)p = w; }
DI f32x4 load4bf(const bf16_t* p) { uint2 w = *(const uint2*)p; f32x4 v; v[0] = __uint_as_float(w.x << 16); v[1] = __uint_as_float(w.x & 0xffff0000u); v[2] = __uint_as_float(w.y << 16); v[3] = __uint_as_float(w.y & 0xffff0000u); return v; }

constexpr int BK = 64, HALF = 128, HT = HALF * BK;
DI int lds_byte(int r, int c) { int st = (r >> 4) * 2 + (c >> 5), rr = r & 15, cc = c & 31, ob = rr * 64 + cc * 2; return st * 1024 + (ob ^ (((ob >> 9) & 1) << 5)); }
DI void stage_rc(int b, int& R, int& C) { int st = b / 1024, sb = b % 1024, swz = sb ^ (((sb >> 9) & 1) << 5); R = (st >> 1) * 16 + swz / 64; C = (st & 1) * 32 + (swz % 64) / 2; }

#define FOR_ACC(...) \
  _Pragma("unroll") for (int ai = 0; ai < 2; ++ai) _Pragma("unroll") for (int m = 0; m < 4; ++m) { const int row = brow + ai * 128 + wr * 64 + m * 16 + fr; \
  _Pragma("unroll") for (int bj = 0; bj < 2; ++bj) _Pragma("unroll") for (int n = 0; n < 2; ++n) { const int col = bcol + bj * 128 + wc * 32 + n * 16 + fq * 4; const f32x4 v = acc[ai][bj][m][n]; __VA_ARGS__ } asm volatile("" ::: "memory"); }

template <int lda, int ldb, int K, class Epi>
DI void gemm_tile(const bf16_t* __restrict__ A, const bf16_t* __restrict__ Bt, int brow, int bcol, const Epi& epi) {
  extern __shared__ __attribute__((aligned(16))) unsigned char smem[];
  bf16_t* shm = (bf16_t*)smem;
#define SA(b, h) (shm + ((b) * 2 + (h)) * HT)
#define SB(b, h) (shm + (4 + (b) * 2 + (h)) * HT)
#define STAGE(P, BASE, LD, VO, br, kt) do { const char* _g = (const char*)((BASE) + (long)(br) * (LD) + (long)(kt) * BK); \
    for (int _i = 0; _i < 2; ++_i) { \
      __builtin_amdgcn_global_load_lds((const unsigned*)(_g + VO[_i]), (unsigned*)((char*)(P) + tidx * 16 + _i * 8192), 16, 0, 0); } } while (0)
#define LDA(dst, b, h) for (int m = 0; m < 4; ++m) for (int k = 0; k < 2; ++k) \
    dst[m][k] = *reinterpret_cast<const bf16x8*>((char*)SA(b, h) + lds_byte(wr * 64 + m * 16 + fr, k * 32 + fq * 8))
#define LDB(dst, b, h) for (int n = 0; n < 2; ++n) for (int k = 0; k < 2; ++k) \
    dst[n][k] = *reinterpret_cast<const bf16x8*>((char*)SB(b, h) + lds_byte(wc * 32 + n * 16 + fr, k * 32 + fq * 8))
#define MMA(ai, bj, At, Bf) do { __builtin_amdgcn_s_setprio(1); \
    for (int m = 0; m < 4; ++m) for (int n = 0; n < 2; ++n) for (int k = 0; k < 2; ++k) \
      acc[ai][bj][m][n] = __builtin_amdgcn_mfma_f32_16x16x32_bf16(Bf[n][k], At[m][k], acc[ai][bj][m][n], 0, 0, 0); \
    __builtin_amdgcn_s_setprio(0); } while (0)
#define WAIT_V(n) asm volatile("s_waitcnt vmcnt(" #n ")" ::: "memory")
#define WAIT_L(n) asm volatile("s_waitcnt lgkmcnt(" #n ")" ::: "memory")
#define BAR __builtin_amdgcn_s_barrier()
#define SCHED __builtin_amdgcn_sched_barrier(0)
  int tidx; asm volatile("v_mov_b32 %0, %1" : "=v"(tidx) : "v"(threadIdx.x));
  const int wid = tidx >> 6, lane = tidx & 63, wr = wid >> 2, wc = wid & 3, fr = lane & 15, fq = lane >> 4;
  f32x4 acc[2][2][4][2] = {};
  bf16x8 At[4][2], B0[2][2], B1[2][2];
  const int nt = K / BK;
  unsigned voA[2], voB[2];
  for (int i = 0; i < 2; ++i) { int r_, c_; stage_rc(tidx * 16 + i * 8192, r_, c_); voA[i] = (unsigned)(r_ * lda + c_) * 2u; voB[i] = (unsigned)(r_ * ldb + c_) * 2u; }
  asm volatile("s_waitcnt vmcnt(0) lgkmcnt(0)" ::: "memory");
  __builtin_amdgcn_s_barrier();
  STAGE(SB(0, 0), Bt, ldb, voB, bcol, 0); STAGE(SA(0, 0), A, lda, voA, brow, 0);
  STAGE(SB(0, 1), Bt, ldb, voB, bcol + HALF, 0); STAGE(SA(0, 1), A, lda, voA, brow + HALF, 0);
  if (wr == 1) BAR;
  WAIT_V(4); BAR;
  STAGE(SB(1, 0), Bt, ldb, voB, bcol, 1); STAGE(SA(1, 0), A, lda, voA, brow, 1); STAGE(SB(1, 1), Bt, ldb, voB, bcol + HALF, 1);
  WAIT_V(6); BAR;
  for (int t = 0; t < nt - 2; t += 2) {
    LDB(B0, 0, 0); SCHED; LDA(At, 0, 0); STAGE(SA(1, 1), A, lda, voA, brow + HALF, t + 1);
    WAIT_L(8); BAR; WAIT_L(0); MMA(0, 0, At, B0); BAR; SCHED;
    LDB(B1, 0, 1); STAGE(SB(0, 0), Bt, ldb, voB, bcol, t + 2);
    BAR; WAIT_L(0); MMA(0, 1, At, B1); BAR;
    LDA(At, 0, 1); STAGE(SA(0, 0), A, lda, voA, brow, t + 2);
    BAR; WAIT_L(0); MMA(1, 0, At, B0); BAR; SCHED;
    STAGE(SB(0, 1), Bt, ldb, voB, bcol + HALF, t + 2);
    WAIT_V(6); BAR; MMA(1, 1, At, B1); BAR;
    LDB(B0, 1, 0); SCHED; LDA(At, 1, 0); STAGE(SA(0, 1), A, lda, voA, brow + HALF, t + 2);
    WAIT_L(8); BAR; WAIT_L(0); MMA(0, 0, At, B0); BAR; SCHED;
    LDB(B1, 1, 1); STAGE(SB(1, 0), Bt, ldb, voB, bcol, t + 3);
    BAR; WAIT_L(0); MMA(0, 1, At, B1); BAR;
    LDA(At, 1, 1); STAGE(SA(1, 0), A, lda, voA, brow, t + 3);
    BAR; WAIT_L(0); MMA(1, 0, At, B0); BAR; SCHED;
    STAGE(SB(1, 1), Bt, ldb, voB, bcol + HALF, t + 3);
    WAIT_V(6); BAR; MMA(1, 1, At, B1); BAR;
  }
  { LDB(B0, 0, 0); LDA(At, 0, 0); STAGE(SA(1, 1), A, lda, voA, brow + HALF, nt - 1);
    BAR; WAIT_L(0); MMA(0, 0, At, B0); BAR;
    LDB(B1, 0, 1); BAR; WAIT_L(0); MMA(0, 1, At, B1); BAR;
    LDA(At, 0, 1); WAIT_V(4); BAR; WAIT_L(0); MMA(1, 0, At, B0); MMA(1, 1, At, B1); BAR; }
  { LDB(B0, 1, 0); LDA(At, 1, 0); WAIT_V(2); BAR; WAIT_L(0); MMA(0, 0, At, B0); BAR;
    LDB(B1, 1, 1); WAIT_V(0); BAR; WAIT_L(0); MMA(0, 1, At, B1); BAR;
    LDA(At, 1, 1); BAR; WAIT_L(0); MMA(1, 0, At, B0); MMA(1, 1, At, B1); BAR; }
  if (wr == 0) BAR;
  epi(acc, brow, bcol, wr, wc, fr, fq);
#undef SA
#undef SB
}

DI int vcu_id() { const int G = gridDim.x, bx = blockIdx.x; return (G % 8 == 0) ? (bx % 8) * (G / 8) + bx / 8 : bx; }

typedef const f32x4 (&AccRef)[2][2][4][2];
struct EpiG1 { bf16_t* Z; bf16_t* UA;
  DI void operator()(AccRef acc, int brow, int bcol, int wr, int wc, int fr, int fq) const {
    FOR_ACC(
      if (col < C_SU) { store4bf(Z + (size_t)row * ZLD + col, v); }
      else if (col < ZLD) { const int cc = col - C_SU, g = cc >> 4, i = cc & 15; store4bf(UA + ((size_t)(g * 2048 + (row >> 4)) * 384 + (row & 15) * 16 + i), v); }
    )
  } };
struct EpiBf16 { bf16_t* O; int ldc;
  DI void operator()(AccRef acc, int brow, int bcol, int wr, int wc, int fr, int fq) const {
    FOR_ACC( store4bf(O + (size_t)row * ldc + col, v); )
  } };
struct EpiS5E { float* E;
  DI void operator()(AccRef acc, int brow, int bcol, int wr, int wc, int fr, int fq) const {
    FOR_ACC( if (col < 128) { *(f32x4*)(E + (size_t)row * 128 + col) = v; } )
  } };
DI float gelu_tanh(float x) { const float z = 0.7978845608028654f * (x + 0.044715f * x * x * x); const float t = 1.f - 2.f / (__expf(2.f * z) + 1.f); return 0.5f * x * (1.f + t); }
struct EpiS5Y { bf16_t* Z; int g;
  DI void operator()(AccRef acc, int brow, int bcol, int wr, int wc, int fr, int fq) const {
    FOR_ACC(
      const int j = col >> 4, i = col & 15;
      const size_t t = (size_t)(row >> 9) * 8192 + (size_t)(row & 511) * 16 + j;
      f32x4 o; o[0] = gelu_tanh(v[0]); o[1] = gelu_tanh(v[1]); o[2] = gelu_tanh(v[2]); o[3] = gelu_tanh(v[3]);
      store4bf(Z + t * ZLD + C_SU + g * 16 + i, o);
    )
  } };
struct EpiGLU { bf16_t* Z; const float* bias;
  DI void operator()(AccRef acc, int brow, int bcol, int wr, int wc, int fr, int fq) const {
    FOR_ACC(
      const f32x4 y = load4bf(Z + (size_t)row * ZLD + C_SU + col);
      const f32x4 b = *(const f32x4*)(bias + col);
      f32x4 o; for (int q = 0; q < 4; ++q) o[q] = y[q] * sigmoidf_(v[q] + b[q]);
      store4bf(Z + (size_t)row * ZLD + C_GR + col, o);
    )
  } };
struct EpiScr { uint2* scr;
  DI void operator()(AccRef acc, int brow, int bcol, int wr, int wc, int fr, int fq) const {
    FOR_ACC( uint2 w; w.x = pack2(v[0], v[1]); w.y = pack2(v[2], v[3]); scr[(((ai * 2 + bj) * 4 + m) * 2 + n) * NTHR + threadIdx.x] = w; )
  } };
struct EpiGate { const uint2* scr; bf16_t* M; const float* gb; int br;
  DI void operator()(AccRef acc, int brow, int bcol, int wr, int wc, int fr, int fq) const {
    FOR_ACC(
      const uint2 w = scr[(((ai * 2 + bj) * 4 + m) * 2 + n) * NTHR + threadIdx.x];
      f32x4 p; p[0] = __uint_as_float(w.x << 16); p[1] = __uint_as_float(w.x & 0xffff0000u); p[2] = __uint_as_float(w.y << 16); p[3] = __uint_as_float(w.y & 0xffff0000u);
      const f32x4 b = *(const f32x4*)(gb + col);
      bf16_t* dst = M + (size_t)row * 1024 + col;
      f32x4 o = {0.f, 0.f, 0.f, 0.f};
      if (br > 0) o = load4bf(dst);
      for (int q = 0; q < 4; ++q) o[q] += sigmoidf_(v[q] + b[q]) * p[q];
      store4bf(dst, o);
    )
  } };
struct EpiP2 { int kind; bf16_t* O; int ldc; float* E;
  DI void operator()(AccRef acc, int brow, int bcol, int wr, int wc, int fr, int fq) const {
    if (kind == 0) { FOR_ACC( store4bf(O + (size_t)row * ldc + col, v); ) }
    else { FOR_ACC( if (col < 128) { *(f32x4*)(E + (size_t)row * 128 + col) = v; } ) }
  } };
struct EpiP6 { int kind; uint2* scr; bf16_t* M; const float* gb; int br;
  DI void operator()(AccRef acc, int brow, int bcol, int wr, int wc, int fr, int fq) const {
    uint2* sl = scr + (((wr * 4 + wc) * 4 + fq) * 16 + fr);
    if (kind == 0) { FOR_ACC( uint2 w; w.x = pack2(v[0], v[1]); w.y = pack2(v[2], v[3]); sl[(((ai * 2 + bj) * 4 + m) * 2 + n) * NTHR] = w; ) }
    else {
      FOR_ACC(
        const uint2 w = sl[(((ai * 2 + bj) * 4 + m) * 2 + n) * NTHR];
        f32x4 p; p[0] = __uint_as_float(w.x << 16); p[1] = __uint_as_float(w.x & 0xffff0000u); p[2] = __uint_as_float(w.y << 16); p[3] = __uint_as_float(w.y & 0xffff0000u);
        const f32x4 b = *(const f32x4*)(gb + col);
        bf16_t* dst = M + (size_t)row * 1024 + col;
        f32x4 o = {0.f, 0.f, 0.f, 0.f};
        if (br > 0) o = load4bf(dst);
        for (int q = 0; q < 4; ++q) o[q] += sigmoidf_(v[q] + b[q]) * p[q];
        store4bf(dst, o);
      )
    }
  } };
struct EpiResid { const float* src; float* dst;
  DI void operator()(AccRef acc, int brow, int bcol, int wr, int wc, int fr, int fq) const {
    FOR_ACC(
      const f32x4 x = *(const f32x4*)(src + (size_t)row * 1024 + col);
      *(f32x4*)(dst + (size_t)row * 1024 + col) = x + v;
    )
  } };
struct EpiRelu2 { bf16_t* O;
  DI void operator()(AccRef acc, int brow, int bcol, int wr, int wc, int fr, int fq) const {
    FOR_ACC( f32x4 o; for (int q = 0; q < 4; ++q) { const float r = fmaxf(v[q], 0.f); o[q] = r * r; } store4bf(O + (size_t)row * DFF + col, o); )
  } };

DI void rmsnorm_rows(const float* __restrict__ src, const float* __restrict__ g, bf16_t* __restrict__ dst) {
  const int wave = threadIdx.x >> 6, lane = threadIdx.x & 63;
  f32x4 gv[4];
#pragma unroll
  for (int i = 0; i < 4; ++i) gv[i] = *(const f32x4*)(g + lane * 4 + 256 * i);
  for (int row = blockIdx.x * 8 + wave; row < T_; row += gridDim.x * 8) {
    f32x4 x[4]; float ss = 0.f;
#pragma unroll
    for (int i = 0; i < 4; ++i) { x[i] = *(const f32x4*)(src + (size_t)row * 1024 + lane * 4 + 256 * i); ss += x[i][0] * x[i][0] + x[i][1] * x[i][1] + x[i][2] * x[i][2] + x[i][3] * x[i][3]; }
    ss = wave_sum(ss);
    const float rs = rsqrtf(ss * (1.f / 1024.f) + EPS);
#pragma unroll
    for (int i = 0; i < 4; ++i) { f32x4 o = x[i] * rs * gv[i]; store4bf(dst + (size_t)row * 1024 + lane * 4 + 256 * i, o); }
  }
}

DI void xpose_cvt(const float* __restrict__ src, int Kd, int Nd, bf16_t* __restrict__ dst, const float* __restrict__ gs) {
  extern __shared__ __attribute__((aligned(16))) unsigned char smem[];
  float* tile = (float*)smem;
  const int tk = Kd / 64, tn = (Nd + 63) / 64, ntile = tk * tn;
  const int tid = threadIdx.x, c = tid & 63, r0 = tid >> 6;
  for (int tix = blockIdx.x; tix < ntile; tix += gridDim.x) {
    const int k0 = (tix % tk) * 64, n0 = (tix / tk) * 64;
    __syncthreads();
#pragma unroll
    for (int i = 0; i < 8; ++i) { const int r = r0 + 8 * i; const int n = n0 + c; tile[r * 65 + c] = (n < Nd) ? src[(size_t)(k0 + r) * Nd + n] : 0.f; }
    __syncthreads();
    const float sc = gs ? gs[k0 + c] : 1.f;
#pragma unroll
    for (int i = 0; i < 8; ++i) { const int r = r0 + 8 * i; const int n = n0 + r; if (n < Nd) dst[(size_t)n * Kd + k0 + c] = f2bf(tile[c * 65 + r] * sc); }
  }
}

DI void s5_mats(const Ctx& c) {
  extern __shared__ __attribute__((aligned(16))) unsigned char smem[];
  float* lp_re = (float*)smem;
  float* lp_im = lp_re + 17 * 64;
  float* bb_re = lp_im + 17 * 64;
  float* bb_im = bb_re + 1024;
  float* cr = bb_im + 1024;
  float* ci = cr + 1024;
  float* Kt = ci + 1024;
  float* dv = Kt + 4096;
  const int tid = threadIdx.x;
  bf16_t* ME = (bf16_t*)(c.ws + OFF_MATS);
  bf16_t* MY = (bf16_t*)(c.ws + OFF_MY);
  for (int g = blockIdx.x; g < 32; g += gridDim.x) {
    __syncthreads();
    if (tid < 64) {
      const int p = tid;
      const float lre = fminf(c.inp(12, 2048)[g * 64 + p], -1e-4f), lim = c.inp(13, 2048)[g * 64 + p];
      const float step = expf(c.inp(19, 32)[g]);
      for (int d = 0; d <= 16; ++d) { const float mag = expf(lre * step * d); float s, co; sincosf(lim * step * d, &s, &co); lp_re[d * 64 + p] = mag * co; lp_im[d * 64 + p] = mag * s; }
      const float nr = lp_re[64 + p] - 1.f, ni = lp_im[64 + p];
      const float den = 1.f / (lre * lre + lim * lim);
      const float kr = (nr * lre + ni * lim) * den, ki = (ni * lre - nr * lim) * den;
      for (int i = 0; i < 16; ++i) { const float br = c.inp(14, 32768)[(g * 64 + p) * 16 + i], bi = c.inp(15, 32768)[(g * 64 + p) * 16 + i]; bb_re[p * 16 + i] = kr * br - ki * bi; bb_im[p * 16 + i] = kr * bi + ki * br; }
    }
    for (int i = tid; i < 1024; i += NTHR) { cr[i] = c.inp(16, 32768)[g * 1024 + i]; ci[i] = c.inp(17, 32768)[g * 1024 + i]; }
    if (tid < 16) dv[tid] = c.inp(18, 512)[g * 16 + tid];
    __syncthreads();
    for (int idx = tid; idx < 4096; idx += NTHR) {
      const int d = idx >> 8, i = (idx >> 4) & 15, i2 = idx & 15; float s = 0.f;
      for (int p = 0; p < 64; ++p) { const float lr = lp_re[d * 64 + p], li = lp_im[d * 64 + p], br = bb_re[p * 16 + i2], bi = bb_im[p * 16 + i2];
        const float wre = lr * br - li * bi, wim = lr * bi + li * br; s += cr[i * 64 + p] * wre - ci[i * 64 + p] * wim; }
      Kt[idx] = s;
    }
    __syncthreads();
    for (int idx = tid; idx < 256 * 384; idx += NTHR) {
      const int n = idx / 384, k = idx % 384, j = n >> 4, i = n & 15; float val;
      if (k < 256) { const int j2 = k >> 4, i2 = k & 15; val = (j >= j2) ? Kt[((j - j2) * 16 + i) * 16 + i2] + ((j == j2 && i == i2) ? dv[i] : 0.f) : 0.f; }
      else if (k < 320) { const int p = k - 256; val = cr[i * 64 + p] * lp_re[(j + 1) * 64 + p] - ci[i * 64 + p] * lp_im[(j + 1) * 64 + p]; }
      else { const int p = k - 320; val = -(cr[i * 64 + p] * lp_im[(j + 1) * 64 + p] + ci[i * 64 + p] * lp_re[(j + 1) * 64 + p]); }
      MY[(size_t)g * 256 * 384 + idx] = f2bf(val);
    }
    for (int idx = tid; idx < 256 * 256; idx += NTHR) {
      const int n = idx >> 8, k = idx & 255, j2 = k >> 4, i2 = k & 15; float val = 0.f;
      if (n < 128) { const int p = n & 63; const float lr = lp_re[(15 - j2) * 64 + p], li = lp_im[(15 - j2) * 64 + p], br = bb_re[p * 16 + i2], bi = bb_im[p * 16 + i2];
        val = (n < 64) ? (lr * br - li * bi) : (lr * bi + li * br); }
      ME[(size_t)g * 65536 + idx] = f2bf(val);
    }
  }
}

DI void rope_table(const Ctx& c) {
  float* cs = (float*)(c.ws + OFF_ROPE); float* sn = cs + 8192 * 16;
  for (int idx = blockIdx.x * NTHR + threadIdx.x; idx < 8192 * 16; idx += gridDim.x * NTHR) {
    const int pos = idx >> 4, i = idx & 15;
    const float invf = powf(10000.f, -(float)(2 * i) / 32.f);
    const float ang = (float)pos * invf;
    cs[idx] = (float)cos((double)ang); sn[idx] = (float)sin((double)ang);
  }
}

DI void gla_bc(const Ctx& c, const bf16_t* Z, int t0, int h, float* glr_s, float* wg_s, float* bc_s) {
  const int tid = threadIdx.x;
  const float* wg = c.inp(9, 16 * 256); const float* bg = c.inp(10, 256);
  for (int idx = tid; idx < 1024; idx += NTHR) { const int cc = idx >> 4, r = idx & 15; glr_s[idx] = bf2f(Z[(size_t)(t0 + cc) * ZLD + C_GLR + r]); wg_s[idx] = wg[(idx >> 6) * 256 + h * 64 + (idx & 63)]; }
  __syncthreads();
  for (int idx = tid; idx < 4096; idx += NTHR) {
    const int cc = idx >> 6, d = idx & 63; float a = bg[h * 64 + d];
#pragma unroll
    for (int r = 0; r < 16; ++r) a += glr_s[cc * 16 + r] * wg_s[r * 64 + d];
    bc_s[idx] = (fminf(a, 0.f) - log1pf(expf(-fabsf(a)))) * (1.f / 16.f);
  }
  __syncthreads();
  if (tid < 64) { float run = 0.f; for (int cc = 0; cc < 64; ++cc) { run += bc_s[cc * 64 + tid]; bc_s[cc * 64 + tid] = run; } }
  __syncthreads();
}

DI void gla_pass1(const Ctx& c, int unit) {
  extern __shared__ __attribute__((aligned(16))) unsigned char smem[];
  float* glr_s = (float*)smem; float* wg_s = glr_s + 1024; float* bc_s = wg_s + 1024; float* ke_s = bc_s + 4096; float* v_s = ke_s + 4096;
  const bf16_t* Z = (const bf16_t*)(c.ws + OFF_Z);
  int tid_; asm volatile("v_mov_b32 %0, %1" : "=v"(tid_) : "v"(threadIdx.x));
  const int tid = tid_, n = unit & 127, bh = unit >> 7, h = bh & 3, b = bh >> 2, t0 = b * L_ + n * 64;
  __syncthreads();
  gla_bc(c, Z, t0, h, glr_s, wg_s, bc_s);
  for (int idx = tid; idx < 4096; idx += NTHR) { const int cc = idx >> 6, d = idx & 63; ke_s[idx] = bf2f(Z[(size_t)(t0 + cc) * ZLD + C_GK + h * 64 + d]) * __expf(bc_s[63 * 64 + d] - bc_s[idx]); }
  for (int idx = tid; idx < 8192; idx += NTHR) { const int cc = idx >> 7, e = idx & 127; v_s[idx] = bf2f(Z[(size_t)(t0 + cc) * ZLD + C_GV + h * 128 + e]); }
  __syncthreads();
  const int e = tid & 127, d0 = (tid >> 7) * 16;
  float a[16];
#pragma unroll
  for (int i = 0; i < 16; ++i) a[i] = 0.f;
  for (int cc = 0; cc < 64; ++cc) {
    const float vv = v_s[cc * 128 + e];
#pragma unroll
    for (int i = 0; i < 16; ++i) a[i] += vv * ke_s[cc * 64 + d0 + i];
  }
  bf16_t* GS = (bf16_t*)(c.ws + OFF_GS) + (size_t)unit * 8192;
#pragma unroll
  for (int i = 0; i < 16; ++i) GS[(d0 + i) * 128 + e] = f2bf(a[i]);
  if (tid < 64) ((float*)(c.ws + OFF_GDEC))[unit * 64 + tid] = __expf(bc_s[63 * 64 + tid]);
}

DI void gla_scan(const Ctx& c) {
  bf16_t* GS = (bf16_t*)(c.ws + OFF_GS); const float* dec = (const float*)(c.ws + OFF_GDEC);
  for (int idx = blockIdx.x * NTHR + threadIdx.x; idx < 16 * 8192; idx += gridDim.x * NTHR) {
    const int bh = idx >> 13, ed = idx & 8191, d = ed >> 7;
    float S = 0.f;
    bf16_t* p = GS + (size_t)bh * 128 * 8192 + ed; const float* dp = dec + bh * 128 * 64 + d;
#pragma unroll 8
    for (int n = 0; n < 128; ++n) { const float ds = bf2f(p[(size_t)n * 8192]); const float dc = dp[n * 64]; p[(size_t)n * 8192] = f2bf(S); S = dc * S + ds; }
  }
}

DI void gla_pass3(const Ctx& c, int unit) {
  extern __shared__ __attribute__((aligned(16))) unsigned char smem[];
  float* glr_s = (float*)smem; float* wg_s = glr_s + 1024; float* bc_s = wg_s + 1024;
  float* A_s = (float*)smem;
  float* qt_s = (float*)smem + 6144;
  float* kt_s = qt_s + 4160;
  float* v_s = kt_s + 4096;
  float* S_s = v_s + 8192;
  float* red_s = S_s + 8192;
  bf16_t* Z = (bf16_t*)(c.ws + OFF_Z);
  int tid_; asm volatile("v_mov_b32 %0, %1" : "=v"(tid_) : "v"(threadIdx.x));
  const int tid = tid_, n = unit & 127, bh = unit >> 7, h = bh & 3, b = bh >> 2, t0 = b * L_ + n * 64;
  __syncthreads();
  gla_bc(c, Z, t0, h, glr_s, wg_s, bc_s);
  for (int idx = tid; idx < 4096; idx += NTHR) {
    const int cc = idx >> 6, d = idx & 63; const float bcv = bc_s[idx];
    qt_s[cc * 65 + d] = bf2f(Z[(size_t)(t0 + cc) * ZLD + C_GQ + h * 64 + d]) * 0.125f * __expf(bcv);
    kt_s[idx] = bf2f(Z[(size_t)(t0 + cc) * ZLD + C_GK + h * 64 + d]) * __expf(-bcv);
  }
  const bf16_t* GS = (const bf16_t*)(c.ws + OFF_GS) + (size_t)unit * 8192;
  for (int idx = tid; idx < 8192; idx += NTHR) { const int cc = idx >> 7, e = idx & 127; v_s[idx] = bf2f(Z[(size_t)(t0 + cc) * ZLD + C_GV + h * 128 + e]); S_s[idx] = bf2f(GS[idx]); }
  __syncthreads();
  const int cc = tid & 63, wg8 = tid >> 6;
  {
    float a[8];
#pragma unroll
    for (int i = 0; i < 8; ++i) a[i] = 0.f;
    for (int d = 0; d < 64; ++d) { const float qv = qt_s[cc * 65 + d];
#pragma unroll
      for (int i = 0; i < 8; ++i) a[i] += qv * kt_s[(wg8 * 8 + i) * 64 + d]; }
#pragma unroll
    for (int i = 0; i < 8; ++i) { const int s = wg8 * 8 + i; A_s[cc * 65 + s] = (s <= cc) ? a[i] : 0.f; }
  }
  __syncthreads();
  const int e0 = wg8 * 16;
  float o[16];
#pragma unroll
  for (int i = 0; i < 16; ++i) o[i] = 0.f;
  for (int s = 0; s < 64; ++s) { const float av = A_s[cc * 65 + s];
#pragma unroll
    for (int i = 0; i < 16; ++i) o[i] += av * v_s[s * 128 + e0 + i]; }
  for (int d = 0; d < 64; ++d) { const float qv = qt_s[cc * 65 + d];
#pragma unroll
    for (int i = 0; i < 16; ++i) o[i] += qv * S_s[d * 128 + e0 + i]; }
  float ss = 0.f;
#pragma unroll
  for (int i = 0; i < 16; ++i) ss += o[i] * o[i];
  red_s[wg8 * 64 + cc] = ss;
  __syncthreads();
  float tot = 0.f;
#pragma unroll
  for (int i = 0; i < 8; ++i) tot += red_s[i * 64 + cc];
  const float rinv = rsqrtf(tot * (1.f / 128.f) + EPS);
  const float* og = c.inp(11, 128);
  const bf16_t* rp = Z + (size_t)(t0 + cc) * ZLD + C_GR + h * 128 + e0;
  bf16_t* op = Z + (size_t)(t0 + cc) * ZLD + C_GV + h * 128 + e0;
#pragma unroll
  for (int q = 0; q < 4; ++q) {
    const f32x4 r = load4bf(rp + q * 4); f32x4 w;
#pragma unroll
    for (int i = 0; i < 4; ++i) { const float rv = r[i]; w[i] = o[q * 4 + i] * rinv * og[e0 + q * 4 + i] * (rv / (1.f + __expf(-rv))); }
    store4bf(op + q * 4, w);
  }
}

DI void s5_scan(const Ctx& c) {
  const float* E = (const float*)(c.ws + OFF_EOA); bf16_t* UA = (bf16_t*)(c.ws + OFF_UA);
  const int idx = blockIdx.x * NTHR + threadIdx.x;
  if (idx >= 8192) return;
  const int p = idx & 63, b = (idx >> 6) & 3, g = idx >> 8;
  const float lre = fminf(c.inp(12, 2048)[g * 64 + p], -1e-4f), lim = c.inp(13, 2048)[g * 64 + p];
  const float step = expf(c.inp(19, 32)[g]);
  const float mag = expf(lre * step * 16.f); float sn, cs; sincosf(lim * step * 16.f, &sn, &cs);
  const float ar = mag * cs, ai = mag * sn;
  float sr = 0.f, si = 0.f;
  const size_t row0 = (size_t)g * 2048 + (size_t)b * 512;
#pragma unroll 8
  for (int ch = 0; ch < 512; ++ch) {
    const float er = E[(row0 + ch) * 128 + p], ei = E[(row0 + ch) * 128 + 64 + p];
    UA[(row0 + ch) * 384 + 256 + p] = f2bf(sr); UA[(row0 + ch) * 384 + 320 + p] = f2bf(si);
    const float nr = ar * sr - ai * si + er, ni = ar * si + ai * sr + ei; sr = nr; si = ni;
  }
}

DI void mla_finalize(const Ctx& c, int first_block, int nblocks) {
  const int wave = threadIdx.x >> 6, lane = threadIdx.x & 63;
  const bf16_t* Z = (const bf16_t*)(c.ws + OFF_Z);
  bf16_t* Q = (bf16_t*)(c.ws + OFF_QRAW); bf16_t* KV = (bf16_t*)(c.ws + OFF_KVRAW); bf16_t* KP = (bf16_t*)(c.ws + OFF_KPE2);
  const float* cs = (const float*)(c.ws + OFF_ROPE); const float* sn = cs + 8192 * 16;
  const float* qg = c.inp(7, 96); const float* kg = c.inp(8, 96);
  const float qg0 = qg[lane], qg1 = qg[64 + (lane & 31)], kg0 = kg[lane], kg1 = kg[64 + (lane & 31)];
  const float qscale = 0.10206207261596575f * 1.4426950408889634f;
  for (int t = (blockIdx.x - first_block) * 8 + wave; t < T_; t += nblocks * 8) {
    const int pos = t & (L_ - 1);
    float ss = 0.f;
#pragma unroll
    for (int i = 0; i < 6; ++i) { const float v = bf2f(Z[(size_t)t * ZLD + C_CQ + lane + 64 * i]); ss += v * v; }
    const float rsq = rsqrtf(wave_sum(ss) * (1.f / 384.f) + EPS);
    ss = 0.f;
#pragma unroll
    for (int i = 0; i < 4; ++i) { const float v = bf2f(Z[(size_t)t * ZLD + C_CKV + lane + 64 * i]); ss += v * v; }
    const float rskv = rsqrtf(wave_sum(ss) * (1.f / 256.f) + EPS);
    const float cv = cs[pos * 16 + (lane & 15)], sv = sn[pos * 16 + (lane & 15)];
    const float kpe = (lane < 32) ? bf2f(Z[(size_t)t * ZLD + C_KPE + lane]) : 0.f;
    for (int h = 0; h < 8; ++h) {
      bf16_t* qp = Q + (size_t)t * 768 + h * 96;
      const float a0 = bf2f(qp[lane]) * rsq;
      const float a1 = (lane < 32) ? bf2f(qp[64 + lane]) * rsq : 0.f;
      const float rq = rsqrtf(wave_sum(a0 * a0 + a1 * a1) * (1.f / 96.f) + EPS);
      const float n0 = a0 * rq * qg0;
      float n1 = a1 * rq * qg1;
      { const float oth = __shfl_xor(n1, 16); n1 = (lane < 16) ? (n1 * cv - oth * sv) : (oth * sv + n1 * cv); }
      qp[lane] = f2bf(n0 * qscale);
      if (lane < 32) qp[64 + lane] = f2bf(n1 * qscale);
      bf16_t* kp = KV + (size_t)t * 1024 + h * 128;
      const float k0 = bf2f(kp[lane]) * rskv;
      const float rk = rsqrtf(wave_sum(k0 * k0 + kpe * kpe) * (1.f / 96.f) + EPS);
      kp[lane] = f2bf(k0 * rk * kg0);
      float p1 = kpe * rk * kg1;
      { const float oth = __shfl_xor(p1, 16); p1 = (lane < 16) ? (p1 * cv - oth * sv) : (oth * sv + p1 * cv); }
      if (lane < 32) KP[((size_t)t * 8 + h) * 32 + lane] = f2bf(p1);
      kp[64 + lane] = f2bf(bf2f(kp[64 + lane]) * rskv);
    }
  }
}

constexpr int KSTR = 104, VSTR = 72;
constexpr int KS_BYTES = 64 * KSTR * 2, VT_BYTES = 64 * VSTR * 2;
DI bf16x8 pack8(const f32x16& x, int s) {
  union { unsigned u[4]; bf16x8 v; } r;
  r.u[0] = pack2(x[8 * s + 0], x[8 * s + 1]); r.u[1] = pack2(x[8 * s + 2], x[8 * s + 3]); r.u[2] = pack2(x[8 * s + 4], x[8 * s + 5]); r.u[3] = pack2(x[8 * s + 6], x[8 * s + 7]);
  return r.v;
}
DI void attn_unit(const Ctx& c, int unit) {
  extern __shared__ __attribute__((aligned(16))) unsigned char smem[];
  int tid_; asm volatile("v_mov_b32 %0, %1" : "=v"(tid_) : "v"(threadIdx.x));
  const int tid = tid_, wave = tid >> 6, lane = tid & 63, l32 = lane & 31, hb = lane >> 5;
  const int qb = 31 - (unit >> 5), bh = unit & 31, b = bh >> 3, h = bh & 7;
  const size_t tb = (size_t)b * L_;
  const bf16_t* Q = (const bf16_t*)(c.ws + OFF_QRAW); const bf16_t* KV = (const bf16_t*)(c.ws + OFF_KVRAW); const bf16_t* KP = (const bf16_t*)(c.ws + OFF_KPE2);
  bf16_t* OA = (bf16_t*)(c.ws + OFF_EOA);
  const int q0 = qb * 256, qw0 = q0 + wave * 32;
  bf16x8 qf[6];
#pragma unroll
  for (int s = 0; s < 6; ++s) qf[s] = *(const bf16x8*)(Q + (tb + qw0 + l32) * 768 + h * 96 + s * 16 + hb * 8);
  f32x16 ot[2];
#pragma unroll
  for (int i = 0; i < 16; ++i) { ot[0][i] = 0.f; ot[1][i] = 0.f; }
  float mrun = -1e30f, lrun = 0.f;
  const int nkt = (q0 + 256) / 64;
  const int kn_row = tid >> 3, kn_ch = tid & 7, kp_row = tid >> 2, kp_ch = tid & 3, v_key = tid & 63, v_ch = tid >> 6;
  uint4 rkn, rkp = {0, 0, 0, 0}, rv;
  auto gload = [&](int k0) {
    rkn = *(const uint4*)(KV + (tb + k0 + kn_row) * 1024 + h * 128 + kn_ch * 8);
    if (tid < 256) rkp = *(const uint4*)(KP + ((tb + k0 + kp_row) * 8 + h) * 32 + kp_ch * 8);
    rv = *(const uint4*)(KV + (tb + k0 + v_key) * 1024 + h * 128 + 64 + v_ch * 8);
  };
  auto lstore = [&](int buf) {
    unsigned char* ks = smem + buf * KS_BYTES; bf16_t* vt = (bf16_t*)(smem + 2 * KS_BYTES + buf * VT_BYTES);
    *(uint4*)(ks + (kn_row * KSTR + kn_ch * 8) * 2) = rkn;
    if (tid < 256) *(uint4*)(ks + (kp_row * KSTR + 64 + kp_ch * 8) * 2) = rkp;
    const unsigned w[4] = {rv.x, rv.y, rv.z, rv.w};
#pragma unroll
    for (int i = 0; i < 4; ++i) { vt[(v_ch * 8 + 2 * i) * VSTR + v_key] = (bf16_t)(w[i] & 0xffffu); vt[(v_ch * 8 + 2 * i + 1) * VSTR + v_key] = (bf16_t)(w[i] >> 16); }
  };
  __syncthreads();
  gload(0); lstore(0);
  __syncthreads();
  for (int kt = 0; kt < nkt; ++kt) {
    const int k0 = kt * 64, buf = kt & 1;
    if (kt + 1 < nkt) gload(k0 + 64);
    if (k0 <= qw0 + 31) {
      const unsigned char* ks = smem + buf * KS_BYTES; const bf16_t* vt = (const bf16_t*)(smem + 2 * KS_BYTES + buf * VT_BYTES);
      f32x16 st[2];
#pragma unroll
      for (int i = 0; i < 16; ++i) { st[0][i] = 0.f; st[1][i] = 0.f; }
#pragma unroll
      for (int ksub = 0; ksub < 2; ++ksub)
#pragma unroll
        for (int s = 0; s < 6; ++s) {
          const bf16x8 a = *(const bf16x8*)(ks + ((ksub * 32 + l32) * KSTR + s * 16 + hb * 8) * 2);
          st[ksub] = __builtin_amdgcn_mfma_f32_32x32x16_bf16(a, qf[s], st[ksub], 0, 0, 0);
        }
      if (k0 + 63 > qw0) {
        const int qpos = qw0 + l32;
#pragma unroll
        for (int ksub = 0; ksub < 2; ++ksub)
#pragma unroll
          for (int r = 0; r < 16; ++r) { const int key = k0 + ksub * 32 + (r & 3) + 8 * (r >> 2) + 4 * hb; if (key > qpos) st[ksub][r] = -1e30f; }
      }
      float mx = -1e30f;
#pragma unroll
      for (int r = 0; r < 16; ++r) mx = fmaxf(mx, fmaxf(st[0][r], st[1][r]));
      mx = fmaxf(mx, __shfl_xor(mx, 32));
      const float mnew = fmaxf(mrun, mx);
      const float alpha = __builtin_amdgcn_exp2f(mrun - mnew);
      float rs = 0.f;
#pragma unroll
      for (int r = 0; r < 16; ++r) { st[0][r] = __builtin_amdgcn_exp2f(st[0][r] - mnew); st[1][r] = __builtin_amdgcn_exp2f(st[1][r] - mnew); rs += st[0][r] + st[1][r]; }
      rs += __shfl_xor(rs, 32);
      lrun = lrun * alpha + rs; mrun = mnew;
#pragma unroll
      for (int i = 0; i < 16; ++i) { ot[0][i] *= alpha; ot[1][i] *= alpha; }
#pragma unroll
      for (int ksub = 0; ksub < 2; ++ksub)
#pragma unroll
        for (int s2 = 0; s2 < 2; ++s2) {
          const bf16x8 pf = pack8(st[ksub], s2);
#pragma unroll
          for (int dt = 0; dt < 2; ++dt) {
            const bf16_t* vp = vt + (dt * 32 + l32) * VSTR + ksub * 32 + 16 * s2 + 4 * hb;
            const s16x4 lo = *(const s16x4*)vp, hi = *(const s16x4*)(vp + 8);
            const bf16x8 a = __builtin_shufflevector(lo, hi, 0, 1, 2, 3, 4, 5, 6, 7);
            ot[dt] = __builtin_amdgcn_mfma_f32_32x32x16_bf16(a, pf, ot[dt], 0, 0, 0);
          }
        }
    }
    if (kt + 1 < nkt) lstore(buf ^ 1);
    __syncthreads();
  }
  const float inv = 1.f / lrun;
  bf16_t* op = OA + (tb + qw0 + l32) * 512 + h * 64;
#pragma unroll
  for (int dt = 0; dt < 2; ++dt)
#pragma unroll
    for (int g4 = 0; g4 < 4; ++g4) {
      f32x4 v; v[0] = ot[dt][g4 * 4 + 0] * inv; v[1] = ot[dt][g4 * 4 + 1] * inv; v[2] = ot[dt][g4 * 4 + 2] * inv; v[3] = ot[dt][g4 * 4 + 3] * inv;
      store4bf(op + dt * 32 + 8 * g4 + 4 * hb, v);
    }
}

constexpr int N_PH_LAYER = 11;
DI int next_unit(unsigned* ctr) {
  extern __shared__ __attribute__((aligned(16))) unsigned char smem[];
  volatile int* su = (volatile int*)(smem + LDS_UNIT_OFF);
  __syncthreads();
  if (threadIdx.x == 0) *su = (int)atomicAdd(ctr, 1u);
  __syncthreads();
  return *su;
}

DI void run_phase(const Ctx& c, int k) {
  unsigned char* ws = c.ws;
  bf16_t* Z = (bf16_t*)(ws + OFF_Z); bf16_t* H = (bf16_t*)(ws + OFF_H); bf16_t* W = (bf16_t*)(ws + OFF_W); bf16_t* UA = (bf16_t*)(ws + OFF_UA);
  const int G = gridDim.x, vcu = vcu_id();
  const float* xsrc = (c.layer == 0) ? c.in[0] : c.out;
  switch (k) {
    case 0: {
      rmsnorm_rows(xsrc, c.inp(1, 1024), H);
      if (c.layer == 0) rope_table(c);
      s5_mats(c);
      xpose_cvt(c.inp(2, (size_t)1024 * DIN), 1024, DIN, W + W_IN, nullptr);
      xpose_cvt(c.inp(4, 384 * 768), 384, 768, W + W_UQ, c.inp(3, 384));
      xpose_cvt(c.inp(6, 256 * 1024), 256, 1024, W + W_UKV, c.inp(5, 256));
      xpose_cvt(c.inp(20, 512 * 512), 512, 512, W + W_GLU, nullptr);
      xpose_cvt(c.inp(22, 512 * 1024), 512, 1024, W + W_BR, nullptr);
      xpose_cvt(c.inp(23, 512 * 1024), 512, 1024, W + W_BR + 1024 * 512, nullptr);
      xpose_cvt(c.inp(24, 512 * 1024), 512, 1024, W + W_BR + 2 * 1024 * 512, nullptr);
      xpose_cvt(c.inp(26, 1024 * 1024), 1024, 1024, W + W_OUT, nullptr);
    } break;
    case 1: {
      const EpiG1 e{Z, UA};
      for (int u = vcu; u < 128 * 11; u += G) gemm_tile<1024, 1024, 1024>(H, W + W_IN, (u / 11) * 256, (u % 11) * 256, e);
    } break;
    case 2: {
      for (int u = vcu; u < 896 + 256 + 2048; u += G) {
        if (u < 384) { const EpiP2 e{0, (bf16_t*)(ws + OFF_QRAW), 768, nullptr}; gemm_tile<ZLD, 384, 384>(Z + C_CQ, W + W_UQ, (u / 3) * 256, (u % 3) * 256, e); }
        else if (u < 896) { const int v = u - 384; const EpiP2 e{0, (bf16_t*)(ws + OFF_KVRAW), 1024, nullptr}; gemm_tile<ZLD, 256, 256>(Z + C_CKV, W + W_UKV, (v / 4) * 256, (v % 4) * 256, e); }
        else if (u < 1152) { const int v = u - 896, g = v >> 3, pm = v & 7; const EpiP2 e{1, nullptr, 0, (float*)(ws + OFF_EOA) + (size_t)g * 2048 * 128};
          gemm_tile<384, 256, 256>(UA + (size_t)g * 2048 * 384, (const bf16_t*)(ws + OFF_MATS) + (size_t)g * 65536, pm * 256, 0, e); }
        else gla_pass1(c, u - 1152);
      }
    } break;
    case 3: {
      gla_scan(c);
      if (blockIdx.x < 16) s5_scan(c); else mla_finalize(c, 16, G - 16);
    } break;
    case 4: {
      unsigned* ctr = (unsigned*)(ws + OFF_CTL) + c.layer;
      for (;;) {
        const int u = next_unit(ctr);
        if (u >= 1024 + 256 + 2048) break;
        if (u < 1024) attn_unit(c, u);
        else if (u < 1280) { const int v = u - 1024, g = v >> 3, pm = v & 7; const EpiS5Y e{Z, g};
          gemm_tile<384, 384, 384>(UA + (size_t)g * 2048 * 384, (const bf16_t*)(ws + OFF_MY) + (size_t)g * 256 * 384, pm * 256, 0, e); }
        else gla_pass3(c, u - 1280);
      }
    } break;
    case 5: {
      const EpiGLU e{Z, c.inp(21, 512)};
      for (int u = vcu; u < 256; u += G) gemm_tile<ZLD, 512, 512>(Z + C_SU, W + W_GLU, (u / 2) * 256, (u % 2) * 256, e);
    } break;
    case 6: {
      uint2* scr = (uint2*)(ws + OFF_SCR) + (size_t)blockIdx.x * 16384;
      bf16_t* M = (bf16_t*)(ws + OFF_MERGED);
      for (int u = vcu; u < 512; u += G) {
        const int brow = (u / 4) * 256, bcol = (u % 4) * 256;
        for (int br = 0; br < 3; ++br) {
          const EpiP6 e0{0, scr, M, c.inp(25, 3072) + br * 1024, br};
          if (br == 0) gemm_tile<512, 512, 512>((const bf16_t*)(ws + OFF_EOA), W + W_BR, brow, bcol, e0);
          else gemm_tile<ZLD, 512, 512>(br == 1 ? Z + C_GV : Z + C_GR, W + W_BR + (size_t)br * 1024 * 512, brow, bcol, e0);
          const EpiP6 e1{1, scr, M, c.inp(25, 3072) + br * 1024, br};
          gemm_tile<1024, 1024, 1024>(H, W + W_IN + (size_t)(ZLD + br * 1024) * 1024, brow, bcol, e1);
        }
      }
    } break;
    case 7: {
      const EpiResid e{xsrc, c.out};
      for (int u = vcu; u < 512; u += G) gemm_tile<1024, 1024, 1024>((const bf16_t*)(ws + OFF_MERGED), W + W_OUT, (u / 4) * 256, (u % 4) * 256, e);
    } break;
    case 8: {
      rmsnorm_rows(c.out, c.inp(27, 1024), H);
      xpose_cvt(c.inp(28, (size_t)1024 * 4096), 1024, 4096, (bf16_t*)(ws + OFF_WFF1), nullptr);
      xpose_cvt(c.inp(29, (size_t)4096 * 1024), 4096, 1024, (bf16_t*)(ws + OFF_WFF2), nullptr);
    } break;
    case 9: {
      const EpiRelu2 e{(bf16_t*)(ws + OFF_FFH)};
      for (int u = vcu; u < 128 * 16; u += G) gemm_tile<1024, 1024, 1024>(H, (const bf16_t*)(ws + OFF_WFF1), (u / 16) * 256, (u % 16) * 256, e);
    } break;
    case 10: {
      const EpiResid e{c.out, c.out};
      for (int u = vcu; u < 512; u += G) gemm_tile<4096, 4096, 4096>((const bf16_t*)(ws + OFF_FFH), (const bf16_t*)(ws + OFF_WFF2), (u / 4) * 256, (u % 4) * 256, e);
    } break;
  }
}

__global__ void __launch_bounds__(NTHR) mega(Params p) {
  cg::grid_group grid = cg::this_grid();
  Ctx c{p, p.in, p.out, p.ws, 0};
  const int lo = p.ph_lo, hi = p.ph_hi;
#define PH(k) if (lo <= (k) && (k) < hi) { c.layer = (k) / N_PH_LAYER; run_phase(c, (k) % N_PH_LAYER); if ((k) + 1 < hi) grid.sync(); }
  PH(0) PH(1) PH(2) PH(3) PH(4) PH(5) PH(6) PH(7) PH(8) PH(9) PH(10)
  PH(11) PH(12) PH(13) PH(14) PH(15) PH(16) PH(17) PH(18) PH(19) PH(20) PH(21)
#undef PH
}

#ifndef MULTI_LAUNCH
#define MULTI_LAUNCH 0
#endif

extern "C" void kernel_launch(void* const* d_in, const int* in_sizes, int n_in,
                              void* d_out, int out_size, void* d_ws, size_t ws_size,
                              hipStream_t stream) {
  static int grid_blocks = 0;
  if (!grid_blocks) {
    if (n_in != 30 || out_size != T_ * D_ || ws_size < WS_END) { fprintf(stderr, "kernel_launch: unexpected shapes n_in=%d out=%d ws=%zu (need %zu)\n", n_in, out_size, ws_size, (size_t)WS_END); grid_blocks = -1; return; }
    int dev = 0, cus = 0, per_cu = 0;
    hipGetDevice(&dev);
    hipDeviceGetAttribute(&cus, hipDeviceAttributeMultiprocessorCount, dev);
    hipFuncSetAttribute((const void*)mega, hipFuncAttributeMaxDynamicSharedMemorySize, LDS_BYTES);
    hipOccupancyMaxActiveBlocksPerMultiprocessor(&per_cu, (const void*)mega, NTHR, LDS_BYTES);
    fprintf(stderr, "cus=%d per_cu=%d ws_size=%zu\n", cus, per_cu, ws_size);
    if (per_cu < 1) { fprintf(stderr, "kernel_launch: occupancy query says 0 blocks/CU\n"); grid_blocks = -1; return; }
    grid_blocks = cus;
  }
  if (grid_blocks < 0) return;
  hipMemsetAsync((char*)d_ws + OFF_CTL, 0, 4096, stream);
  Params p{};
  for (int i = 0; i < 30; ++i) p.in[i] = (const float*)d_in[i];
  p.out = (float*)d_out; p.ws = (unsigned char*)d_ws;
#if MULTI_LAUNCH
  for (int ph = 0; ph < 2 * N_PH_LAYER; ++ph) {
    p.ph_lo = ph; p.ph_hi = ph + 1;
    hipLaunchKernelGGL(mega, dim3(grid_blocks), dim3(NTHR), LDS_BYTES, stream, p);
  }
#else
  p.ph_lo = 0; p.ph_hi = 2 * N_PH_LAYER;
  void* args[] = {&p};
  hipError_t e = hipLaunchCooperativeKernel((void*)mega, dim3(grid_blocks), dim3(NTHR), args, LDS_BYTES, stream);
  if (e != hipSuccess) fprintf(stderr, "coop launch failed: %s\n", hipGetErrorString(e));
#endif
}
```

```cpp
#include <hip/hip_runtime.h>
#include <hip/hip_cooperative_groups.h>
#include <cstdio>
#include <cstdint>
namespace cg = cooperative_groups;

#define DI __device__ __forceinline__
typedef unsigned short bf16_t;
typedef short bf16x8 __attribute__((ext_vector_type(8)));
typedef short s16x4 __attribute__((ext_vector_type(4)));
typedef float f32x4 __attribute__((ext_vector_type(4)));
typedef float f32x16 __attribute__((ext_vector_type(16)));

constexpr int T_ = 32768, L_ = 8192, D_ = 1024, DIN = 5808, DFF = 4096;
constexpr int ZLD = 2736;
constexpr int C_CQ = 0, C_CKV = 384, C_KPE = 640, C_GQ = 672, C_GK = 928, C_GV = 1184, C_GLR = 1696, C_GR = 1712, C_SU = 2224;
constexpr float EPS = 1e-6f;
constexpr int NTHR = 512;
constexpr int LDS_BYTES = 147456;
constexpr int LDS_UNIT_OFF = LDS_BYTES - 16;

constexpr size_t OFF_Z = 0;
constexpr size_t OFF_QRAW = 179306496;
constexpr size_t OFF_KVRAW = OFF_QRAW + 50331648;
constexpr size_t OFF_KPE2 = OFF_KVRAW + 67108864;
constexpr size_t OFF_EOA = OFF_KPE2 + 16777216;
constexpr size_t OFF_H = OFF_EOA + 33554432;
constexpr size_t OFF_GS = OFF_H + 67108864;
constexpr size_t OFF_UA = OFF_GS + 33554432;
constexpr size_t OFF_W = OFF_UA + 50331648;
constexpr size_t W_IN = 0, W_UQ = W_IN + (size_t)DIN * 1024, W_UKV = W_UQ + 768 * 384, W_GLU = W_UKV + 1024 * 256,
                 W_BR = W_GLU + 512 * 512, W_OUT = W_BR + 3 * 1024 * 512, W_END = W_OUT + 1024 * 1024;
constexpr size_t OFF_MATS = OFF_W + ((W_END * 2 + 255) / 256) * 256;
constexpr size_t OFF_MY = OFF_MATS + 32 * 256 * 256 * 2;
constexpr size_t OFF_ROPE = OFF_MY + 32 * 256 * 384 * 2;
constexpr size_t OFF_GDEC = OFF_ROPE + 2 * 8192 * 16 * 4;
constexpr size_t OFF_CTL = OFF_GDEC + 2048 * 64 * 4;
constexpr size_t WS_END = OFF_CTL + 4096;
constexpr size_t OFF_FFH = OFF_Z;
constexpr size_t OFF_MERGED = OFF_QRAW;
constexpr size_t OFF_SCR = OFF_GS;
constexpr size_t OFF_WFF1 = OFF_UA, OFF_WFF2 = OFF_UA + (size_t)4096 * 1024 * 2;
static_assert(WS_END <= 536870912ull, "workspace");
static_assert((size_t)T_ * 4096 * 2 <= OFF_KPE2, "ffh overlay");

struct Params { const float* in[30]; float* out; unsigned char* ws; int ph_lo, ph_hi; };

struct Ctx {
  const Params& P;
  const float* const* in; float* out; unsigned char* ws;
  int layer;
  DI const float* inp(int i, size_t per_layer) const { return P.in[i] + (size_t)layer * per_layer; }
};

DI bf16_t f2bf(float x) { unsigned u = __float_as_uint(x); u += 0x7fffu + ((u >> 16) & 1u); return (bf16_t)(u >> 16); }
DI float bf2f(bf16_t b) { return __uint_as_float(((unsigned)b) << 16); }
typedef __bf16 bf2_t __attribute__((ext_vector_type(2)));
typedef float f32x2 __attribute__((ext_vector_type(2)));
DI unsigned pack2(float lo, float hi) { f32x2 v; v.x = lo; v.y = hi; return __builtin_bit_cast(unsigned, __builtin_convertvector(v, bf2_t)); }
DI float wave_sum(float v) {
#pragma unroll
  for (int o = 32; o; o >>= 1) v += __shfl_xor(v, o);
  return v;
}
DI float sigmoidf_(float x) { return 1.f / (1.f + __expf(-x)); }
DI void store4bf(bf16_t* p, const f32x4& v) { uint2 w; w.x = pack2(v[0], v[1]); w.y = pack2(v[2], v[3]); *(uint2*)p = w; }
DI f32x4 load4bf(const bf16_t* p) { uint2 w = *(const uint2*)p; f32x4 v; v[0] = __uint_as_float(w.x << 16); v[1] = __uint_as_float(w.x & 0xffff0000u); v[2] = __uint_as_float(w.y << 16); v[3] = __uint_as_float(w.y & 0xffff0000u); return v; }

constexpr int BK = 64, HALF = 128, HT = HALF * BK;
DI int lds_byte(int r, int c) { int st = (r >> 4) * 2 + (c >> 5), rr = r & 15, cc = c & 31, ob = rr * 64 + cc * 2; return st * 1024 + (ob ^ (((ob >> 9) & 1) << 5)); }
DI void stage_rc(int b, int& R, int& C) { int st = b / 1024, sb = b % 1024, swz = sb ^ (((sb >> 9) & 1) << 5); R = (st >> 1) * 16 + swz / 64; C = (st & 1) * 32 + (swz % 64) / 2; }

#define FOR_ACC(...) \
  _Pragma("unroll") for (int ai = 0; ai < 2; ++ai) _Pragma("unroll") for (int m = 0; m < 4; ++m) { const int row = brow + ai * 128 + wr * 64 + m * 16 + fr; \
  _Pragma("unroll") for (int bj = 0; bj < 2; ++bj) _Pragma("unroll") for (int n = 0; n < 2; ++n) { const int col = bcol + bj * 128 + wc * 32 + n * 16 + fq * 4; const f32x4 v = acc[ai][bj][m][n]; __VA_ARGS__ } asm volatile("" ::: "memory"); }

template <int lda, int ldb, int K, class Epi>
DI void gemm_tile(const bf16_t* __restrict__ A, const bf16_t* __restrict__ Bt, int brow, int bcol, const Epi& epi) {
  extern __shared__ __attribute__((aligned(16))) unsigned char smem[];
  bf16_t* shm = (bf16_t*)smem;
#define SA(b, h) (shm + ((b) * 2 + (h)) * HT)
#define SB(b, h) (shm + (4 + (b) * 2 + (h)) * HT)
#define STAGE(P, BASE, LD, VO, br, kt) do { const char* _g = (const char*)((BASE) + (long)(br) * (LD) + (long)(kt) * BK); \
    for (int _i = 0; _i < 2; ++_i) { \
      __builtin_amdgcn_global_load_lds((const unsigned*)(_g + VO[_i]), (unsigned*)((char*)(P) + tidx * 16 + _i * 8192), 16, 0, 0); } } while (0)
#define LDA(dst, b, h) for (int m = 0; m < 4; ++m) for (int k = 0; k < 2; ++k) \
    dst[m][k] = *reinterpret_cast<const bf16x8*>((char*)SA(b, h) + lds_byte(wr * 64 + m * 16 + fr, k * 32 + fq * 8))
#define LDB(dst, b, h) for (int n = 0; n < 2; ++n) for (int k = 0; k < 2; ++k) \
    dst[n][k] = *reinterpret_cast<const bf16x8*>((char*)SB(b, h) + lds_byte(wc * 32 + n * 16 + fr, k * 32 + fq * 8))
#define MMA(ai, bj, At, Bf) do { __builtin_amdgcn_s_setprio(1); \
    for (int m = 0; m < 4; ++m) for (int n = 0; n < 2; ++n) for (int k = 0; k < 2; ++k) \
      acc[ai][bj][m][n] = __builtin_amdgcn_mfma_f32_16x16x32_bf16(Bf[n][k], At[m][k], acc[ai][bj][m][n], 0, 0, 0); \
    __builtin_amdgcn_s_setprio(0); } while (0)
#define WAIT_V(n) asm volatile("s_waitcnt vmcnt(" #n ")" ::: "memory")
#define WAIT_L(n) asm volatile("s_waitcnt lgkmcnt(" #n ")" ::: "memory")
#define BAR __builtin_amdgcn_s_barrier()
#define SCHED __builtin_amdgcn_sched_barrier(0)
  int tidx; asm volatile("v_mov_b32 %0, %1" : "=v"(tidx) : "v"(threadIdx.x));
  const int wid = tidx >> 6, lane = tidx & 63, wr = wid >> 2, wc = wid & 3, fr = lane & 15, fq = lane >> 4;
  f32x4 acc[2][2][4][2] = {};
  bf16x8 At[4][2], B0[2][2], B1[2][2];
  const int nt = K / BK;
  unsigned voA[2], voB[2];
  for (int i = 0; i < 2; ++i) { int r_, c_; stage_rc(tidx * 16 + i * 8192, r_, c_); voA[i] = (unsigned)(r_ * lda + c_) * 2u; voB[i] = (unsigned)(r_ * ldb + c_) * 2u; }
  asm volatile("s_waitcnt vmcnt(0) lgkmcnt(0)" ::: "memory");
  __builtin_amdgcn_s_barrier();
  STAGE(SB(0, 0), Bt, ldb, voB, bcol, 0); STAGE(SA(0, 0), A, lda, voA, brow, 0);
  STAGE(SB(0, 1), Bt, ldb, voB, bcol + HALF, 0); STAGE(SA(0, 1), A, lda, voA, brow + HALF, 0);
  if (wr == 1) BAR;
  WAIT_V(4); BAR;
  STAGE(SB(1, 0), Bt, ldb, voB, bcol, 1); STAGE(SA(1, 0), A, lda, voA, brow, 1); STAGE(SB(1, 1), Bt, ldb, voB, bcol + HALF, 1);
  WAIT_V(6); BAR;
  for (int t = 0; t < nt - 2; t += 2) {
    LDB(B0, 0, 0); SCHED; LDA(At, 0, 0); STAGE(SA(1, 1), A, lda, voA, brow + HALF, t + 1);
    WAIT_L(8); BAR; WAIT_L(0); MMA(0, 0, At, B0); BAR; SCHED;
    LDB(B1, 0, 1); STAGE(SB(0, 0), Bt, ldb, voB, bcol, t + 2);
    BAR; WAIT_L(0); MMA(0, 1, At, B1); BAR;
    LDA(At, 0, 1); STAGE(SA(0, 0), A, lda, voA, brow, t + 2);
    BAR; WAIT_L(0); MMA(1, 0, At, B0); BAR; SCHED;
    STAGE(SB(0, 1), Bt, ldb, voB, bcol + HALF, t + 2);
    WAIT_V(6); BAR; MMA(1, 1, At, B1); BAR;
    LDB(B0, 1, 0); SCHED; LDA(At, 1, 0); STAGE(SA(0, 1), A, lda, voA, brow + HALF, t + 2);
    WAIT_L(8); BAR; WAIT_L(0); MMA(0, 0, At, B0); BAR; SCHED;
    LDB(B1, 1, 1); STAGE(SB(1, 0), Bt, ldb, voB, bcol, t + 3);
    BAR; WAIT_L(0); MMA(0, 1, At, B1); BAR;
    LDA(At, 1, 1); STAGE(SA(1, 0), A, lda, voA, brow, t + 3);
    BAR; WAIT_L(0); MMA(1, 0, At, B0); BAR; SCHED;
    STAGE(SB(1, 1), Bt, ldb, voB, bcol + HALF, t + 3);
    WAIT_V(6); BAR; MMA(1, 1, At, B1); BAR;
  }
  { LDB(B0, 0, 0); LDA(At, 0, 0); STAGE(SA(1, 1), A, lda, voA, brow + HALF, nt - 1);
    BAR; WAIT_L(0); MMA(0, 0, At, B0); BAR;
    LDB(B1, 0, 1); BAR; WAIT_L(0); MMA(0, 1, At, B1); BAR;
    LDA(At, 0, 1); WAIT_V(4); BAR; WAIT_L(0); MMA(1, 0, At, B0); MMA(1, 1, At, B1); BAR; }
  { LDB(B0, 1, 0); LDA(At, 1, 0); WAIT_V(2); BAR; WAIT_L(0); MMA(0, 0, At, B0); BAR;
    LDB(B1, 1, 1); WAIT_V(0); BAR; WAIT_L(0); MMA(0, 1, At, B1); BAR;
    LDA(At, 1, 1); BAR; WAIT_L(0); MMA(1, 0, At, B0); MMA(1, 1, At, B1); BAR; }
  if (wr == 0) BAR;
  epi(acc, brow, bcol, wr, wc, fr, fq);
#undef SA
#undef SB
}

DI int vcu_id() { const int G = gridDim.x, bx = blockIdx.x; return (G % 8 == 0) ? (bx % 8) * (G / 8) + bx / 8 : bx; }

typedef const f32x4 (&AccRef)[2][2][4][2];
struct EpiG1 { bf16_t* Z; bf16_t* UA;
  DI void operator()(AccRef acc, int brow, int bcol, int wr, int wc, int fr, int fq) const {
    FOR_ACC(
      if (col < C_SU) { store4bf(Z + (size_t)row * ZLD + col, v); }
      else if (col < ZLD) { const int cc = col - C_SU, g = cc >> 4, i = cc & 15; store4bf(UA + ((size_t)(g * 2048 + (row >> 4)) * 384 + (row & 15) * 16 + i), v); }
    )
  } };
struct EpiBf16 { bf16_t* O; int ldc;
  DI void operator()(AccRef acc, int brow, int bcol, int wr, int wc, int fr, int fq) const {
    FOR_ACC( store4bf(O + (size_t)row * ldc + col, v); )
  } };
struct EpiS5E { float* E;
  DI void operator()(AccRef acc, int brow, int bcol, int wr, int wc, int fr, int fq) const {
    FOR_ACC( if (col < 128) { *(f32x4*)(E + (size_t)row * 128 + col) = v; } )
  } };
DI float gelu_tanh(float x) { const float z = 0.7978845608028654f * (x + 0.044715f * x * x * x); const float t = 1.f - 2.f / (__expf(2.f * z) + 1.f); return 0.5f * x * (1.f + t); }
struct EpiS5Y { bf16_t* Z; int g;
  DI void operator()(AccRef acc, int brow, int bcol, int wr, int wc, int fr, int fq) const {
    FOR_ACC(
      const int j = col >> 4, i = col & 15;
      const size_t t = (size_t)(row >> 9) * 8192 + (size_t)(row & 511) * 16 + j;
      f32x4 o; o[0] = gelu_tanh(v[0]); o[1] = gelu_tanh(v[1]); o[2] = gelu_tanh(v[2]); o[3] = gelu_tanh(v[3]);
      store4bf(Z + t * ZLD + C_SU + g * 16 + i, o);
    )
  } };
struct EpiGLU { bf16_t* Z; const float* bias;
  DI void operator()(AccRef acc, int brow, int bcol, int wr, int wc, int fr, int fq) const {
    FOR_ACC(
      const f32x4 y = load4bf(Z + (size_t)row * ZLD + C_SU + col);
      const f32x4 b = *(const f32x4*)(bias + col);
      f32x4 o; for (int q = 0; q < 4; ++q) o[q] = y[q] * sigmoidf_(v[q] + b[q]);
      store4bf(Z + (size_t)row * ZLD + C_GR + col, o);
    )
  } };
struct EpiScr { uint2* scr;
  DI void operator()(AccRef acc, int brow, int bcol, int wr, int wc, int fr, int fq) const {
    FOR_ACC( uint2 w; w.x = pack2(v[0], v[1]); w.y = pack2(v[2], v[3]); scr[(((ai * 2 + bj) * 4 + m) * 2 + n) * NTHR + threadIdx.x] = w; )
  } };
struct EpiGate { const uint2* scr; bf16_t* M; const float* gb; int br;
  DI void operator()(AccRef acc, int brow, int bcol, int wr, int wc, int fr, int fq) const {
    FOR_ACC(
      const uint2 w = scr[(((ai * 2 + bj) * 4 + m) * 2 + n) * NTHR + threadIdx.x];
      f32x4 p; p[0] = __uint_as_float(w.x << 16); p[1] = __uint_as_float(w.x & 0xffff0000u); p[2] = __uint_as_float(w.y << 16); p[3] = __uint_as_float(w.y & 0xffff0000u);
      const f32x4 b = *(const f32x4*)(gb + col);
      bf16_t* dst = M + (size_t)row * 1024 + col;
      f32x4 o = {0.f, 0.f, 0.f, 0.f};
      if (br > 0) o = load4bf(dst);
      for (int q = 0; q < 4; ++q) o[q] += sigmoidf_(v[q] + b[q]) * p[q];
      store4bf(dst, o);
    )
  } };
struct EpiP2 { int kind; bf16_t* O; int ldc; float* E;
  DI void operator()(AccRef acc, int brow, int bcol, int wr, int wc, int fr, int fq) const {
    if (kind == 0) { FOR_ACC( store4bf(O + (size_t)row * ldc + col, v); ) }
    else { FOR_ACC( if (col < 128) { *(f32x4*)(E + (size_t)row * 128 + col) = v; } ) }
  } };
struct EpiP6 { int kind; uint2* scr; bf16_t* M; const float* gb; int br;
  DI void operator()(AccRef acc, int brow, int bcol, int wr, int wc, int fr, int fq) const {
    uint2* sl = scr + (((wr * 4 + wc) * 4 + fq) * 16 + fr);
    if (kind == 0) { FOR_ACC( uint2 w; w.x = pack2(v[0], v[1]); w.y = pack2(v[2], v[3]); sl[(((ai * 2 + bj) * 4 + m) * 2 + n) * NTHR] = w; ) }
    else {
      FOR_ACC(
        const uint2 w = sl[(((ai * 2 + bj) * 4 + m) * 2 + n) * NTHR];
        f32x4 p; p[0] = __uint_as_float(w.x << 16); p[1] = __uint_as_float(w.x & 0xffff0000u); p[2] = __uint_as_float(w.y << 16); p[3] = __uint_as_float(w.y & 0xffff0000u);
        const f32x4 b = *(const f32x4*)(gb + col);
        bf16_t* dst = M + (size_t)row * 1024 + col;
        f32x4 o = {0.f, 0.f, 0.f, 0.f};
        if (br > 0) o = load4bf(dst);
        for (int q = 0; q < 4; ++q) o[q] += sigmoidf_(v[q] + b[q]) * p[q];
        store4bf(dst, o);
      )
    }
  } };
struct EpiResid { const float* src; float* dst;
  DI void operator()(AccRef acc, int brow, int bcol, int wr, int wc, int fr, int fq) const {
    FOR_ACC(
      const f32x4 x = *(const f32x4*)(src + (size_t)row * 1024 + col);
      *(f32x4*)(dst + (size_t)row * 1024 + col) = x + v;
    )
  } };
struct EpiRelu2 { bf16_t* O;
  DI void operator()(AccRef acc, int brow, int bcol, int wr, int wc, int fr, int fq) const {
    FOR_ACC( f32x4 o; for (int q = 0; q < 4; ++q) { const float r = fmaxf(v[q], 0.f); o[q] = r * r; } store4bf(O + (size_t)row * DFF + col, o); )
  } };

DI void rmsnorm_rows(const float* __restrict__ src, const float* __restrict__ g, bf16_t* __restrict__ dst) {
  const int wave = threadIdx.x >> 6, lane = threadIdx.x & 63;
  f32x4 gv[4];
#pragma unroll
  for (int i = 0; i < 4; ++i) gv[i] = *(const f32x4*)(g + lane * 4 + 256 * i);
  for (int row = blockIdx.x * 8 + wave; row < T_; row += gridDim.x * 8) {
    f32x4 x[4]; float ss = 0.f;
#pragma unroll
    for (int i = 0; i < 4; ++i) { x[i] = *(const f32x4*)(src + (size_t)row * 1024 + lane * 4 + 256 * i); ss += x[i][0] * x[i][0] + x[i][1] * x[i][1] + x[i][2] * x[i][2] + x[i][3] * x[i][3]; }
    ss = wave_sum(ss);
    const float rs = rsqrtf(ss * (1.f / 1024.f) + EPS);
#pragma unroll
    for (int i = 0; i < 4; ++i) { f32x4 o = x[i] * rs * gv[i]; store4bf(dst + (size_t)row * 1024 + lane * 4 + 256 * i, o); }
  }
}

DI void xpose_cvt(const float* __restrict__ src, int Kd, int Nd, bf16_t* __restrict__ dst, const float* __restrict__ gs) {
  extern __shared__ __attribute__((aligned(16))) unsigned char smem[];
  float* tile = (float*)smem;
  const int tk = Kd / 64, tn = (Nd + 63) / 64, ntile = tk * tn;
  const int tid = threadIdx.x, c = tid & 63, r0 = tid >> 6;
  for (int tix = blockIdx.x; tix < ntile; tix += gridDim.x) {
    const int k0 = (tix % tk) * 64, n0 = (tix / tk) * 64;
    __syncthreads();
#pragma unroll
    for (int i = 0; i < 8; ++i) { const int r = r0 + 8 * i; const int n = n0 + c; tile[r * 65 + c] = (n < Nd) ? src[(size_t)(k0 + r) * Nd + n] : 0.f; }
    __syncthreads();
    const float sc = gs ? gs[k0 + c] : 1.f;
#pragma unroll
    for (int i = 0; i < 8; ++i) { const int r = r0 + 8 * i; const int n = n0 + r; if (n < Nd) dst[(size_t)n * Kd + k0 + c] = f2bf(tile[c * 65 + r] * sc); }
  }
}

DI void s5_mats(const Ctx& c) {
  extern __shared__ __attribute__((aligned(16))) unsigned char smem[];
  float* lp_re = (float*)smem;
  float* lp_im = lp_re + 17 * 64;
  float* bb_re = lp_im + 17 * 64;
  float* bb_im = bb_re + 1024;
  float* cr = bb_im + 1024;
  float* ci = cr + 1024;
  float* Kt = ci + 1024;
  float* dv = Kt + 4096;
  const int tid = threadIdx.x;
  bf16_t* ME = (bf16_t*)(c.ws + OFF_MATS);
  bf16_t* MY = (bf16_t*)(c.ws + OFF_MY);
  for (int g = blockIdx.x; g < 32; g += gridDim.x) {
    __syncthreads();
    if (tid < 64) {
      const int p = tid;
      const float lre = fminf(c.inp(12, 2048)[g * 64 + p], -1e-4f), lim = c.inp(13, 2048)[g * 64 + p];
      const float step = expf(c.inp(19, 32)[g]);
      for (int d = 0; d <= 16; ++d) { const float mag = expf(lre * step * d); float s, co; sincosf(lim * step * d, &s, &co); lp_re[d * 64 + p] = mag * co; lp_im[d * 64 + p] = mag * s; }
      const float nr = lp_re[64 + p] - 1.f, ni = lp_im[64 + p];
      const float den = 1.f / (lre * lre + lim * lim);
      const float kr = (nr * lre + ni * lim) * den, ki = (ni * lre - nr * lim) * den;
      for (int i = 0; i < 16; ++i) { const float br = c.inp(14, 32768)[(g * 64 + p) * 16 + i], bi = c.inp(15, 32768)[(g * 64 + p) * 16 + i]; bb_re[p * 16 + i] = kr * br - ki * bi; bb_im[p * 16 + i] = kr * bi + ki * br; }
    }
    for (int i = tid; i < 1024; i += NTHR) { cr[i] = c.inp(16, 32768)[g * 1024 + i]; ci[i] = c.inp(17, 32768)[g * 1024 + i]; }
    if (tid < 16) dv[tid] = c.inp(18, 512)[g * 16 + tid];
    __syncthreads();
    for (int idx = tid; idx < 4096; idx += NTHR) {
      const int d = idx >> 8, i = (idx >> 4) & 15, i2 = idx & 15; float s = 0.f;
      for (int p = 0; p < 64; ++p) { const float lr = lp_re[d * 64 + p], li = lp_im[d * 64 + p], br = bb_re[p * 16 + i2], bi = bb_im[p * 16 + i2];
        const float wre = lr * br - li * bi, wim = lr * bi + li * br; s += cr[i * 64 + p] * wre - ci[i * 64 + p] * wim; }
      Kt[idx] = s;
    }
    __syncthreads();
    for (int idx = tid; idx < 256 * 384; idx += NTHR) {
      const int n = idx / 384, k = idx % 384, j = n >> 4, i = n & 15; float val;
      if (k < 256) { const int j2 = k >> 4, i2 = k & 15; val = (j >= j2) ? Kt[((j - j2) * 16 + i) * 16 + i2] + ((j == j2 && i == i2) ? dv[i] : 0.f) : 0.f; }
      else if (k < 320) { const int p = k - 256; val = cr[i * 64 + p] * lp_re[(j + 1) * 64 + p] - ci[i * 64 + p] * lp_im[(j + 1) * 64 + p]; }
      else { const int p = k - 320; val = -(cr[i * 64 + p] * lp_im[(j + 1) * 64 + p] + ci[i * 64 + p] * lp_re[(j + 1) * 64 + p]); }
      MY[(size_t)g * 256 * 384 + idx] = f2bf(val);
    }
    for (int idx = tid; idx < 256 * 256; idx += NTHR) {
      const int n = idx >> 8, k = idx & 255, j2 = k >> 4, i2 = k & 15; float val = 0.f;
      if (n < 128) { const int p = n & 63; const float lr = lp_re[(15 - j2) * 64 + p], li = lp_im[(15 - j2) * 64 + p], br = bb_re[p * 16 + i2], bi = bb_im[p * 16 + i2];
        val = (n < 64) ? (lr * br - li * bi) : (lr * bi + li * br); }
      ME[(size_t)g * 65536 + idx] = f2bf(val);
    }
  }
}

DI void rope_table(const Ctx& c) {
  float* cs = (float*)(c.ws + OFF_ROPE); float* sn = cs + 8192 * 16;
  for (int idx = blockIdx.x * NTHR + threadIdx.x; idx < 8192 * 16; idx += gridDim.x * NTHR) {
    const int pos = idx >> 4, i = idx & 15;
    const float invf = powf(10000.f, -(float)(2 * i) / 32.f);
    const float ang = (float)pos * invf;
    cs[idx] = (float)cos((double)ang); sn[idx] = (float)sin((double)ang);
  }
}

DI void unpack8(const uint4& w, float* f) {
  f[0] = __uint_as_float(w.x << 16); f[1] = __uint_as_float(w.x & 0xffff0000u); f[2] = __uint_as_float(w.y << 16); f[3] = __uint_as_float(w.y & 0xffff0000u);
  f[4] = __uint_as_float(w.z << 16); f[5] = __uint_as_float(w.z & 0xffff0000u); f[6] = __uint_as_float(w.w << 16); f[7] = __uint_as_float(w.w & 0xffff0000u);
}
DI void gla_bc(const Ctx& c, const bf16_t* Z, int t0, int h, int tid, float* glr_s, float* wg_s, float* bc_s) {
  const float* wg = c.inp(9, 16 * 256); const float* bg = c.inp(10, 256);
  if (tid < 128) { const int cc = tid >> 1, r0 = (tid & 1) * 8; const uint4 w = *(const uint4*)(Z + (size_t)(t0 + cc) * ZLD + C_GLR + r0); float f[8]; unpack8(w, f);
#pragma unroll
    for (int i = 0; i < 8; ++i) glr_s[cc * 16 + r0 + i] = f[i]; }
  for (int idx = tid; idx < 1024; idx += NTHR) wg_s[idx] = wg[(idx >> 6) * 256 + h * 64 + (idx & 63)];
  __syncthreads();
  const int d = tid & 63, seg = tid >> 6;
  const float bgv = bg[h * 64 + d];
  float wv[16];
#pragma unroll
  for (int r = 0; r < 16; ++r) wv[r] = wg_s[r * 64 + d];
  float run = 0.f, loc[8];
#pragma unroll
  for (int i = 0; i < 8; ++i) {
    const int cc = seg * 8 + i; float a = bgv;
#pragma unroll
    for (int r = 0; r < 16; ++r) a += glr_s[cc * 16 + r] * wv[r];
    run += (fminf(a, 0.f) - __logf(1.f + __expf(-fabsf(a)))) * (1.f / 16.f);
    loc[i] = run;
  }
  __syncthreads();
  glr_s[seg * 64 + d] = run;
  __syncthreads();
  float off = 0.f;
  for (int s2 = 0; s2 < seg; ++s2) off += glr_s[s2 * 64 + d];
#pragma unroll
  for (int i = 0; i < 8; ++i) bc_s[(seg * 8 + i) * 64 + d] = loc[i] + off;
  __syncthreads();
}

DI void gla_pass1(const Ctx& c, int unit) {
  extern __shared__ __attribute__((aligned(16))) unsigned char smem[];
  float* glr_s = (float*)smem; float* wg_s = glr_s + 1024; float* bc_s = wg_s + 1024; float* ke_s = bc_s + 4096; float* v_s = ke_s + 4096;
  const bf16_t* Z = (const bf16_t*)(c.ws + OFF_Z);
  int tid_; asm volatile("v_mov_b32 %0, %1" : "=v"(tid_) : "v"(threadIdx.x));
  const int tid = tid_, n = unit & 127, bh = unit >> 7, h = bh & 3, b = bh >> 2, t0 = b * L_ + n * 64;
  __syncthreads();
  gla_bc(c, Z, t0, h, tid, glr_s, wg_s, bc_s);
  { const int cc = tid >> 3, d0 = (tid & 7) * 8; const uint4 w = *(const uint4*)(Z + (size_t)(t0 + cc) * ZLD + C_GK + h * 64 + d0); float f[8]; unpack8(w, f);
#pragma unroll
    for (int i = 0; i < 8; ++i) ke_s[cc * 64 + d0 + i] = f[i] * __expf(bc_s[63 * 64 + d0 + i] - bc_s[cc * 64 + d0 + i]); }
#pragma unroll
  for (int k = 0; k < 2; ++k) { const int idx8 = tid + k * NTHR, cc = idx8 >> 4, e0 = (idx8 & 15) * 8; const uint4 w = *(const uint4*)(Z + (size_t)(t0 + cc) * ZLD + C_GV + h * 128 + e0); float f[8]; unpack8(w, f);
#pragma unroll
    for (int i = 0; i < 8; ++i) v_s[cc * 128 + e0 + i] = f[i]; }
  __syncthreads();
  const int e = tid & 127, d0 = (tid >> 7) * 16;
  float a[16];
#pragma unroll
  for (int i = 0; i < 16; ++i) a[i] = 0.f;
  for (int cc = 0; cc < 64; ++cc) {
    const float vv = v_s[cc * 128 + e];
#pragma unroll
    for (int i = 0; i < 16; ++i) a[i] += vv * ke_s[cc * 64 + d0 + i];
  }
  bf16_t* GS = (bf16_t*)(c.ws + OFF_GS) + (size_t)unit * 8192;
#pragma unroll
  for (int i = 0; i < 16; ++i) GS[(d0 + i) * 128 + e] = f2bf(a[i]);
  if (tid < 64) ((float*)(c.ws + OFF_GDEC))[unit * 64 + tid] = __expf(bc_s[63 * 64 + tid]);
}

DI void gla_scan(const Ctx& c) {
  bf16_t* GS = (bf16_t*)(c.ws + OFF_GS); const float* dec = (const float*)(c.ws + OFF_GDEC);
  for (int idx = blockIdx.x * NTHR + threadIdx.x; idx < 16 * 8192; idx += gridDim.x * NTHR) {
    const int bh = idx >> 13, ed = idx & 8191, d = ed >> 7;
    float S = 0.f;
    bf16_t* p = GS + (size_t)bh * 128 * 8192 + ed; const float* dp = dec + bh * 128 * 64 + d;
#pragma unroll 8
    for (int n = 0; n < 128; ++n) { const float ds = bf2f(p[(size_t)n * 8192]); const float dc = dp[n * 64]; p[(size_t)n * 8192] = f2bf(S); S = dc * S + ds; }
  }
}

DI void gla_pass3(const Ctx& c, int unit) {
  extern __shared__ __attribute__((aligned(16))) unsigned char smem[];
  float* glr_s = (float*)smem; float* wg_s = glr_s + 1024; float* bc_s = wg_s + 1024;
  float* A_s = (float*)smem;
  float* qt_s = (float*)smem + 6144;
  float* kt_s = qt_s + 4160;
  float* v_s = kt_s + 4096;
  float* S_s = v_s + 8192;
  float* red_s = S_s + 8192;
  bf16_t* Z = (bf16_t*)(c.ws + OFF_Z);
  int tid_; asm volatile("v_mov_b32 %0, %1" : "=v"(tid_) : "v"(threadIdx.x));
  const int tid = tid_, n = unit & 127, bh = unit >> 7, h = bh & 3, b = bh >> 2, t0 = b * L_ + n * 64;
  __syncthreads();
  gla_bc(c, Z, t0, h, tid, glr_s, wg_s, bc_s);
  { const int cr = tid >> 3, d0 = (tid & 7) * 8;
    const uint4 wq = *(const uint4*)(Z + (size_t)(t0 + cr) * ZLD + C_GQ + h * 64 + d0), wk = *(const uint4*)(Z + (size_t)(t0 + cr) * ZLD + C_GK + h * 64 + d0);
    float fq_[8], fk_[8]; unpack8(wq, fq_); unpack8(wk, fk_);
#pragma unroll
    for (int i = 0; i < 8; ++i) { const float bcv = bc_s[cr * 64 + d0 + i]; const float ex = __expf(bcv); qt_s[cr * 65 + d0 + i] = fq_[i] * 0.125f * ex; kt_s[cr * 64 + d0 + i] = fk_[i] * __builtin_amdgcn_rcpf(ex); } }
  const bf16_t* GS = (const bf16_t*)(c.ws + OFF_GS) + (size_t)unit * 8192;
#pragma unroll
  for (int k = 0; k < 2; ++k) { const int idx8 = tid + k * NTHR, cr = idx8 >> 4, e0 = (idx8 & 15) * 8;
    const uint4 wv = *(const uint4*)(Z + (size_t)(t0 + cr) * ZLD + C_GV + h * 128 + e0), wS = *(const uint4*)(GS + idx8 * 8);
    float fv[8], fs[8]; unpack8(wv, fv); unpack8(wS, fs);
#pragma unroll
    for (int i = 0; i < 8; ++i) { v_s[cr * 128 + e0 + i] = fv[i]; S_s[idx8 * 8 + i] = fs[i]; } }
  __syncthreads();
  const int cc = tid & 63, wg8 = tid >> 6;
  {
    float a[8];
#pragma unroll
    for (int i = 0; i < 8; ++i) a[i] = 0.f;
    for (int d = 0; d < 64; ++d) { const float qv = qt_s[cc * 65 + d];
#pragma unroll
      for (int i = 0; i < 8; ++i) a[i] += qv * kt_s[(wg8 * 8 + i) * 64 + d]; }
#pragma unroll
    for (int i = 0; i < 8; ++i) { const int s = wg8 * 8 + i; A_s[cc * 65 + s] = (s <= cc) ? a[i] : 0.f; }
  }
  __syncthreads();
  const int e0 = wg8 * 16;
  float o[16];
#pragma unroll
  for (int i = 0; i < 16; ++i) o[i] = 0.f;
  for (int s = 0; s < 64; ++s) { const float av = A_s[cc * 65 + s];
#pragma unroll
    for (int i = 0; i < 16; ++i) o[i] += av * v_s[s * 128 + e0 + i]; }
  for (int d = 0; d < 64; ++d) { const float qv = qt_s[cc * 65 + d];
#pragma unroll
    for (int i = 0; i < 16; ++i) o[i] += qv * S_s[d * 128 + e0 + i]; }
  float ss = 0.f;
#pragma unroll
  for (int i = 0; i < 16; ++i) ss += o[i] * o[i];
  red_s[wg8 * 64 + cc] = ss;
  __syncthreads();
  float tot = 0.f;
#pragma unroll
  for (int i = 0; i < 8; ++i) tot += red_s[i * 64 + cc];
  const float rinv = rsqrtf(tot * (1.f / 128.f) + EPS);
  const float* og = c.inp(11, 128);
  const bf16_t* rp = Z + (size_t)(t0 + cc) * ZLD + C_GR + h * 128 + e0;
  bf16_t* op = Z + (size_t)(t0 + cc) * ZLD + C_GV + h * 128 + e0;
#pragma unroll
  for (int q = 0; q < 4; ++q) {
    const f32x4 r = load4bf(rp + q * 4); f32x4 w;
#pragma unroll
    for (int i = 0; i < 4; ++i) { const float rv = r[i]; w[i] = o[q * 4 + i] * rinv * og[e0 + q * 4 + i] * (rv / (1.f + __expf(-rv))); }
    store4bf(op + q * 4, w);
  }
}

DI void s5_scan(const Ctx& c) {
  extern __shared__ __attribute__((aligned(16))) unsigned char smem[];
  float* end_s = (float*)smem;
  const float* E = (const float*)(c.ws + OFF_EOA); bf16_t* UA = (bf16_t*)(c.ws + OFF_UA);
  const int tid = threadIdx.x, p = tid & 63, seg = tid >> 6, g = blockIdx.x >> 2, b = blockIdx.x & 3;
  const float lre = fminf(c.inp(12, 2048)[g * 64 + p], -1e-4f), lim = c.inp(13, 2048)[g * 64 + p];
  const float step = expf(c.inp(19, 32)[g]);
  const float mag = expf(lre * step * 16.f); float sn, cs; sincosf(lim * step * 16.f, &sn, &cs);
  const float ar = mag * cs, ai = mag * sn;
  const size_t row0 = (size_t)g * 2048 + (size_t)b * 512 + (size_t)seg * 64;
  float sr = 0.f, si = 0.f;
#pragma unroll 16
  for (int ch = 0; ch < 64; ++ch) {
    const float er = E[(row0 + ch) * 128 + p], ei = E[(row0 + ch) * 128 + 64 + p];
    const float nr = ar * sr - ai * si + er, ni = ar * si + ai * sr + ei; sr = nr; si = ni;
  }
  __syncthreads();
  end_s[(seg * 64 + p) * 2] = sr; end_s[(seg * 64 + p) * 2 + 1] = si;
  __syncthreads();
  float a64r = ar, a64i = ai;
#pragma unroll
  for (int q = 0; q < 6; ++q) { const float nr = a64r * a64r - a64i * a64i, ni = 2.f * a64r * a64i; a64r = nr; a64i = ni; }
  sr = 0.f; si = 0.f;
  for (int s2 = 0; s2 < seg; ++s2) { const float er = end_s[(s2 * 64 + p) * 2], ei = end_s[(s2 * 64 + p) * 2 + 1]; const float nr = a64r * sr - a64i * si + er, ni = a64r * si + a64i * sr + ei; sr = nr; si = ni; }
#pragma unroll 16
  for (int ch = 0; ch < 64; ++ch) {
    const float er = E[(row0 + ch) * 128 + p], ei = E[(row0 + ch) * 128 + 64 + p];
    UA[(row0 + ch) * 384 + 256 + p] = f2bf(sr); UA[(row0 + ch) * 384 + 320 + p] = f2bf(si);
    const float nr = ar * sr - ai * si + er, ni = ar * si + ai * sr + ei; sr = nr; si = ni;
  }
  __syncthreads();
}

DI void mla_finalize_unit(const Ctx& c, int unit) {
  const int wave = threadIdx.x >> 6, lane = threadIdx.x & 63;
  const bf16_t* Z = (const bf16_t*)(c.ws + OFF_Z);
  bf16_t* Q = (bf16_t*)(c.ws + OFF_QRAW); bf16_t* KV = (bf16_t*)(c.ws + OFF_KVRAW); bf16_t* KP = (bf16_t*)(c.ws + OFF_KPE2);
  const float* cs = (const float*)(c.ws + OFF_ROPE); const float* sn = cs + 8192 * 16;
  const float* qg = c.inp(7, 96); const float* kg = c.inp(8, 96);
  const float qg0 = qg[lane], qg1 = qg[64 + (lane & 31)], kg0 = kg[lane], kg1 = kg[64 + (lane & 31)];
  const float qscale = 0.10206207261596575f * 1.4426950408889634f;
  for (int ti = 0; ti < 8; ++ti) {
    const int t = unit * 64 + wave * 8 + ti;
    const int pos = t & (L_ - 1);
    float cqv[6], ckv[4], a0[8], a1[8], k0[8], vv[8];
    const bf16_t* zr = Z + (size_t)t * ZLD; const bf16_t* qr = Q + (size_t)t * 768; const bf16_t* kr = KV + (size_t)t * 1024;
#pragma unroll
    for (int i = 0; i < 6; ++i) cqv[i] = bf2f(zr[C_CQ + lane + 64 * i]);
#pragma unroll
    for (int i = 0; i < 4; ++i) ckv[i] = bf2f(zr[C_CKV + lane + 64 * i]);
    const float kpe = (lane < 32) ? bf2f(zr[C_KPE + lane]) : 0.f;
#pragma unroll
    for (int h = 0; h < 8; ++h) { a0[h] = bf2f(qr[h * 96 + lane]); a1[h] = (lane < 32) ? bf2f(qr[h * 96 + 64 + lane]) : 0.f; k0[h] = bf2f(kr[h * 128 + lane]); vv[h] = bf2f(kr[h * 128 + 64 + lane]); }
    const float cv = cs[pos * 16 + (lane & 15)], sv = sn[pos * 16 + (lane & 15)];
    float ss = 0.f;
#pragma unroll
    for (int i = 0; i < 6; ++i) ss += cqv[i] * cqv[i];
    const float rsq = rsqrtf(wave_sum(ss) * (1.f / 384.f) + EPS);
    ss = 0.f;
#pragma unroll
    for (int i = 0; i < 4; ++i) ss += ckv[i] * ckv[i];
    const float rskv = rsqrtf(wave_sum(ss) * (1.f / 256.f) + EPS);
#pragma unroll
    for (int h = 0; h < 8; ++h) {
      const float x0 = a0[h] * rsq, x1 = a1[h] * rsq;
      const float rq = rsqrtf(wave_sum(x0 * x0 + x1 * x1) * (1.f / 96.f) + EPS);
      a0[h] = x0 * rq * qg0 * qscale;
      float n1 = x1 * rq * qg1;
      { const float oth = __shfl_xor(n1, 16); n1 = (lane < 16) ? (n1 * cv - oth * sv) : (oth * sv + n1 * cv); }
      a1[h] = n1 * qscale;
      const float y0 = k0[h] * rskv;
      const float rk = rsqrtf(wave_sum(y0 * y0 + kpe * kpe) * (1.f / 96.f) + EPS);
      k0[h] = y0 * rk * kg0;
      float p1 = kpe * rk * kg1;
      { const float oth = __shfl_xor(p1, 16); p1 = (lane < 16) ? (p1 * cv - oth * sv) : (oth * sv + p1 * cv); }
      cqv[0] = p1;
      vv[h] = vv[h] * rskv;
      bf16_t* qp = Q + (size_t)t * 768 + h * 96; bf16_t* kp = KV + (size_t)t * 1024 + h * 128;
      qp[lane] = f2bf(a0[h]);
      if (lane < 32) { qp[64 + lane] = f2bf(a1[h]); KP[((size_t)t * 8 + h) * 32 + lane] = f2bf(p1); }
      kp[lane] = f2bf(k0[h]); kp[64 + lane] = f2bf(vv[h]);
    }
  }
}

constexpr int KSTR = 104, VSTR = 72;
constexpr int KS_BYTES = 64 * KSTR * 2, VT_BYTES = 64 * VSTR * 2;
DI bf16x8 pack8(const f32x16& x, int s) {
  union { unsigned u[4]; bf16x8 v; } r;
  r.u[0] = pack2(x[8 * s + 0], x[8 * s + 1]); r.u[1] = pack2(x[8 * s + 2], x[8 * s + 3]); r.u[2] = pack2(x[8 * s + 4], x[8 * s + 5]); r.u[3] = pack2(x[8 * s + 6], x[8 * s + 7]);
  return r.v;
}
DI void attn_unit(const Ctx& c, int unit) {
  extern __shared__ __attribute__((aligned(16))) unsigned char smem[];
  int tid_; asm volatile("v_mov_b32 %0, %1" : "=v"(tid_) : "v"(threadIdx.x));
  const int tid = tid_, wave = tid >> 6, lane = tid & 63, l32 = lane & 31, hb = lane >> 5;
  const int qb = 31 - (unit >> 5), bh = unit & 31, b = bh >> 3, h = bh & 7;
  const size_t tb = (size_t)b * L_;
  const bf16_t* Q = (const bf16_t*)(c.ws + OFF_QRAW); const bf16_t* KV = (const bf16_t*)(c.ws + OFF_KVRAW); const bf16_t* KP = (const bf16_t*)(c.ws + OFF_KPE2);
  bf16_t* OA = (bf16_t*)(c.ws + OFF_EOA);
  const int q0 = qb * 256, qw0 = q0 + wave * 32;
  bf16x8 qf[6];
#pragma unroll
  for (int s = 0; s < 6; ++s) qf[s] = *(const bf16x8*)(Q + (tb + qw0 + l32) * 768 + h * 96 + s * 16 + hb * 8);
  f32x16 ot[2];
#pragma unroll
  for (int i = 0; i < 16; ++i) { ot[0][i] = 0.f; ot[1][i] = 0.f; }
  float mrun = -1e30f, lrun = 0.f;
  const int nkt = (q0 + 256) / 64;
  const int kn_row = tid >> 3, kn_ch = tid & 7, kp_row = tid >> 2, kp_ch = tid & 3, v_key = tid & 63, v_ch = tid >> 6;
  uint4 rkn, rkp = {0, 0, 0, 0}, rv;
  auto gload = [&](int k0) {
    rkn = *(const uint4*)(KV + (tb + k0 + kn_row) * 1024 + h * 128 + kn_ch * 8);
    if (tid < 256) rkp = *(const uint4*)(KP + ((tb + k0 + kp_row) * 8 + h) * 32 + kp_ch * 8);
    rv = *(const uint4*)(KV + (tb + k0 + v_key) * 1024 + h * 128 + 64 + v_ch * 8);
  };
  auto lstore = [&](int buf) {
    unsigned char* ks = smem + buf * KS_BYTES; bf16_t* vt = (bf16_t*)(smem + 2 * KS_BYTES + buf * VT_BYTES);
    *(uint4*)(ks + (kn_row * KSTR + kn_ch * 8) * 2) = rkn;
    if (tid < 256) *(uint4*)(ks + (kp_row * KSTR + 64 + kp_ch * 8) * 2) = rkp;
    const unsigned w[4] = {rv.x, rv.y, rv.z, rv.w};
#pragma unroll
    for (int i = 0; i < 4; ++i) { vt[(v_ch * 8 + 2 * i) * VSTR + v_key] = (bf16_t)(w[i] & 0xffffu); vt[(v_ch * 8 + 2 * i + 1) * VSTR + v_key] = (bf16_t)(w[i] >> 16); }
  };
  __syncthreads();
  gload(0); lstore(0);
  __syncthreads();
  for (int kt = 0; kt < nkt; ++kt) {
    const int k0 = kt * 64, buf = kt & 1;
    if (kt + 1 < nkt) gload(k0 + 64);
    if (k0 <= qw0 + 31) {
      const unsigned char* ks = smem + buf * KS_BYTES; const bf16_t* vt = (const bf16_t*)(smem + 2 * KS_BYTES + buf * VT_BYTES);
      f32x16 st[2];
#pragma unroll
      for (int i = 0; i < 16; ++i) { st[0][i] = 0.f; st[1][i] = 0.f; }
#pragma unroll
      for (int ksub = 0; ksub < 2; ++ksub)
#pragma unroll
        for (int s = 0; s < 6; ++s) {
          const bf16x8 a = *(const bf16x8*)(ks + ((ksub * 32 + l32) * KSTR + s * 16 + hb * 8) * 2);
          st[ksub] = __builtin_amdgcn_mfma_f32_32x32x16_bf16(a, qf[s], st[ksub], 0, 0, 0);
        }
      if (k0 + 63 > qw0) {
        const int qpos = qw0 + l32;
#pragma unroll
        for (int ksub = 0; ksub < 2; ++ksub)
#pragma unroll
          for (int r = 0; r < 16; ++r) { const int key = k0 + ksub * 32 + (r & 3) + 8 * (r >> 2) + 4 * hb; if (key > qpos) st[ksub][r] = -1e30f; }
      }
      float mx = -1e30f;
#pragma unroll
      for (int r = 0; r < 16; ++r) mx = fmaxf(mx, fmaxf(st[0][r], st[1][r]));
      mx = fmaxf(mx, __shfl_xor(mx, 32));
      const float mnew = fmaxf(mrun, mx);
      const float alpha = __builtin_amdgcn_exp2f(mrun - mnew);
      float rs = 0.f;
#pragma unroll
      for (int r = 0; r < 16; ++r) { st[0][r] = __builtin_amdgcn_exp2f(st[0][r] - mnew); st[1][r] = __builtin_amdgcn_exp2f(st[1][r] - mnew); rs += st[0][r] + st[1][r]; }
      rs += __shfl_xor(rs, 32);
      lrun = lrun * alpha + rs; mrun = mnew;
#pragma unroll
      for (int i = 0; i < 16; ++i) { ot[0][i] *= alpha; ot[1][i] *= alpha; }
#pragma unroll
      for (int ksub = 0; ksub < 2; ++ksub)
#pragma unroll
        for (int s2 = 0; s2 < 2; ++s2) {
          const bf16x8 pf = pack8(st[ksub], s2);
#pragma unroll
          for (int dt = 0; dt < 2; ++dt) {
            const bf16_t* vp = vt + (dt * 32 + l32) * VSTR + ksub * 32 + 16 * s2 + 4 * hb;
            const s16x4 lo = *(const s16x4*)vp, hi = *(const s16x4*)(vp + 8);
            const bf16x8 a = __builtin_shufflevector(lo, hi, 0, 1, 2, 3, 4, 5, 6, 7);
            ot[dt] = __builtin_amdgcn_mfma_f32_32x32x16_bf16(a, pf, ot[dt], 0, 0, 0);
          }
        }
    }
    if (kt + 1 < nkt) lstore(buf ^ 1);
    __syncthreads();
  }
  const float inv = 1.f / lrun;
  bf16_t* op = OA + (tb + qw0 + l32) * 512 + h * 64;
#pragma unroll
  for (int dt = 0; dt < 2; ++dt)
#pragma unroll
    for (int g4 = 0; g4 < 4; ++g4) {
      f32x4 v; v[0] = ot[dt][g4 * 4 + 0] * inv; v[1] = ot[dt][g4 * 4 + 1] * inv; v[2] = ot[dt][g4 * 4 + 2] * inv; v[3] = ot[dt][g4 * 4 + 3] * inv;
      store4bf(op + dt * 32 + 8 * g4 + 4 * hb, v);
    }
}

constexpr int N_PH_LAYER = 11;
DI int next_unit(unsigned* ctr) {
  extern __shared__ __attribute__((aligned(16))) unsigned char smem[];
  volatile int* su = (volatile int*)(smem + LDS_UNIT_OFF);
  __syncthreads();
  if (threadIdx.x == 0) *su = (int)atomicAdd(ctr, 1u);
  __syncthreads();
  return *su;
}

DI void run_phase(const Ctx& c, int k) {
  unsigned char* ws = c.ws;
  bf16_t* Z = (bf16_t*)(ws + OFF_Z); bf16_t* H = (bf16_t*)(ws + OFF_H); bf16_t* W = (bf16_t*)(ws + OFF_W); bf16_t* UA = (bf16_t*)(ws + OFF_UA);
  const int G = gridDim.x, vcu = vcu_id();
  const float* xsrc = (c.layer == 0) ? c.in[0] : c.out;
  switch (k) {
    case 0: {
      rmsnorm_rows(xsrc, c.inp(1, 1024), H);
      if (c.layer == 0) rope_table(c);
      s5_mats(c);
      xpose_cvt(c.inp(2, (size_t)1024 * DIN), 1024, DIN, W + W_IN, nullptr);
      xpose_cvt(c.inp(4, 384 * 768), 384, 768, W + W_UQ, c.inp(3, 384));
      xpose_cvt(c.inp(6, 256 * 1024), 256, 1024, W + W_UKV, c.inp(5, 256));
      xpose_cvt(c.inp(20, 512 * 512), 512, 512, W + W_GLU, nullptr);
      xpose_cvt(c.inp(22, 512 * 1024), 512, 1024, W + W_BR, nullptr);
      xpose_cvt(c.inp(23, 512 * 1024), 512, 1024, W + W_BR + 1024 * 512, nullptr);
      xpose_cvt(c.inp(24, 512 * 1024), 512, 1024, W + W_BR + 2 * 1024 * 512, nullptr);
      xpose_cvt(c.inp(26, 1024 * 1024), 1024, 1024, W + W_OUT, nullptr);
    } break;
    case 1: {
      const EpiG1 e{Z, UA};
      for (int u = vcu; u < 128 * 11; u += G) gemm_tile<1024, 1024, 1024>(H, W + W_IN, (u / 11) * 256, (u % 11) * 256, e);
    } break;
    case 2: {
      for (int u = vcu; u < 896 + 256 + 2048; u += G) {
        if (u < 384) { const EpiP2 e{0, (bf16_t*)(ws + OFF_QRAW), 768, nullptr}; gemm_tile<ZLD, 384, 384>(Z + C_CQ, W + W_UQ, (u / 3) * 256, (u % 3) * 256, e); }
        else if (u < 896) { const int v = u - 384; const EpiP2 e{0, (bf16_t*)(ws + OFF_KVRAW), 1024, nullptr}; gemm_tile<ZLD, 256, 256>(Z + C_CKV, W + W_UKV, (v / 4) * 256, (v % 4) * 256, e); }
        else if (u < 1152) { const int v = u - 896, g = v >> 3, pm = v & 7; const EpiP2 e{1, nullptr, 0, (float*)(ws + OFF_EOA) + (size_t)g * 2048 * 128};
          gemm_tile<384, 256, 256>(UA + (size_t)g * 2048 * 384, (const bf16_t*)(ws + OFF_MATS) + (size_t)g * 65536, pm * 256, 0, e); }
        else gla_pass1(c, u - 1152);
      }
    } break;
    case 3: {
      gla_scan(c);
      if (blockIdx.x < 128) s5_scan(c);
      unsigned* ctr = (unsigned*)(ws + OFF_CTL) + 2 + c.layer;
      for (;;) { const int u = next_unit(ctr); if (u >= 512) break; mla_finalize_unit(c, u); }
    } break;
    case 4: {
      unsigned* ctr = (unsigned*)(ws + OFF_CTL) + c.layer;
      for (;;) {
        const int u = next_unit(ctr);
        if (u >= 1024 + 256 + 2048) break;
        if (u < 1024) attn_unit(c, u);
        else if (u < 1280) { const int v = u - 1024, g = v >> 3, pm = v & 7; const EpiS5Y e{Z, g};
          gemm_tile<384, 384, 384>(UA + (size_t)g * 2048 * 384, (const bf16_t*)(ws + OFF_MY) + (size_t)g * 256 * 384, pm * 256, 0, e); }
        else gla_pass3(c, u - 1280);
      }
    } break;
    case 5: {
      const EpiGLU e{Z, c.inp(21, 512)};
      for (int u = vcu; u < 256; u += G) gemm_tile<ZLD, 512, 512>(Z + C_SU, W + W_GLU, (u / 2) * 256, (u % 2) * 256, e);
    } break;
    case 6: {
      uint2* scr = (uint2*)(ws + OFF_SCR) + (size_t)blockIdx.x * 16384;
      bf16_t* M = (bf16_t*)(ws + OFF_MERGED);
      for (int u = vcu; u < 512; u += G) {
        const int brow = (u / 4) * 256, bcol = (u % 4) * 256;
        for (int br = 0; br < 3; ++br) {
          const EpiP6 e0{0, scr, M, c.inp(25, 3072) + br * 1024, br};
          if (br == 0) gemm_tile<512, 512, 512>((const bf16_t*)(ws + OFF_EOA), W + W_BR, brow, bcol, e0);
          else gemm_tile<ZLD, 512, 512>(br == 1 ? Z + C_GV : Z + C_GR, W + W_BR + (size_t)br * 1024 * 512, brow, bcol, e0);
          const EpiP6 e1{1, scr, M, c.inp(25, 3072) + br * 1024, br};
          gemm_tile<1024, 1024, 1024>(H, W + W_IN + (size_t)(ZLD + br * 1024) * 1024, brow, bcol, e1);
        }
      }
    } break;
    case 7: {
      const EpiResid e{xsrc, c.out};
      for (int u = vcu; u < 512; u += G) gemm_tile<1024, 1024, 1024>((const bf16_t*)(ws + OFF_MERGED), W + W_OUT, (u / 4) * 256, (u % 4) * 256, e);
    } break;
    case 8: {
      rmsnorm_rows(c.out, c.inp(27, 1024), H);
      xpose_cvt(c.inp(28, (size_t)1024 * 4096), 1024, 4096, (bf16_t*)(ws + OFF_WFF1), nullptr);
      xpose_cvt(c.inp(29, (size_t)4096 * 1024), 4096, 1024, (bf16_t*)(ws + OFF_WFF2), nullptr);
    } break;
    case 9: {
      const EpiRelu2 e{(bf16_t*)(ws + OFF_FFH)};
      for (int u = vcu; u < 128 * 16; u += G) gemm_tile<1024, 1024, 1024>(H, (const bf16_t*)(ws + OFF_WFF1), (u / 16) * 256, (u % 16) * 256, e);
    } break;
    case 10: {
      const EpiResid e{c.out, c.out};
      for (int u = vcu; u < 512; u += G) gemm_tile<4096, 4096, 4096>((const bf16_t*)(ws + OFF_FFH), (const bf16_t*)(ws + OFF_WFF2), (u / 4) * 256, (u % 4) * 256, e);
    } break;
  }
}

__global__ void __launch_bounds__(NTHR) mega(Params p) {
  cg::grid_group grid = cg::this_grid();
  Ctx c{p, p.in, p.out, p.ws, 0};
  const int lo = p.ph_lo, hi = p.ph_hi;
#define PH(k) if (lo <= (k) && (k) < hi) { c.layer = (k) / N_PH_LAYER; run_phase(c, (k) % N_PH_LAYER); if ((k) + 1 < hi) grid.sync(); }
  PH(0) PH(1) PH(2) PH(3) PH(4) PH(5) PH(6) PH(7) PH(8) PH(9) PH(10)
  PH(11) PH(12) PH(13) PH(14) PH(15) PH(16) PH(17) PH(18) PH(19) PH(20) PH(21)
#undef PH
}

#ifndef MULTI_LAUNCH
#define MULTI_LAUNCH 0
#endif

extern "C" void kernel_launch(void* const* d_in, const int* in_sizes, int n_in,
                              void* d_out, int out_size, void* d_ws, size_t ws_size,
                              hipStream_t stream) {
  static int grid_blocks = 0;
  if (!grid_blocks) {
    if (n_in != 30 || out_size != T_ * D_ || ws_size < WS_END) { fprintf(stderr, "kernel_launch: unexpected shapes n_in=%d out=%d ws=%zu (need %zu)\n", n_in, out_size, ws_size, (size_t)WS_END); grid_blocks = -1; return; }
    int dev = 0, cus = 0, per_cu = 0;
    hipGetDevice(&dev);
    hipDeviceGetAttribute(&cus, hipDeviceAttributeMultiprocessorCount, dev);
    hipFuncSetAttribute((const void*)mega, hipFuncAttributeMaxDynamicSharedMemorySize, LDS_BYTES);
    hipOccupancyMaxActiveBlocksPerMultiprocessor(&per_cu, (const void*)mega, NTHR, LDS_BYTES);
    fprintf(stderr, "cus=%d per_cu=%d ws_size=%zu\n", cus, per_cu, ws_size);
    if (per_cu < 1) { fprintf(stderr, "kernel_launch: occupancy query says 0 blocks/CU\n"); grid_blocks = -1; return; }
    grid_blocks = cus;
  }
  if (grid_blocks < 0) return;
  hipMemsetAsync((char*)d_ws + OFF_CTL, 0, 4096, stream);
  Params p{};
  for (int i = 0; i < 30; ++i) p.in[i] = (const float*)d_in[i];
  p.out = (float*)d_out; p.ws = (unsigned char*)d_ws;
#if MULTI_LAUNCH
  for (int ph = 0; ph < 2 * N_PH_LAYER; ++ph) {
    p.ph_lo = ph; p.ph_hi = ph + 1;
    hipLaunchKernelGGL(mega, dim3(grid_blocks), dim3(NTHR), LDS_BYTES, stream, p);
  }
#else
  p.ph_lo = 0; p.ph_hi = 2 * N_PH_LAYER;
  void* args[] = {&p};
  hipError_t e = hipLaunchCooperativeKernel((void*)mega, dim3(grid_blocks), dim3(NTHR), args, LDS_BYTES, stream);
  if (e != hipSuccess) fprintf(stderr, "coop launch failed: %s\n", hipGetErrorString(e));
#endif
}
```

```cpp
#include <hip/hip_runtime.h>
#include <hip/hip_cooperative_groups.h>
#include <cstdio>
#include <cstdint>
namespace cg = cooperative_groups;

#define DI __device__ __forceinline__
typedef unsigned short bf16_t;
typedef short bf16x8 __attribute__((ext_vector_type(8)));
typedef short s16x4 __attribute__((ext_vector_type(4)));
typedef float f32x4 __attribute__((ext_vector_type(4)));
typedef float f32x16 __attribute__((ext_vector_type(16)));

constexpr int T_ = 32768, L_ = 8192, D_ = 1024, DIN = 5808, DFF = 4096;
constexpr int ZLD = 2736;
constexpr int C_CQ = 0, C_CKV = 384, C_KPE = 640, C_GQ = 672, C_GK = 928, C_GV = 1184, C_GLR = 1696, C_GR = 1712, C_SU = 2224;
constexpr float EPS = 1e-6f;
constexpr int NTHR = 512;
constexpr int LDS_BYTES = 147456;
constexpr int LDS_UNIT_OFF = LDS_BYTES - 16;

constexpr size_t OFF_Z = 0;
constexpr size_t OFF_QRAW = 179306496;
constexpr size_t OFF_KVRAW = OFF_QRAW + 50331648;
constexpr size_t OFF_KPE2 = OFF_KVRAW + 67108864;
constexpr size_t OFF_EOA = OFF_KPE2 + 16777216;
constexpr size_t OFF_H = OFF_EOA + 33554432;
constexpr size_t OFF_GS = OFF_H + 67108864;
constexpr size_t OFF_UA = OFF_GS + 33554432;
constexpr size_t OFF_W = OFF_UA + 50331648;
constexpr size_t W_IN = 0, W_UQ = W_IN + (size_t)DIN * 1024, W_UKV = W_UQ + 768 * 384, W_GLU = W_UKV + 1024 * 256,
                 W_BR = W_GLU + 512 * 512, W_OUT = W_BR + 3 * 1024 * 512, W_END = W_OUT + 1024 * 1024;
constexpr size_t OFF_MATS = OFF_W + ((W_END * 2 + 255) / 256) * 256;
constexpr size_t OFF_MY = OFF_MATS + 32 * 256 * 256 * 2;
constexpr size_t OFF_ROPE = OFF_MY + 32 * 256 * 384 * 2;
constexpr size_t OFF_GDEC = OFF_ROPE + 2 * 8192 * 16 * 4;
constexpr size_t OFF_CTL = OFF_GDEC + 2048 * 64 * 4;
constexpr size_t WS_END = OFF_CTL + 4096;
constexpr size_t OFF_FFH = OFF_Z;
constexpr size_t OFF_MERGED = OFF_QRAW;
constexpr size_t OFF_SCR = OFF_GS;
constexpr size_t OFF_WFF1 = OFF_UA, OFF_WFF2 = OFF_UA + (size_t)4096 * 1024 * 2;
static_assert(WS_END <= 536870912ull, "workspace");
static_assert((size_t)T_ * 4096 * 2 <= OFF_KPE2, "ffh overlay");

struct Params { const float* in[30]; float* out; unsigned char* ws; int ph_lo, ph_hi; };

struct Ctx {
  const Params& P;
  const float* const* in; float* out; unsigned char* ws;
  int layer;
  DI const float* inp(int i, size_t per_layer) const { return P.in[i] + (size_t)layer * per_layer; }
};

DI bf16_t f2bf(float x) { unsigned u = __float_as_uint(x); u += 0x7fffu + ((u >> 16) & 1u); return (bf16_t)(u >> 16); }
DI float bf2f(bf16_t b) { return __uint_as_float(((unsigned)b) << 16); }
typedef __bf16 bf2_t __attribute__((ext_vector_type(2)));
typedef float f32x2 __attribute__((ext_vector_type(2)));
DI unsigned pack2(float lo, float hi) { f32x2 v; v.x = lo; v.y = hi; return __builtin_bit_cast(unsigned, __builtin_convertvector(v, bf2_t)); }
DI float wave_sum(float v) {
#pragma unroll
  for (int o = 32; o; o >>= 1) v += __shfl_xor(v, o);
  return v;
}
DI float sigmoidf_(float x) { return 1.f / (1.f + __expf(-x)); }
DI void store4bf(bf16_t* p, const f32x4& v) { uint2 w; w.x = pack2(v[0], v[1]); w.y = pack2(v[2], v[3]); *(uint2*)p = w; }
DI f32x4 load4bf(const bf16_t* p) { uint2 w = *(const uint2*)p; f32x4 v; v[0] = __uint_as_float(w.x << 16); v[1] = __uint_as_float(w.x & 0xffff0000u); v[2] = __uint_as_float(w.y << 16); v[3] = __uint_as_float(w.y & 0xffff0000u); return v; }

constexpr int BK = 64, HALF = 128, HT = HALF * BK;
DI int lds_byte(int r, int c) { int st = (r >> 4) * 2 + (c >> 5), rr = r & 15, cc = c & 31, ob = rr * 64 + cc * 2; return st * 1024 + (ob ^ (((ob >> 9) & 1) << 5)); }
DI void stage_rc(int b, int& R, int& C) { int st = b / 1024, sb = b % 1024, swz = sb ^ (((sb >> 9) & 1) << 5); R = (st >> 1) * 16 + swz / 64; C = (st & 1) * 32 + (swz % 64) / 2; }

#define FOR_ACC(...) \
  _Pragma("unroll") for (int ai = 0; ai < 2; ++ai) { _Pragma("unroll") for (int m = 0; m < 4; ++m) { const int row = brow + ai * 128 + wr * 64 + m * 16 + fr; \
  _Pragma("unroll") for (int bj = 0; bj < 2; ++bj) _Pragma("unroll") for (int n = 0; n < 2; ++n) { const int col = bcol + bj * 128 + wc * 32 + n * 16 + fq * 4; const f32x4 v = acc[ai][bj][m][n]; __VA_ARGS__ } } asm volatile("" ::: "memory"); }

#define SA(b, h) (shm + ((b) * 2 + (h)) * HT)
#define SB(b, h) (shm + (4 + (b) * 2 + (h)) * HT)
#define STAGE(P, BASE, LD, VO, br, kt) do { const char* _g = (const char*)((BASE) + (long)(br) * (LD) + (long)(kt) * BK); \
    for (int _i = 0; _i < 2; ++_i) { \
      __builtin_amdgcn_global_load_lds((const unsigned*)(_g + VO[_i]), (unsigned*)((char*)(P) + tidx * 16 + _i * 8192), 16, 0, 0); } } while (0)
#define LDA(dst, b, h) for (int m = 0; m < 4; ++m) for (int k = 0; k < 2; ++k) \
    dst[m][k] = *reinterpret_cast<const bf16x8*>((char*)SA(b, h) + lds_byte(wr * 64 + m * 16 + fr, k * 32 + fq * 8))
#define LDB(dst, b, h) for (int n = 0; n < 2; ++n) for (int k = 0; k < 2; ++k) \
    dst[n][k] = *reinterpret_cast<const bf16x8*>((char*)SB(b, h) + lds_byte(wc * 32 + n * 16 + fr, k * 32 + fq * 8))
#define MMA(ai, bj, At, Bf) do { __builtin_amdgcn_s_setprio(1); \
    for (int m = 0; m < 4; ++m) for (int n = 0; n < 2; ++n) for (int k = 0; k < 2; ++k) \
      acc[ai][bj][m][n] = __builtin_amdgcn_mfma_f32_16x16x32_bf16(Bf[n][k], At[m][k], acc[ai][bj][m][n], 0, 0, 0); \
    __builtin_amdgcn_s_setprio(0); } while (0)
#define WAIT_V(n) asm volatile("s_waitcnt vmcnt(" #n ")" ::: "memory")
#define WAIT_L(n) asm volatile("s_waitcnt lgkmcnt(" #n ")" ::: "memory")
#define BAR __builtin_amdgcn_s_barrier()
#define SCHED __builtin_amdgcn_sched_barrier(0)
#define GEMM_TID \
  int tidx; asm volatile("v_mov_b32 %0, %1" : "=v"(tidx) : "v"(threadIdx.x)); \
  unsigned voA[2], voB[2]; \
  for (int i = 0; i < 2; ++i) { int r_, c_; stage_rc(tidx * 16 + i * 8192, r_, c_); voA[i] = (unsigned)(r_ * lda + c_) * 2u; voB[i] = (unsigned)(r_ * ldb + c_) * 2u; }

template <int lda, int ldb>
DI void gemm_issue(const bf16_t* __restrict__ A, const bf16_t* __restrict__ Bt, int brow, int bcol) {
  extern __shared__ __attribute__((aligned(16))) unsigned char smem[];
  bf16_t* shm = (bf16_t*)smem;
  GEMM_TID
  STAGE(SB(0, 0), Bt, ldb, voB, bcol, 0); STAGE(SA(0, 0), A, lda, voA, brow, 0);
  STAGE(SB(0, 1), Bt, ldb, voB, bcol + HALF, 0); STAGE(SA(0, 1), A, lda, voA, brow + HALF, 0);
}

template <int lda, int ldb, int K>
DI void gemm_main(const bf16_t* __restrict__ A, const bf16_t* __restrict__ Bt, int brow, int bcol, f32x4 (&acc)[2][2][4][2]) {
  extern __shared__ __attribute__((aligned(16))) unsigned char smem[];
  bf16_t* shm = (bf16_t*)smem;
  GEMM_TID
  const int wid = tidx >> 6, lane = tidx & 63, wr = wid >> 2, wc = wid & 3, fr = lane & 15, fq = lane >> 4;
#pragma unroll
  for (int a = 0; a < 2; ++a)
#pragma unroll
    for (int b = 0; b < 2; ++b)
#pragma unroll
      for (int m = 0; m < 4; ++m)
#pragma unroll
        for (int n = 0; n < 2; ++n) acc[a][b][m][n] = (f32x4){0.f, 0.f, 0.f, 0.f};
  bf16x8 At[4][2], B0[2][2], B1[2][2];
  const int nt = K / BK;
  if (wr == 1) BAR;
  WAIT_V(4); BAR;
  STAGE(SB(1, 0), Bt, ldb, voB, bcol, 1); STAGE(SA(1, 0), A, lda, voA, brow, 1); STAGE(SB(1, 1), Bt, ldb, voB, bcol + HALF, 1);
  WAIT_V(6); BAR;
  for (int t = 0; t < nt - 2; t += 2) {
    LDB(B0, 0, 0); SCHED; LDA(At, 0, 0); STAGE(SA(1, 1), A, lda, voA, brow + HALF, t + 1);
    WAIT_L(8); BAR; WAIT_L(0); MMA(0, 0, At, B0); BAR; SCHED;
    LDB(B1, 0, 1); STAGE(SB(0, 0), Bt, ldb, voB, bcol, t + 2);
    BAR; WAIT_L(0); MMA(0, 1, At, B1); BAR;
    LDA(At, 0, 1); STAGE(SA(0, 0), A, lda, voA, brow, t + 2);
    BAR; WAIT_L(0); MMA(1, 0, At, B0); BAR; SCHED;
    STAGE(SB(0, 1), Bt, ldb, voB, bcol + HALF, t + 2);
    WAIT_V(6); BAR; MMA(1, 1, At, B1); BAR;
    LDB(B0, 1, 0); SCHED; LDA(At, 1, 0); STAGE(SA(0, 1), A, lda, voA, brow + HALF, t + 2);
    WAIT_L(8); BAR; WAIT_L(0); MMA(0, 0, At, B0); BAR; SCHED;
    LDB(B1, 1, 1); STAGE(SB(1, 0), Bt, ldb, voB, bcol, t + 3);
    BAR; WAIT_L(0); MMA(0, 1, At, B1); BAR;
    LDA(At, 1, 1); STAGE(SA(1, 0), A, lda, voA, brow, t + 3);
    BAR; WAIT_L(0); MMA(1, 0, At, B0); BAR; SCHED;
    STAGE(SB(1, 1), Bt, ldb, voB, bcol + HALF, t + 3);
    WAIT_V(6); BAR; MMA(1, 1, At, B1); BAR;
  }
  { LDB(B0, 0, 0); LDA(At, 0, 0); STAGE(SA(1, 1), A, lda, voA, brow + HALF, nt - 1);
    BAR; WAIT_L(0); MMA(0, 0, At, B0); BAR;
    LDB(B1, 0, 1); BAR; WAIT_L(0); MMA(0, 1, At, B1); BAR;
    LDA(At, 0, 1); WAIT_V(4); BAR; WAIT_L(0); MMA(1, 0, At, B0); MMA(1, 1, At, B1); BAR; }
  { LDB(B0, 1, 0); LDA(At, 1, 0); WAIT_V(2); BAR; WAIT_L(0); MMA(0, 0, At, B0); BAR;
    LDB(B1, 1, 1); WAIT_V(0); BAR; WAIT_L(0); MMA(0, 1, At, B1); BAR;
    LDA(At, 1, 1); BAR; WAIT_L(0); MMA(1, 0, At, B0); MMA(1, 1, At, B1); BAR; }
  if (wr == 0) BAR;
}

template <int lda, int ldb, int K, class Epi>
DI void gemm_tile(const bf16_t* __restrict__ A, const bf16_t* __restrict__ Bt, int brow, int bcol, const Epi& epi) {
  asm volatile("s_waitcnt vmcnt(0) lgkmcnt(0)" ::: "memory");
  __builtin_amdgcn_s_barrier();
  gemm_issue<lda, ldb>(A, Bt, brow, bcol);
  f32x4 acc[2][2][4][2];
  gemm_main<lda, ldb, K>(A, Bt, brow, bcol, acc);
  int tidx; asm volatile("v_mov_b32 %0, %1" : "=v"(tidx) : "v"(threadIdx.x));
  const int wid = tidx >> 6, lane = tidx & 63;
  epi(acc, brow, bcol, wid >> 2, wid & 3, lane & 15, lane >> 4);
}

DI int vcu_id();
template <int lda, int ldb, int K, class Epi>
DI void gemm_phase(const bf16_t* __restrict__ A, const bf16_t* __restrict__ Bt, int ntiles, int nN, const Epi& epi) {
  const int G = gridDim.x; int u = vcu_id();
  if (u >= ntiles) return;
  asm volatile("s_waitcnt vmcnt(0) lgkmcnt(0)" ::: "memory");
  __builtin_amdgcn_s_barrier();
  gemm_issue<lda, ldb>(A, Bt, (u / nN) * 256, (u % nN) * 256);
  for (; u < ntiles; u += G) {
    const int brow = (u / nN) * 256, bcol = (u % nN) * 256;
    f32x4 acc[2][2][4][2];
    gemm_main<lda, ldb, K>(A, Bt, brow, bcol, acc);
    const int un = u + G;
    if (un < ntiles) gemm_issue<lda, ldb>(A, Bt, (un / nN) * 256, (un % nN) * 256);
    int tidx; asm volatile("v_mov_b32 %0, %1" : "=v"(tidx) : "v"(threadIdx.x));
    const int wid = tidx >> 6, lane = tidx & 63;
    epi(acc, brow, bcol, wid >> 2, wid & 3, lane & 15, lane >> 4);
  }
}

DI int vcu_id() { const int G = gridDim.x, bx = blockIdx.x; return (G % 8 == 0) ? (bx % 8) * (G / 8) + bx / 8 : bx; }

typedef const f32x4 (&AccRef)[2][2][4][2];
struct EpiG1 { bf16_t* Z; bf16_t* UA;
  DI void operator()(AccRef acc, int brow, int bcol, int wr, int wc, int fr, int fq) const {
    FOR_ACC(
      if (col < C_SU) { store4bf(Z + (size_t)row * ZLD + col, v); }
      else if (col < ZLD) { const int cc = col - C_SU, g = cc >> 4, i = cc & 15; store4bf(UA + ((size_t)(g * 2048 + (row >> 4)) * 384 + (row & 15) * 16 + i), v); }
    )
  } };
struct EpiBf16 { bf16_t* O; int ldc;
  DI void operator()(AccRef acc, int brow, int bcol, int wr, int wc, int fr, int fq) const {
    FOR_ACC( store4bf(O + (size_t)row * ldc + col, v); )
  } };
struct EpiS5E { float* E;
  DI void operator()(AccRef acc, int brow, int bcol, int wr, int wc, int fr, int fq) const {
    FOR_ACC( if (col < 128) { *(f32x4*)(E + (size_t)row * 128 + col) = v; } )
  } };
DI float gelu_tanh(float x) { const float z = 0.7978845608028654f * (x + 0.044715f * x * x * x); const float t = 1.f - 2.f / (__expf(2.f * z) + 1.f); return 0.5f * x * (1.f + t); }
struct EpiS5Y { bf16_t* Z; int g;
  DI void operator()(AccRef acc, int brow, int bcol, int wr, int wc, int fr, int fq) const {
    FOR_ACC(
      const int j = col >> 4, i = col & 15;
      const size_t t = (size_t)(row >> 9) * 8192 + (size_t)(row & 511) * 16 + j;
      f32x4 o; o[0] = gelu_tanh(v[0]); o[1] = gelu_tanh(v[1]); o[2] = gelu_tanh(v[2]); o[3] = gelu_tanh(v[3]);
      store4bf(Z + t * ZLD + C_SU + g * 16 + i, o);
    )
  } };
struct EpiGLU { bf16_t* Z; const float* bias;
  DI void operator()(AccRef acc, int brow, int bcol, int wr, int wc, int fr, int fq) const {
    FOR_ACC(
      const f32x4 y = load4bf(Z + (size_t)row * ZLD + C_SU + col);
      const f32x4 b = *(const f32x4*)(bias + col);
      f32x4 o; for (int q = 0; q < 4; ++q) o[q] = y[q] * sigmoidf_(v[q] + b[q]);
      store4bf(Z + (size_t)row * ZLD + C_GR + col, o);
    )
  } };
struct EpiScr { uint2* scr;
  DI void operator()(AccRef acc, int brow, int bcol, int wr, int wc, int fr, int fq) const {
    FOR_ACC( uint2 w; w.x = pack2(v[0], v[1]); w.y = pack2(v[2], v[3]); scr[(((ai * 2 + bj) * 4 + m) * 2 + n) * NTHR + threadIdx.x] = w; )
  } };
struct EpiGate { const uint2* scr; bf16_t* M; const float* gb; int br;
  DI void operator()(AccRef acc, int brow, int bcol, int wr, int wc, int fr, int fq) const {
    FOR_ACC(
      const uint2 w = scr[(((ai * 2 + bj) * 4 + m) * 2 + n) * NTHR + threadIdx.x];
      f32x4 p; p[0] = __uint_as_float(w.x << 16); p[1] = __uint_as_float(w.x & 0xffff0000u); p[2] = __uint_as_float(w.y << 16); p[3] = __uint_as_float(w.y & 0xffff0000u);
      const f32x4 b = *(const f32x4*)(gb + col);
      bf16_t* dst = M + (size_t)row * 1024 + col;
      f32x4 o = {0.f, 0.f, 0.f, 0.f};
      if (br > 0) o = load4bf(dst);
      for (int q = 0; q < 4; ++q) o[q] += sigmoidf_(v[q] + b[q]) * p[q];
      store4bf(dst, o);
    )
  } };
struct EpiP2 { int kind; bf16_t* O; int ldc; float* E;
  DI void operator()(AccRef acc, int brow, int bcol, int wr, int wc, int fr, int fq) const {
    if (kind == 0) { FOR_ACC( store4bf(O + (size_t)row * ldc + col, v); ) }
    else { FOR_ACC( if (col < 128) { *(f32x4*)(E + (size_t)row * 128 + col) = v; } ) }
  } };
struct EpiP6 { int kind; uint2* scr; bf16_t* M; const float* gb; int br;
  DI void operator()(AccRef acc, int brow, int bcol, int wr, int wc, int fr, int fq) const {
    uint2* sl = scr + (((wr * 4 + wc) * 4 + fq) * 16 + fr);
    asm volatile("" : "+v"(sl));
    if (kind == 0) { FOR_ACC( uint2 w; w.x = pack2(v[0], v[1]); w.y = pack2(v[2], v[3]); sl[(((ai * 2 + bj) * 4 + m) * 2 + n) * NTHR] = w; ) }
    else {
      FOR_ACC(
        const uint2 w = sl[(((ai * 2 + bj) * 4 + m) * 2 + n) * NTHR];
        f32x4 p; p[0] = __uint_as_float(w.x << 16); p[1] = __uint_as_float(w.x & 0xffff0000u); p[2] = __uint_as_float(w.y << 16); p[3] = __uint_as_float(w.y & 0xffff0000u);
        const f32x4 b = *(const f32x4*)(gb + col);
        bf16_t* dst = M + (size_t)row * 1024 + col;
        f32x4 o = {0.f, 0.f, 0.f, 0.f};
        if (br > 0) o = load4bf(dst);
        for (int q = 0; q < 4; ++q) o[q] += sigmoidf_(v[q] + b[q]) * p[q];
        store4bf(dst, o);
      )
    }
  } };
struct EpiResid { const float* src; float* dst;
  DI void operator()(AccRef acc, int brow, int bcol, int wr, int wc, int fr, int fq) const {
    FOR_ACC(
      const f32x4 x = *(const f32x4*)(src + (size_t)row * 1024 + col);
      *(f32x4*)(dst + (size_t)row * 1024 + col) = x + v;
    )
  } };
struct EpiRelu2 { bf16_t* O;
  DI void operator()(AccRef acc, int brow, int bcol, int wr, int wc, int fr, int fq) const {
    FOR_ACC( f32x4 o; for (int q = 0; q < 4; ++q) { const float r = fmaxf(v[q], 0.f); o[q] = r * r; } store4bf(O + (size_t)row * DFF + col, o); )
  } };

DI void rmsnorm_rows(const float* __restrict__ src, const float* __restrict__ g, bf16_t* __restrict__ dst) {
  const int wave = threadIdx.x >> 6, lane = threadIdx.x & 63;
  f32x4 gv[4];
#pragma unroll
  for (int i = 0; i < 4; ++i) gv[i] = *(const f32x4*)(g + lane * 4 + 256 * i);
  for (int row = (blockIdx.x * 8 + wave) * 2; row < T_; row += gridDim.x * 16) {
    f32x4 x[8]; float ss0 = 0.f, ss1 = 0.f;
#pragma unroll
    for (int i = 0; i < 8; ++i) x[i] = *(const f32x4*)(src + (size_t)(row + (i >> 2)) * 1024 + lane * 4 + 256 * (i & 3));
#pragma unroll
    for (int i = 0; i < 4; ++i) { ss0 += x[i][0] * x[i][0] + x[i][1] * x[i][1] + x[i][2] * x[i][2] + x[i][3] * x[i][3]; ss1 += x[i + 4][0] * x[i + 4][0] + x[i + 4][1] * x[i + 4][1] + x[i + 4][2] * x[i + 4][2] + x[i + 4][3] * x[i + 4][3]; }
    ss0 = wave_sum(ss0); ss1 = wave_sum(ss1);
    const float rs0 = rsqrtf(ss0 * (1.f / 1024.f) + EPS), rs1 = rsqrtf(ss1 * (1.f / 1024.f) + EPS);
#pragma unroll
    for (int i = 0; i < 8; ++i) { f32x4 o = x[i] * ((i >> 2) ? rs1 : rs0) * gv[i & 3]; store4bf(dst + (size_t)(row + (i >> 2)) * 1024 + lane * 4 + 256 * (i & 3), o); }
  }
}

DI void xpose_tile(const float* __restrict__ src, int Kd, int Nd, bf16_t* __restrict__ dst, const float* __restrict__ gs, int tix) {
  extern __shared__ __attribute__((aligned(16))) unsigned char smem[];
  float* tile = (float*)smem;
  const int tk = Kd >> 7;
  const int k0 = (tix % tk) * 128, n0 = (tix / tk) * 128;
  const int tid = threadIdx.x;
  __syncthreads();
  f32x4 v[8];
#pragma unroll
  for (int i = 0; i < 8; ++i) { const int r = (tid >> 5) + 16 * i, cq = (tid & 31) * 4; const int n = n0 + cq;
    v[i] = (n + 3 < Nd) ? *(const f32x4*)(src + (size_t)(k0 + r) * Nd + n) : (f32x4){0.f, 0.f, 0.f, 0.f}; }
#pragma unroll
  for (int i = 0; i < 8; ++i) { const int r = (tid >> 5) + 16 * i, cq = (tid & 31) * 4; const float sc = gs ? gs[k0 + r] : 1.f;
    tile[r * 129 + cq] = v[i][0] * sc; tile[r * 129 + cq + 1] = v[i][1] * sc; tile[r * 129 + cq + 2] = v[i][2] * sc; tile[r * 129 + cq + 3] = v[i][3] * sc; }
  __syncthreads();
#pragma unroll
  for (int i = 0; i < 4; ++i) { const int n = tid & 127, kc = ((tid >> 7) + 4 * i) * 8;
    if (n0 + n < Nd) { uint4 w;
      w.x = pack2(tile[(kc + 0) * 129 + n], tile[(kc + 1) * 129 + n]); w.y = pack2(tile[(kc + 2) * 129 + n], tile[(kc + 3) * 129 + n]);
      w.z = pack2(tile[(kc + 4) * 129 + n], tile[(kc + 5) * 129 + n]); w.w = pack2(tile[(kc + 6) * 129 + n], tile[(kc + 7) * 129 + n]);
      *(uint4*)(dst + (size_t)(n0 + n) * Kd + k0 + kc) = w; } }
}

DI void s5_mats_unit(const Ctx& c, int unit) {
  extern __shared__ __attribute__((aligned(16))) unsigned char smem[];
  float* lp_re = (float*)smem;
  float* lp_im = lp_re + 17 * 64;
  float* bb_re = lp_im + 17 * 64;
  float* bb_im = bb_re + 1024;
  float* cr = bb_im + 1024;
  float* ci = cr + 1024;
  float* Kt = ci + 1024;
  float* dv = Kt + 4096;
  const int tid = threadIdx.x;
  bf16_t* ME = (bf16_t*)(c.ws + OFF_MATS);
  bf16_t* MY = (bf16_t*)(c.ws + OFF_MY);
  const int g = unit >> 3, qpart = unit & 7;
  {
    __syncthreads();
    if (tid < 64) {
      const int p = tid;
      const float lre = fminf(c.inp(12, 2048)[g * 64 + p], -1e-4f), lim = c.inp(13, 2048)[g * 64 + p];
      const float step = expf(c.inp(19, 32)[g]);
      for (int d = 0; d <= 16; ++d) { const float mag = expf(lre * step * d); float s, co; sincosf(lim * step * d, &s, &co); lp_re[d * 64 + p] = mag * co; lp_im[d * 64 + p] = mag * s; }
      const float nr = lp_re[64 + p] - 1.f, ni = lp_im[64 + p];
      const float den = 1.f / (lre * lre + lim * lim);
      const float kr = (nr * lre + ni * lim) * den, ki = (ni * lre - nr * lim) * den;
      for (int i = 0; i < 16; ++i) { const float br = c.inp(14, 32768)[(g * 64 + p) * 16 + i], bi = c.inp(15, 32768)[(g * 64 + p) * 16 + i]; bb_re[p * 16 + i] = kr * br - ki * bi; bb_im[p * 16 + i] = kr * bi + ki * br; }
    }
    for (int i = tid; i < 1024; i += NTHR) { cr[i] = c.inp(16, 32768)[g * 1024 + i]; ci[i] = c.inp(17, 32768)[g * 1024 + i]; }
    if (tid < 16) dv[tid] = c.inp(18, 512)[g * 16 + tid];
    __syncthreads();
    for (int idx = tid; idx < 512 * (qpart + 1); idx += NTHR) {
      const int d = idx >> 8, i = (idx >> 4) & 15, i2 = idx & 15; float s = 0.f;
      for (int p = 0; p < 64; ++p) { const float lr = lp_re[d * 64 + p], li = lp_im[d * 64 + p], br = bb_re[p * 16 + i2], bi = bb_im[p * 16 + i2];
        const float wre = lr * br - li * bi, wim = lr * bi + li * br; s += cr[i * 64 + p] * wre - ci[i * 64 + p] * wim; }
      Kt[idx] = s;
    }
    __syncthreads();
    for (int idx = qpart * 32 * 384 + tid; idx < (qpart + 1) * 32 * 384; idx += NTHR) {
      const int n = idx / 384, k = idx % 384, j = n >> 4, i = n & 15; float val;
      if (k < 256) { const int j2 = k >> 4, i2 = k & 15; val = (j >= j2) ? Kt[((j - j2) * 16 + i) * 16 + i2] + ((j == j2 && i == i2) ? dv[i] : 0.f) : 0.f; }
      else if (k < 320) { const int p = k - 256; val = cr[i * 64 + p] * lp_re[(j + 1) * 64 + p] - ci[i * 64 + p] * lp_im[(j + 1) * 64 + p]; }
      else { const int p = k - 320; val = -(cr[i * 64 + p] * lp_im[(j + 1) * 64 + p] + ci[i * 64 + p] * lp_re[(j + 1) * 64 + p]); }
      MY[(size_t)g * 256 * 384 + idx] = f2bf(val);
    }
    for (int idx = qpart * 32 * 256 + tid; idx < (qpart + 1) * 32 * 256; idx += NTHR) {
      const int n = idx >> 8, k = idx & 255, j2 = k >> 4, i2 = k & 15; float val = 0.f;
      if (n < 128) { const int p = n & 63; const float lr = lp_re[(15 - j2) * 64 + p], li = lp_im[(15 - j2) * 64 + p], br = bb_re[p * 16 + i2], bi = bb_im[p * 16 + i2];
        val = (n < 64) ? (lr * br - li * bi) : (lr * bi + li * br); }
      ME[(size_t)g * 65536 + idx] = f2bf(val);
    }
  }
}

DI void rope_table(const Ctx& c) {
  float* cs = (float*)(c.ws + OFF_ROPE); float* sn = cs + 8192 * 16;
  for (int idx = blockIdx.x * NTHR + threadIdx.x; idx < 8192 * 16; idx += gridDim.x * NTHR) {
    const int pos = idx >> 4, i = idx & 15;
    const float invf = powf(10000.f, -(float)(2 * i) / 32.f);
    const float ang = (float)pos * invf;
    cs[idx] = (float)cos((double)ang); sn[idx] = (float)sin((double)ang);
  }
}

DI void unpack8(const uint4& w, float* f) {
  f[0] = __uint_as_float(w.x << 16); f[1] = __uint_as_float(w.x & 0xffff0000u); f[2] = __uint_as_float(w.y << 16); f[3] = __uint_as_float(w.y & 0xffff0000u);
  f[4] = __uint_as_float(w.z << 16); f[5] = __uint_as_float(w.z & 0xffff0000u); f[6] = __uint_as_float(w.w << 16); f[7] = __uint_as_float(w.w & 0xffff0000u);
}
struct GlaPre { uint4 glr; float wg0, wg1, bgv; };
DI GlaPre gla_preload(const Ctx& c, const bf16_t* Z, int t0, int h, int tid) {
  const float* wg = c.inp(9, 16 * 256); const float* bg = c.inp(10, 256);
  GlaPre p; p.glr = make_uint4(0, 0, 0, 0);
  if (tid < 128) p.glr = *(const uint4*)(Z + (size_t)(t0 + (tid >> 1)) * ZLD + C_GLR + (tid & 1) * 8);
  p.wg0 = wg[(tid >> 6) * 256 + h * 64 + (tid & 63)]; p.wg1 = wg[((tid + NTHR) >> 6) * 256 + h * 64 + (tid & 63)];
  p.bgv = bg[h * 64 + (tid & 63)];
  return p;
}
DI void gla_bc(const GlaPre& pre, int tid, float* glr_s, float* wg_s, float* bc_s) {
  if (tid < 128) { const int cc = tid >> 1, r0 = (tid & 1) * 8; float f[8]; unpack8(pre.glr, f);
#pragma unroll
    for (int i = 0; i < 8; ++i) glr_s[cc * 16 + r0 + i] = f[i]; }
  wg_s[tid] = pre.wg0; wg_s[tid + NTHR] = pre.wg1;
  __syncthreads();
  const int d = tid & 63, seg = tid >> 6;
  const float bgv = pre.bgv;
  float wv[16];
#pragma unroll
  for (int r = 0; r < 16; ++r) wv[r] = wg_s[r * 64 + d];
  float run = 0.f, loc[8];
#pragma unroll
  for (int i = 0; i < 8; ++i) {
    const int cc = seg * 8 + i; float a = bgv;
#pragma unroll
    for (int r = 0; r < 16; ++r) a += glr_s[cc * 16 + r] * wv[r];
    run += (fminf(a, 0.f) - __logf(1.f + __expf(-fabsf(a)))) * (1.f / 16.f);
    loc[i] = run;
  }
  __syncthreads();
  glr_s[seg * 64 + d] = run;
  __syncthreads();
  float off = 0.f;
  for (int s2 = 0; s2 < seg; ++s2) off += glr_s[s2 * 64 + d];
#pragma unroll
  for (int i = 0; i < 8; ++i) bc_s[(seg * 8 + i) * 64 + d] = loc[i] + off;
  __syncthreads();
}

constexpr int GQS = 72;
DI void gla_pass1(const Ctx& c, int unit) {
  extern __shared__ __attribute__((aligned(16))) unsigned char smem[];
  float* glr_s = (float*)smem; float* wg_s = glr_s + 1024; float* bc_s = wg_s + 1024;
  bf16_t* vT = (bf16_t*)(smem + 24576);
  bf16_t* keT = (bf16_t*)(smem + 43008);
  const bf16_t* Z = (const bf16_t*)(c.ws + OFF_Z);
  int tid_; asm volatile("v_mov_b32 %0, %1" : "=v"(tid_) : "v"(threadIdx.x));
  const int tid = tid_, n = unit & 127, bh = unit >> 7, h = bh & 3, b = bh >> 2, t0 = b * L_ + n * 64;
  const int cc = tid & 63, ch = tid >> 6;
  const GlaPre pre = gla_preload(c, Z, t0, h, tid);
  const uint4 wkk = *(const uint4*)(Z + (size_t)(t0 + cc) * ZLD + C_GK + h * 64 + ch * 8);
  const uint4 wv0 = *(const uint4*)(Z + (size_t)(t0 + cc) * ZLD + C_GV + h * 128 + ch * 8), wv1 = *(const uint4*)(Z + (size_t)(t0 + cc) * ZLD + C_GV + h * 128 + (ch + 8) * 8);
  __syncthreads();
  gla_bc(pre, tid, glr_s, wg_s, bc_s);
  { const int d0 = ch * 8; float f[8]; unpack8(wkk, f);
#pragma unroll
    for (int i = 0; i < 8; ++i) keT[(d0 + i) * GQS + cc] = f2bf(f[i] * __expf(bc_s[63 * 64 + d0 + i] - bc_s[cc * 64 + d0 + i])); }
#pragma unroll
  for (int k = 0; k < 2; ++k) { const int e0 = (ch + 8 * k) * 8; const uint4 w = k ? wv1 : wv0;
    const unsigned ww[4] = {w.x, w.y, w.z, w.w};
#pragma unroll
    for (int i = 0; i < 4; ++i) { vT[(e0 + 2 * i) * GQS + cc] = (bf16_t)(ww[i] & 0xffffu); vT[(e0 + 2 * i + 1) * GQS + cc] = (bf16_t)(ww[i] >> 16); } }
  __syncthreads();
  const int wave = tid >> 6, lane = tid & 63, l32 = lane & 31, hb = lane >> 5, mt = wave >> 1, nt = wave & 1;
  f32x16 acc;
#pragma unroll
  for (int i = 0; i < 16; ++i) acc[i] = 0.f;
#pragma unroll
  for (int ks = 0; ks < 4; ++ks) {
    const bf16x8 a = *(const bf16x8*)(vT + (mt * 32 + l32) * GQS + ks * 16 + hb * 8);
    const bf16x8 bq = *(const bf16x8*)(keT + (nt * 32 + l32) * GQS + ks * 16 + hb * 8);
    acc = __builtin_amdgcn_mfma_f32_32x32x16_bf16(a, bq, acc, 0, 0, 0);
  }
  bf16_t* GS = (bf16_t*)(c.ws + OFF_GS) + (size_t)unit * 8192;
#pragma unroll
  for (int r = 0; r < 16; ++r) { const int e = mt * 32 + (r & 3) + 8 * (r >> 2) + 4 * hb; GS[e * 64 + nt * 32 + l32] = f2bf(acc[r]); }
  if (tid < 64) ((float*)(c.ws + OFF_GDEC))[unit * 64 + tid] = __expf(bc_s[63 * 64 + tid]);
}

DI void gla_scan(const Ctx& c, int first_block, int nblocks) {
  bf16_t* GS = (bf16_t*)(c.ws + OFF_GS); const float* dec = (const float*)(c.ws + OFF_GDEC);
  for (int idx = (blockIdx.x - first_block) * NTHR + threadIdx.x; idx < 8 * 8192; idx += nblocks * NTHR) {
    const int bh = idx >> 13, ed = idx & 8191, d = ed & 63;
    float S0 = 0.f, S1 = 0.f;
    bf16_t* p0 = GS + (size_t)bh * 128 * 8192 + ed; const float* dp0 = dec + bh * 128 * 64 + d;
    bf16_t* p1 = p0 + (size_t)8 * 128 * 8192; const float* dp1 = dp0 + 8 * 128 * 64;
#pragma unroll 8
    for (int n = 0; n < 128; ++n) {
      const float ds0 = bf2f(p0[(size_t)n * 8192]), ds1 = bf2f(p1[(size_t)n * 8192]); const float dc0 = dp0[n * 64], dc1 = dp1[n * 64];
      p0[(size_t)n * 8192] = f2bf(S0); p1[(size_t)n * 8192] = f2bf(S1); S0 = dc0 * S0 + ds0; S1 = dc1 * S1 + ds1; }
  }
}

DI void gla_pass3(const Ctx& c, int unit) {
  extern __shared__ __attribute__((aligned(16))) unsigned char smem[];
  float* glr_s = (float*)smem; float* wg_s = glr_s + 1024; float* bc_s = wg_s + 1024;
  bf16_t* qt = (bf16_t*)(smem + 24576);
  bf16_t* kt = (bf16_t*)(smem + 33792);
  bf16_t* vT = (bf16_t*)(smem + 43008);
  bf16_t* ST = (bf16_t*)(smem + 61440);
  bf16_t* As = (bf16_t*)(smem + 79872);
  float* o_s = (float*)(smem + 89088);
  float* red_s = (float*)(smem + 122880);
  bf16_t* Z = (bf16_t*)(c.ws + OFF_Z);
  int tid_; asm volatile("v_mov_b32 %0, %1" : "=v"(tid_) : "v"(threadIdx.x));
  const int tid = tid_, n = unit & 127, bh = unit >> 7, h = bh & 3, b = bh >> 2, t0 = b * L_ + n * 64;
  const bf16_t* GS = (const bf16_t*)(c.ws + OFF_GS) + (size_t)unit * 8192;
  const int cr_ = tid >> 3, d0_ = (tid & 7) * 8, cc_ = tid & 63, ch_ = tid >> 6;
  const GlaPre pre = gla_preload(c, Z, t0, h, tid);
  const uint4 wq = *(const uint4*)(Z + (size_t)(t0 + cr_) * ZLD + C_GQ + h * 64 + d0_), wk = *(const uint4*)(Z + (size_t)(t0 + cr_) * ZLD + C_GK + h * 64 + d0_);
  const uint4 wv0 = *(const uint4*)(Z + (size_t)(t0 + cc_) * ZLD + C_GV + h * 128 + ch_ * 8), wv1 = *(const uint4*)(Z + (size_t)(t0 + cc_) * ZLD + C_GV + h * 128 + (ch_ + 8) * 8);
  const uint4 wS0 = *(const uint4*)(GS + (tid >> 3) * 64 + (tid & 7) * 8), wS1 = *(const uint4*)(GS + ((tid + NTHR) >> 3) * 64 + (tid & 7) * 8);
  const uint4 wr0 = *(const uint4*)(Z + (size_t)(t0 + cc_) * ZLD + C_GR + h * 128 + ch_ * 16), wr1 = *(const uint4*)(Z + (size_t)(t0 + cc_) * ZLD + C_GR + h * 128 + ch_ * 16 + 8);
  __syncthreads();
  gla_bc(pre, tid, glr_s, wg_s, bc_s);
  { const int cr = cr_, d0 = d0_;
    float fq_[8], fk_[8]; unpack8(wq, fq_); unpack8(wk, fk_);
#pragma unroll
    for (int i = 0; i < 8; ++i) { const float ex = __expf(bc_s[cr * 64 + d0 + i]); fq_[i] = fq_[i] * 0.125f * ex; fk_[i] = fk_[i] * __builtin_amdgcn_rcpf(ex); }
    uint4 oq, ok; oq.x = pack2(fq_[0], fq_[1]); oq.y = pack2(fq_[2], fq_[3]); oq.z = pack2(fq_[4], fq_[5]); oq.w = pack2(fq_[6], fq_[7]);
    ok.x = pack2(fk_[0], fk_[1]); ok.y = pack2(fk_[2], fk_[3]); ok.z = pack2(fk_[4], fk_[5]); ok.w = pack2(fk_[6], fk_[7]);
    *(uint4*)(qt + cr * GQS + d0) = oq; *(uint4*)(kt + cr * GQS + d0) = ok; }
  { const int cc = cc_, ch = ch_;
#pragma unroll
    for (int k = 0; k < 2; ++k) { const int e0 = (ch + 8 * k) * 8; const uint4 w = k ? wv1 : wv0;
      const unsigned ww[4] = {w.x, w.y, w.z, w.w};
#pragma unroll
      for (int i = 0; i < 4; ++i) { vT[(e0 + 2 * i) * GQS + cc] = (bf16_t)(ww[i] & 0xffffu); vT[(e0 + 2 * i + 1) * GQS + cc] = (bf16_t)(ww[i] >> 16); } }
    *(uint4*)(ST + (tid >> 3) * GQS + (tid & 7) * 8) = wS0; *(uint4*)(ST + ((tid + NTHR) >> 3) * GQS + (tid & 7) * 8) = wS1; }
  __syncthreads();
  const int wave = tid >> 6, lane = tid & 63, l32 = lane & 31, hb = lane >> 5;
  if (wave < 4) {
    const int mt = wave >> 1, nt = wave & 1;
    f32x16 acc;
#pragma unroll
    for (int i = 0; i < 16; ++i) acc[i] = 0.f;
#pragma unroll
    for (int ks = 0; ks < 4; ++ks) {
      const bf16x8 a = *(const bf16x8*)(qt + (mt * 32 + l32) * GQS + ks * 16 + hb * 8);
      const bf16x8 bq = *(const bf16x8*)(kt + (nt * 32 + l32) * GQS + ks * 16 + hb * 8);
      acc = __builtin_amdgcn_mfma_f32_32x32x16_bf16(a, bq, acc, 0, 0, 0);
    }
#pragma unroll
    for (int r = 0; r < 16; ++r) { const int cr = mt * 32 + (r & 3) + 8 * (r >> 2) + 4 * hb, sc = nt * 32 + l32; As[cr * GQS + sc] = (sc <= cr) ? f2bf(acc[r]) : (bf16_t)0; }
  }
  __syncthreads();
  {
    const int mt = wave >> 2, nt = wave & 3;
    f32x16 acc;
#pragma unroll
    for (int i = 0; i < 16; ++i) acc[i] = 0.f;
#pragma unroll
    for (int ks = 0; ks < 4; ++ks) {
      const bf16x8 a = *(const bf16x8*)(As + (mt * 32 + l32) * GQS + ks * 16 + hb * 8);
      const bf16x8 bq = *(const bf16x8*)(vT + (nt * 32 + l32) * GQS + ks * 16 + hb * 8);
      acc = __builtin_amdgcn_mfma_f32_32x32x16_bf16(a, bq, acc, 0, 0, 0);
    }
#pragma unroll
    for (int ks = 0; ks < 4; ++ks) {
      const bf16x8 a = *(const bf16x8*)(qt + (mt * 32 + l32) * GQS + ks * 16 + hb * 8);
      const bf16x8 bq = *(const bf16x8*)(ST + (nt * 32 + l32) * GQS + ks * 16 + hb * 8);
      acc = __builtin_amdgcn_mfma_f32_32x32x16_bf16(a, bq, acc, 0, 0, 0);
    }
#pragma unroll
    for (int r = 0; r < 16; ++r) { const int cr = mt * 32 + (r & 3) + 8 * (r >> 2) + 4 * hb; o_s[cr * 132 + nt * 32 + l32] = acc[r]; }
  }
  __syncthreads();
  const int cc = tid & 63, wg8 = tid >> 6, e0 = wg8 * 16;
  float o[16];
#pragma unroll
  for (int q = 0; q < 4; ++q) { const f32x4 v = *(const f32x4*)(o_s + cc * 132 + e0 + q * 4); o[q * 4] = v[0]; o[q * 4 + 1] = v[1]; o[q * 4 + 2] = v[2]; o[q * 4 + 3] = v[3]; }
  float ss = 0.f;
#pragma unroll
  for (int i = 0; i < 16; ++i) ss += o[i] * o[i];
  red_s[wg8 * 64 + cc] = ss;
  __syncthreads();
  float tot = 0.f;
#pragma unroll
  for (int i = 0; i < 8; ++i) tot += red_s[i * 64 + cc];
  const float rinv = rsqrtf(tot * (1.f / 128.f) + EPS);
  const float* og = c.inp(11, 128);
  bf16_t* op = Z + (size_t)(t0 + cc) * ZLD + C_GV + h * 128 + e0;
  float rr[16]; unpack8(wr0, rr); unpack8(wr1, rr + 8);
#pragma unroll
  for (int q = 0; q < 4; ++q) {
    f32x4 w;
#pragma unroll
    for (int i = 0; i < 4; ++i) { const float rv = rr[q * 4 + i]; w[i] = o[q * 4 + i] * rinv * og[e0 + q * 4 + i] * (rv / (1.f + __expf(-rv))); }
    store4bf(op + q * 4, w);
  }
}

DI void s5_scan(const Ctx& c) {
  extern __shared__ __attribute__((aligned(16))) unsigned char smem[];
  float* end_s = (float*)smem;
  const float* E = (const float*)(c.ws + OFF_EOA); bf16_t* UA = (bf16_t*)(c.ws + OFF_UA);
  const int tid = threadIdx.x, p = tid & 63, seg = tid >> 6, g = blockIdx.x >> 2, b = blockIdx.x & 3;
  const float lre = fminf(c.inp(12, 2048)[g * 64 + p], -1e-4f), lim = c.inp(13, 2048)[g * 64 + p];
  const float step = expf(c.inp(19, 32)[g]);
  const float mag = expf(lre * step * 16.f); float sn, cs; sincosf(lim * step * 16.f, &sn, &cs);
  const float ar = mag * cs, ai = mag * sn;
  const size_t row0 = (size_t)g * 2048 + (size_t)b * 512 + (size_t)seg * 64;
  float sr = 0.f, si = 0.f;
#pragma unroll 16
  for (int ch = 0; ch < 64; ++ch) {
    const float er = E[(row0 + ch) * 128 + p], ei = E[(row0 + ch) * 128 + 64 + p];
    const float nr = ar * sr - ai * si + er, ni = ar * si + ai * sr + ei; sr = nr; si = ni;
  }
  __syncthreads();
  end_s[(seg * 64 + p) * 2] = sr; end_s[(seg * 64 + p) * 2 + 1] = si;
  __syncthreads();
  float a64r = ar, a64i = ai;
#pragma unroll
  for (int q = 0; q < 6; ++q) { const float nr = a64r * a64r - a64i * a64i, ni = 2.f * a64r * a64i; a64r = nr; a64i = ni; }
  sr = 0.f; si = 0.f;
  for (int s2 = 0; s2 < seg; ++s2) { const float er = end_s[(s2 * 64 + p) * 2], ei = end_s[(s2 * 64 + p) * 2 + 1]; const float nr = a64r * sr - a64i * si + er, ni = a64r * si + a64i * sr + ei; sr = nr; si = ni; }
#pragma unroll 16
  for (int ch = 0; ch < 64; ++ch) {
    const float er = E[(row0 + ch) * 128 + p], ei = E[(row0 + ch) * 128 + 64 + p];
    UA[(row0 + ch) * 384 + 256 + p] = f2bf(sr); UA[(row0 + ch) * 384 + 320 + p] = f2bf(si);
    const float nr = ar * sr - ai * si + er, ni = ar * si + ai * sr + ei; sr = nr; si = ni;
  }
  __syncthreads();
}

template <int CTRL> DI float dpp_mov(float v) { return __builtin_bit_cast(float, __builtin_amdgcn_update_dpp(0, __builtin_bit_cast(int, v), CTRL, 0xf, 0xf, true)); }
DI void mla_finalize_unit(const Ctx& c, int unit) {
  extern __shared__ __attribute__((aligned(16))) unsigned char smem[];
  constexpr int TOKE = 2464;
  bf16_t* lds = (bf16_t*)smem;
  const int tid = threadIdx.x, wave = tid >> 6, lane = tid & 63;
  const bf16_t* Z = (const bf16_t*)(c.ws + OFF_Z);
  bf16_t* Q = (bf16_t*)(c.ws + OFF_QRAW); bf16_t* KV = (bf16_t*)(c.ws + OFF_KVRAW); bf16_t* KP = (bf16_t*)(c.ws + OFF_KPE2);
  const float* cs = (const float*)(c.ws + OFF_ROPE); const float* sn = cs + 8192 * 16;
  const float* qg = c.inp(7, 96); const float* kg = c.inp(8, 96);
  const int l31 = lane & 31, lpar = l31 ^ 16;
  const float qg0 = qg[lane], qg1 = qg[64 + l31], qg1p = qg[64 + lpar], kg0 = kg[lane], kg1 = kg[64 + l31], kg1p = kg[64 + lpar];
  const float qscale = 0.10206207261596575f * 1.4426950408889634f;
  const size_t tbase = (size_t)unit * 16;
  __syncthreads();
  for (int idx = tid; idx < 16 * 308; idx += NTHR) {
    const int tok = idx / 308, ch = idx - tok * 308; const size_t t = tbase + tok;
    const bf16_t* src = (ch < 84) ? Z + t * ZLD + ch * 8 : (ch < 180 ? Q + t * 768 + (ch - 84) * 8 : KV + t * 1024 + (ch - 180) * 8);
    *(uint4*)(lds + tok * TOKE + ch * 8) = *(const uint4*)src;
  }
  __syncthreads();
#pragma unroll
  for (int ti = 0; ti < 2; ++ti) {
    const int tok = wave * 2 + ti; const int t = (int)tbase + tok;
    const int pos = t & (L_ - 1);
    bf16_t* zr = lds + tok * TOKE; bf16_t* qr = zr + 672; bf16_t* kr = zr + 1440;
    float a0[8], a1[8], a1p[8], k0[8], vv[8], red[19];
    float scq = 0.f, sckv = 0.f;
#pragma unroll
    for (int i = 0; i < 6; ++i) { const float v = bf2f(zr[C_CQ + lane + 64 * i]); scq += v * v; }
#pragma unroll
    for (int i = 0; i < 4; ++i) { const float v = bf2f(zr[C_CKV + lane + 64 * i]); sckv += v * v; }
    const float kpe = (lane < 32) ? bf2f(zr[C_KPE + l31]) : 0.f, kpep = bf2f(zr[C_KPE + lpar]);
#pragma unroll
    for (int h = 0; h < 8; ++h) { a0[h] = bf2f(qr[h * 96 + lane]); a1[h] = (lane < 32) ? bf2f(qr[h * 96 + 64 + l31]) : 0.f; a1p[h] = bf2f(qr[h * 96 + 64 + lpar]);
      k0[h] = bf2f(kr[h * 128 + lane]); vv[h] = bf2f(kr[h * 128 + 64 + lane]); }
    const float cv = cs[pos * 16 + (lane & 15)], sv = sn[pos * 16 + (lane & 15)];
    red[0] = scq; red[1] = sckv; red[2] = kpe * kpe;
#pragma unroll
    for (int h = 0; h < 8; ++h) { red[3 + h] = a0[h] * a0[h] + a1[h] * a1[h]; red[11 + h] = k0[h] * k0[h]; }
#pragma unroll
    for (int k = 0; k < 19; ++k) red[k] += dpp_mov<0xB1>(red[k]);
#pragma unroll
    for (int k = 0; k < 19; ++k) red[k] += dpp_mov<0x4E>(red[k]);
#pragma unroll
    for (int k = 0; k < 19; ++k) red[k] += dpp_mov<0x141>(red[k]);
#pragma unroll
    for (int k = 0; k < 19; ++k) red[k] += dpp_mov<0x140>(red[k]);
    { float tmp[19];
#pragma unroll
      for (int k = 0; k < 19; ++k) tmp[k] = __shfl_xor(red[k], 16);
#pragma unroll
      for (int k = 0; k < 19; ++k) red[k] += tmp[k];
#pragma unroll
      for (int k = 0; k < 19; ++k) tmp[k] = __shfl_xor(red[k], 32);
#pragma unroll
      for (int k = 0; k < 19; ++k) red[k] += tmp[k]; }
    const float rsq = rsqrtf(red[0] * (1.f / 384.f) + EPS), rskv = rsqrtf(red[1] * (1.f / 256.f) + EPS);
#pragma unroll
    for (int h = 0; h < 8; ++h) {
      const float rq = rsq * rsqrtf(rsq * rsq * red[3 + h] * (1.f / 96.f) + EPS);
      const float rk = rsqrtf((rskv * rskv * red[11 + h] + red[2]) * (1.f / 96.f) + EPS);
      const float q0o = a0[h] * rq * qg0 * qscale;
      const float n1 = a1[h] * rq * qg1, n1p = a1p[h] * rq * qg1p;
      const float q1o = ((l31 < 16) ? (n1 * cv - n1p * sv) : (n1p * sv + n1 * cv)) * qscale;
      const float k0o = k0[h] * rskv * rk * kg0;
      const float p1 = kpe * rk * kg1, p1p = kpep * rk * kg1p;
      const float kpo = (l31 < 16) ? (p1 * cv - p1p * sv) : (p1p * sv + p1 * cv);
      qr[h * 96 + lane] = f2bf(q0o);
      if (lane < 32) { qr[h * 96 + 64 + lane] = f2bf(q1o); zr[h * 32 + lane] = f2bf(kpo); }
      kr[h * 128 + lane] = f2bf(k0o); kr[h * 128 + 64 + lane] = f2bf(vv[h] * rskv);
    }
  }
  __syncthreads();
  for (int idx = tid; idx < 16 * 256; idx += NTHR) {
    const int tok = idx >> 8, ch = idx & 255; const size_t t = tbase + tok;
    bf16_t* dst = (ch < 32) ? KP + t * 256 + ch * 8 : (ch < 128 ? Q + t * 768 + (ch - 32) * 8 : KV + t * 1024 + (ch - 128) * 8);
    const int so = (ch < 32) ? ch * 8 : (ch < 128 ? 672 + (ch - 32) * 8 : 1440 + (ch - 128) * 8);
    *(uint4*)dst = *(const uint4*)(lds + tok * TOKE + so);
  }
}

constexpr int KSTR = 104, VSTR = 72;
constexpr int KS_BYTES = 64 * KSTR * 2, VT_BYTES = 64 * VSTR * 2;
DI bf16x8 pack8(const f32x16& x, int s) {
  union { unsigned u[4]; bf16x8 v; } r;
  r.u[0] = pack2(x[8 * s + 0], x[8 * s + 1]); r.u[1] = pack2(x[8 * s + 2], x[8 * s + 3]); r.u[2] = pack2(x[8 * s + 4], x[8 * s + 5]); r.u[3] = pack2(x[8 * s + 6], x[8 * s + 7]);
  return r.v;
}
DI void attn_unit(const Ctx& c, int unit) {
  extern __shared__ __attribute__((aligned(16))) unsigned char smem[];
  int tid_; asm volatile("v_mov_b32 %0, %1" : "=v"(tid_) : "v"(threadIdx.x));
  const int tid = tid_, wave = tid >> 6, lane = tid & 63, l32 = lane & 31, hb = lane >> 5;
  const int qb = 31 - (unit >> 5), bh = unit & 31, b = bh >> 3, h = bh & 7;
  const size_t tb = (size_t)b * L_;
  const bf16_t* Q = (const bf16_t*)(c.ws + OFF_QRAW); const bf16_t* KV = (const bf16_t*)(c.ws + OFF_KVRAW); const bf16_t* KP = (const bf16_t*)(c.ws + OFF_KPE2);
  bf16_t* OA = (bf16_t*)(c.ws + OFF_Z);
  const int q0 = qb * 256, qw0 = q0 + wave * 32;
  bf16x8 qf[6];
#pragma unroll
  for (int s = 0; s < 6; ++s) qf[s] = *(const bf16x8*)(Q + (tb + qw0 + l32) * 768 + h * 96 + s * 16 + hb * 8);
  f32x16 ot[2];
#pragma unroll
  for (int i = 0; i < 16; ++i) { ot[0][i] = 0.f; ot[1][i] = 0.f; }
  float lrun = 0.f, shift;
  { const float* qg = c.inp(7, 96); const float* kg = c.inp(8, 96);
    float gq = fmaxf(fabsf(qg[lane]), fabsf(qg[64 + l32])), gk = fmaxf(fabsf(kg[lane]), fabsf(kg[64 + l32]));
#pragma unroll
    for (int o = 32; o; o >>= 1) { gq = fmaxf(gq, __shfl_xor(gq, o)); gk = fmaxf(gk, __shfl_xor(gk, o)); }
    shift = fmaxf(9.797959f * 1.442695f * gq * gk - 40.f, 0.f); }
  const int nkt = (q0 + 256) / 64;
  const int kn_row = tid >> 3, kn_ch = tid & 7, kp_row = tid >> 2, kp_ch = tid & 3, v_key = tid & 63, v_ch = tid >> 6;
  const int v_pos = (v_key & ~15) | (8 * ((v_key >> 2) & 1) + 4 * ((v_key >> 3) & 1) + (v_key & 3));
  struct Stg { uint4 kn, kp, v; };
  Stg sA, sB; sA.kp = make_uint4(0, 0, 0, 0); sB.kp = sA.kp;
  auto gload = [&](Stg& g, int k0) {
    g.kn = *(const uint4*)(KV + (tb + k0 + kn_row) * 1024 + h * 128 + kn_ch * 8);
    if (tid < 256) g.kp = *(const uint4*)(KP + ((tb + k0 + kp_row) * 8 + h) * 32 + kp_ch * 8);
    g.v = *(const uint4*)(KV + (tb + k0 + v_key) * 1024 + h * 128 + 64 + v_ch * 8);
  };
  auto lstore = [&](const Stg& g, int buf) {
    unsigned char* ks = smem + buf * KS_BYTES; bf16_t* vt = (bf16_t*)(smem + 4 * KS_BYTES + buf * VT_BYTES);
    *(uint4*)(ks + (kn_row * KSTR + kn_ch * 8) * 2) = g.kn;
    if (tid < 256) *(uint4*)(ks + (kp_row * KSTR + 64 + kp_ch * 8) * 2) = g.kp;
    const unsigned w[4] = {g.v.x, g.v.y, g.v.z, g.v.w};
#pragma unroll
    for (int i = 0; i < 4; ++i) { vt[(v_ch * 8 + 2 * i) * VSTR + v_pos] = (bf16_t)(w[i] & 0xffffu); vt[(v_ch * 8 + 2 * i + 1) * VSTR + v_pos] = (bf16_t)(w[i] >> 16); }
  };
  auto compute = [&](int kt) {
    const int k0 = kt * 64, buf = kt & 3;
    if (k0 <= qw0 + 31) {
      const unsigned char* ks = smem + buf * KS_BYTES; const bf16_t* vt = (const bf16_t*)(smem + 4 * KS_BYTES + buf * VT_BYTES);
      f32x16 st[2];
#pragma unroll
      for (int i = 0; i < 16; ++i) { st[0][i] = 0.f; st[1][i] = 0.f; }
      bf16x8 kf[2][6], vf[2][2][2];
#pragma unroll
      for (int ksub = 0; ksub < 2; ++ksub)
#pragma unroll
        for (int s = 0; s < 6; ++s) kf[ksub][s] = *(const bf16x8*)(ks + ((ksub * 32 + l32) * KSTR + s * 16 + hb * 8) * 2);
#pragma unroll
      for (int ksub = 0; ksub < 2; ++ksub)
#pragma unroll
        for (int s2 = 0; s2 < 2; ++s2)
#pragma unroll
          for (int dt = 0; dt < 2; ++dt) {
            vf[ksub][s2][dt] = *(const bf16x8*)(vt + (dt * 32 + l32) * VSTR + ksub * 32 + 16 * s2 + 8 * hb);
          }
      __builtin_amdgcn_sched_barrier(0);
#pragma unroll
      for (int ksub = 0; ksub < 2; ++ksub)
#pragma unroll
        for (int s = 0; s < 6; ++s) st[ksub] = __builtin_amdgcn_mfma_f32_32x32x16_bf16(kf[ksub][s], qf[s], st[ksub], 0, 0, 0);
      if (k0 + 63 > qw0) {
        const int qpos = qw0 + l32;
#pragma unroll
        for (int ksub = 0; ksub < 2; ++ksub)
#pragma unroll
          for (int r = 0; r < 16; ++r) { const int key = k0 + ksub * 32 + (r & 3) + 8 * (r >> 2) + 4 * hb; if (key > qpos) st[ksub][r] = -1e30f; }
      }
      if (shift > 0.f) {
#pragma unroll
        for (int r = 0; r < 16; ++r) { st[0][r] -= shift; st[1][r] -= shift; }
      }
#pragma unroll
      for (int ksub = 0; ksub < 2; ++ksub) {
        float rs = 0.f;
#pragma unroll
        for (int r = 0; r < 16; ++r) { st[ksub][r] = __builtin_amdgcn_exp2f(st[ksub][r]); rs += st[ksub][r]; }
        lrun += rs;
#pragma unroll
        for (int s2 = 0; s2 < 2; ++s2) {
          const bf16x8 pf = pack8(st[ksub], s2);
#pragma unroll
          for (int dt = 0; dt < 2; ++dt) ot[dt] = __builtin_amdgcn_mfma_f32_32x32x16_bf16(vf[ksub][s2][dt], pf, ot[dt], 0, 0, 0);
        }
      }
    }
  };
  __syncthreads();
  gload(sA, 0); gload(sB, 64);
  lstore(sA, 0); lstore(sB, 1);
  gload(sA, 128); gload(sB, 192);
  __syncthreads();
  for (int kt = 0; kt < nkt; kt += 2) {
    compute(kt);
    compute(kt + 1);
    if (kt + 2 < nkt) { lstore(sA, (kt + 2) & 3); lstore(sB, (kt + 3) & 3); }
    if (kt + 4 < nkt) { gload(sA, (kt + 4) * 64); gload(sB, (kt + 5) * 64); }
    __syncthreads();
  }
  lrun += __shfl_xor(lrun, 32);
  const float inv = 1.f / lrun;
  bf16_t* op = OA + (tb + qw0 + l32) * ZLD + h * 64;
#pragma unroll
  for (int dt = 0; dt < 2; ++dt)
#pragma unroll
    for (int g4 = 0; g4 < 4; ++g4) {
      f32x4 v; v[0] = ot[dt][g4 * 4 + 0] * inv; v[1] = ot[dt][g4 * 4 + 1] * inv; v[2] = ot[dt][g4 * 4 + 2] * inv; v[3] = ot[dt][g4 * 4 + 3] * inv;
      store4bf(op + dt * 32 + 8 * g4 + 4 * hb, v);
    }
}

#ifndef PROBE_A
#define PROBE_A -1
#define PROBE_B -1
#endif
DI void mark(int k) {
  if (PROBE_A >= 0) {
    extern __shared__ __attribute__((aligned(16))) unsigned char smem[];
    if (blockIdx.x == 0 && threadIdx.x == 0) ((volatile unsigned long long*)(smem + LDS_UNIT_OFF - 8 * 33))[k] = wall_clock64();
  }
}
constexpr int N_PH_LAYER = 11;
DI int next_unit(unsigned* ctr) {
  extern __shared__ __attribute__((aligned(16))) unsigned char smem[];
  volatile int* su = (volatile int*)(smem + LDS_UNIT_OFF);
  __syncthreads();
  if (threadIdx.x == 0) *su = (int)atomicAdd(ctr, 1u);
  __syncthreads();
  return *su;
}

DI void run_phase(const Ctx& c, int k) {
  unsigned char* ws = c.ws;
  bf16_t* Z = (bf16_t*)(ws + OFF_Z); bf16_t* H = (bf16_t*)(ws + OFF_H); bf16_t* W = (bf16_t*)(ws + OFF_W); bf16_t* UA = (bf16_t*)(ws + OFF_UA);
  const int G = gridDim.x, vcu = vcu_id();
  const float* xsrc = (c.layer == 0) ? c.in[0] : c.out;
  switch (k) {
    case 0: {
      if (c.layer == 0) mark(0);
      rmsnorm_rows(xsrc, c.inp(1, 1024), H);
      if (c.layer == 0) mark(1);
      if (c.layer == 0) rope_table(c);
      if (c.layer == 0) mark(2);
      if (c.layer == 0) mark(3);
      unsigned* ctr = (unsigned*)(ws + OFF_CTL) + 4 + c.layer;
      for (;;) {
        const int u = next_unit(ctr);
        if (u >= 578 + 256) break;
        if (u >= 578) s5_mats_unit(c, u - 578);
        else if (u < 368) xpose_tile(c.inp(2, (size_t)1024 * DIN), 1024, DIN, W + W_IN, nullptr, u);
        else if (u < 386) xpose_tile(c.inp(4, 384 * 768), 384, 768, W + W_UQ, c.inp(3, 384), u - 368);
        else if (u < 402) xpose_tile(c.inp(6, 256 * 1024), 256, 1024, W + W_UKV, c.inp(5, 256), u - 386);
        else if (u < 418) xpose_tile(c.inp(20, 512 * 512), 512, 512, W + W_GLU, nullptr, u - 402);
        else if (u < 514) { const int v = u - 418, br = v >> 5; xpose_tile(c.inp(22 + br, 512 * 1024), 512, 1024, W + W_BR + (size_t)br * 1024 * 512, nullptr, v & 31); }
        else xpose_tile(c.inp(26, 1024 * 1024), 1024, 1024, W + W_OUT, nullptr, u - 514);
      }
      if (c.layer == 0) mark(4);
    } break;
    case 1: {
      const EpiG1 e{Z, UA};
      gemm_phase<1024, 1024, 1024>(H, W + W_IN, 128 * 11, 11, e);
    } break;
    case 2: {
      for (int u = vcu; u < 896 + 256 + 2048; u += G) {
        if (u < 384) { const EpiP2 e{0, (bf16_t*)(ws + OFF_QRAW), 768, nullptr}; gemm_tile<ZLD, 384, 384>(Z + C_CQ, W + W_UQ, (u / 3) * 256, (u % 3) * 256, e); }
        else if (u < 896) { const int v = u - 384; const EpiP2 e{0, (bf16_t*)(ws + OFF_KVRAW), 1024, nullptr}; gemm_tile<ZLD, 256, 256>(Z + C_CKV, W + W_UKV, (v / 4) * 256, (v % 4) * 256, e); }
        else if (u < 1152) { const int v = u - 896, g = v >> 3, pm = v & 7; const EpiP2 e{1, nullptr, 0, (float*)(ws + OFF_EOA) + (size_t)g * 2048 * 128};
          gemm_tile<384, 256, 256>(UA + (size_t)g * 2048 * 384, (const bf16_t*)(ws + OFF_MATS) + (size_t)g * 65536, pm * 256, 0, e); }
        else gla_pass1(c, u - 1152);
      }
    } break;
    case 3: {
      if (c.layer == 0) mark(5);
      if (blockIdx.x < 128) s5_scan(c); else gla_scan(c, 128, G - 128);
      if (c.layer == 0) mark(6);
      unsigned* ctr = (unsigned*)(ws + OFF_CTL) + 2 + c.layer;
      for (int u = blockIdx.x; u < 2048; u += G) mla_finalize_unit(c, u);
      if (c.layer == 0) mark(7);
    } break;
    case 4: {
      unsigned* ctr = (unsigned*)(ws + OFF_CTL) + c.layer;
      for (;;) {
        const int u = next_unit(ctr);
        if (u >= 1024 + 256 + 2048) break;
        if (u < 1024) attn_unit(c, u);
        else if (u < 1280) { const int v = u - 1024, g = v >> 3, pm = v & 7; const EpiS5Y e{Z, g};
          gemm_tile<384, 384, 384>(UA + (size_t)g * 2048 * 384, (const bf16_t*)(ws + OFF_MY) + (size_t)g * 256 * 384, pm * 256, 0, e); }
        else gla_pass3(c, u - 1280);
      }
    } break;
    case 5: {
      const EpiGLU e{Z, c.inp(21, 512)};
      gemm_phase<ZLD, 512, 512>(Z + C_SU, W + W_GLU, 256, 2, e);
    } break;
    case 6: {
      uint2* scr = (uint2*)(ws + OFF_SCR) + (size_t)blockIdx.x * 16384;
      bf16_t* M = (bf16_t*)(ws + OFF_MERGED);
      int u = vcu;
      if (u < 512) {
        asm volatile("s_waitcnt vmcnt(0) lgkmcnt(0)" ::: "memory");
        __builtin_amdgcn_s_barrier();
        gemm_issue<ZLD, 512>(Z, W + W_BR, (u / 4) * 256, (u % 4) * 256);
        for (; u < 512; u += G) {
          const int brow = (u / 4) * 256, bcol = (u % 4) * 256;
          for (int br = 0; br < 3; ++br) {
            int tidx; asm volatile("v_mov_b32 %0, %1" : "=v"(tidx) : "v"(threadIdx.x));
            const int wid = tidx >> 6, lane = tidx & 63;
            const bf16_t* Wg = W + W_IN + (size_t)(ZLD + br * 1024) * 1024;
            const bf16_t* Wb = W + W_BR + (size_t)br * 1024 * 512;
            const bf16_t* Ab = Z + (br == 0 ? 0 : (br == 1 ? C_GV : C_GR));
            const bf16_t* Abn = Z + (br == 0 ? C_GV : (br == 1 ? C_GR : 0));
            {
              f32x4 acc[2][2][4][2];
              gemm_main<ZLD, 512, 512>(Ab, Wb, brow, bcol, acc);
              gemm_issue<1024, 1024>(H, Wg, brow, bcol);
              const EpiP6 e0{0, scr, M, c.inp(25, 3072) + br * 1024, br};
              e0(acc, brow, bcol, wid >> 2, wid & 3, lane & 15, lane >> 4);
            }
            {
              f32x4 acc[2][2][4][2];
              gemm_main<1024, 1024, 1024>(H, Wg, brow, bcol, acc);
              if (br < 2) gemm_issue<ZLD, 512>(Abn, Wb + 1024 * 512, brow, bcol);
              else if (u + G < 512) gemm_issue<ZLD, 512>(Abn, W + W_BR, ((u + G) / 4) * 256, ((u + G) % 4) * 256);
              const EpiP6 e1{1, scr, M, c.inp(25, 3072) + br * 1024, br};
              e1(acc, brow, bcol, wid >> 2, wid & 3, lane & 15, lane >> 4);
            }
          }
        }
      }
    } break;
    case 7: {
      const EpiResid e{xsrc, c.out};
      gemm_phase<1024, 1024, 1024>((const bf16_t*)(ws + OFF_MERGED), W + W_OUT, 512, 4, e);
    } break;
    case 8: {
      rmsnorm_rows(c.out, c.inp(27, 1024), H);
      for (int u = vcu; u < 512; u += G) {
        if (u < 256) xpose_tile(c.inp(28, (size_t)1024 * 4096), 1024, 4096, (bf16_t*)(ws + OFF_WFF1), nullptr, u);
        else xpose_tile(c.inp(29, (size_t)4096 * 1024), 4096, 1024, (bf16_t*)(ws + OFF_WFF2), nullptr, u - 256);
      }
    } break;
    case 9: {
      const EpiRelu2 e{(bf16_t*)(ws + OFF_FFH)};
      gemm_phase<1024, 1024, 1024>(H, (const bf16_t*)(ws + OFF_WFF1), 128 * 16, 16, e);
    } break;
    case 10: {
      const EpiResid e{c.out, c.out};
      gemm_phase<4096, 4096, 4096>((const bf16_t*)(ws + OFF_FFH), (const bf16_t*)(ws + OFF_WFF2), 512, 4, e);
    } break;
  }
}

DI void grid_barrier(unsigned* ctr, unsigned target) {
  asm volatile("s_waitcnt vmcnt(0)" ::: "memory");
  __syncthreads();
  if (threadIdx.x == 0) {
    __builtin_amdgcn_fence(__ATOMIC_RELEASE, "agent");
    asm volatile("s_waitcnt vmcnt(0)" ::: "memory");
    __hip_atomic_fetch_add(ctr, 1u, __ATOMIC_RELAXED, __HIP_MEMORY_SCOPE_AGENT);
    while (__hip_atomic_load(ctr, __ATOMIC_RELAXED, __HIP_MEMORY_SCOPE_AGENT) < target) __builtin_amdgcn_s_sleep(2);
    __builtin_amdgcn_fence(__ATOMIC_ACQUIRE, "agent");
    asm volatile("s_waitcnt vmcnt(0)" ::: "memory");
  }
  __syncthreads();
}

__global__ void __launch_bounds__(NTHR) mega(Params p) {
  cg::grid_group grid = cg::this_grid();
  Ctx c{p, p.in, p.out, p.ws, 0};
  const int lo = p.ph_lo, hi = p.ph_hi;
  unsigned* bar = (unsigned*)(p.ws + OFF_CTL) + 64;
  const unsigned G_ = gridDim.x;
#define PH(k) if (lo <= (k) && (k) < hi) { c.layer = (k) / N_PH_LAYER; run_phase(c, (k) % N_PH_LAYER); \
    if ((k) + 1 < hi) { if ((k) == lo) grid.sync(); else grid_barrier(bar, (unsigned)((k) - lo) * G_); } }
  PH(0) PH(1) PH(2) PH(3) PH(4) PH(5) PH(6) PH(7) PH(8) PH(9) PH(10)
  PH(11) PH(12) PH(13) PH(14) PH(15) PH(16) PH(17) PH(18) PH(19) PH(20) PH(21)
#undef PH
  if (PROBE_A >= 0 && blockIdx.x == 0) {
    extern __shared__ __attribute__((aligned(16))) unsigned char smem[];
    volatile unsigned long long* mk = (volatile unsigned long long*)(smem + LDS_UNIT_OFF - 8 * 33);
    const unsigned long long dt = mk[PROBE_B] - mk[PROBE_A];
    const unsigned long long t0 = wall_clock64(); while (wall_clock64() - t0 < dt * 4ull) { __builtin_amdgcn_s_sleep(8); }
  }
}

#ifndef MULTI_LAUNCH
#define MULTI_LAUNCH 0
#endif

extern "C" void kernel_launch(void* const* d_in, const int* in_sizes, int n_in,
                              void* d_out, int out_size, void* d_ws, size_t ws_size,
                              hipStream_t stream) {
  static int grid_blocks = 0;
  if (!grid_blocks) {
    if (n_in != 30 || out_size != T_ * D_ || ws_size < WS_END) { fprintf(stderr, "kernel_launch: unexpected shapes n_in=%d out=%d ws=%zu (need %zu)\n", n_in, out_size, ws_size, (size_t)WS_END); grid_blocks = -1; return; }
    int dev = 0, cus = 0, per_cu = 0;
    hipGetDevice(&dev);
    hipDeviceGetAttribute(&cus, hipDeviceAttributeMultiprocessorCount, dev);
    hipFuncSetAttribute((const void*)mega, hipFuncAttributeMaxDynamicSharedMemorySize, LDS_BYTES);
    hipOccupancyMaxActiveBlocksPerMultiprocessor(&per_cu, (const void*)mega, NTHR, LDS_BYTES);
    fprintf(stderr, "cus=%d per_cu=%d ws_size=%zu\n", cus, per_cu, ws_size);
    if (per_cu < 1) { fprintf(stderr, "kernel_launch: occupancy query says 0 blocks/CU\n"); grid_blocks = -1; return; }
    grid_blocks = cus;
  }
  if (grid_blocks < 0) return;
  hipMemsetAsync((char*)d_ws + OFF_CTL, 0, 4096, stream);
  Params p{};
  for (int i = 0; i < 30; ++i) p.in[i] = (const float*)d_in[i];
  p.out = (float*)d_out; p.ws = (unsigned char*)d_ws;
#if MULTI_LAUNCH
  for (int ph = 0; ph < 2 * N_PH_LAYER; ++ph) {
    p.ph_lo = ph; p.ph_hi = ph + 1;
    hipLaunchKernelGGL(mega, dim3(grid_blocks), dim3(NTHR), LDS_BYTES, stream, p);
  }
#else
  p.ph_lo = 0; p.ph_hi = 2 * N_PH_LAYER;
  void* args[] = {&p};
  hipError_t e = hipLaunchCooperativeKernel((void*)mega, dim3(grid_blocks), dim3(NTHR), args, LDS_BYTES, stream);
  if (e != hipSuccess) fprintf(stderr, "coop launch failed: %s\n", hipGetErrorString(e));
#endif
}
```

```cpp
#include <hip/hip_runtime.h>
#include <hip/hip_cooperative_groups.h>
#include <cstdio>
#include <cstdint>
namespace cg = cooperative_groups;

#define DI __device__ __forceinline__
typedef unsigned short bf16_t;
typedef short bf16x8 __attribute__((ext_vector_type(8)));
typedef short s16x4 __attribute__((ext_vector_type(4)));
typedef float f32x4 __attribute__((ext_vector_type(4)));
typedef float f32x16 __attribute__((ext_vector_type(16)));

constexpr int T_ = 32768, L_ = 8192, D_ = 1024, DIN = 5808, DFF = 4096;
constexpr int ZLD = 2736;
constexpr int C_CQ = 0, C_CKV = 384, C_KPE = 640, C_GQ = 672, C_GK = 928, C_GV = 1184, C_GLR = 1696, C_GR = 1712, C_SU = 2224;
constexpr float EPS = 1e-6f;
constexpr int NTHR = 512;
constexpr int LDS_BYTES = 147456;
constexpr int LDS_UNIT_OFF = LDS_BYTES - 16;

constexpr size_t OFF_Z = 0;
constexpr size_t OFF_QRAW = 179306496;
constexpr size_t OFF_KVRAW = OFF_QRAW + 50331648;
constexpr size_t OFF_KPE2 = OFF_KVRAW + 67108864;
constexpr size_t OFF_EOA = OFF_KPE2 + 16777216;
constexpr size_t OFF_H = OFF_EOA + 33554432;
constexpr size_t OFF_GS = OFF_H + 67108864;
constexpr size_t OFF_UA = OFF_GS + 33554432;
constexpr size_t OFF_W = OFF_UA + 50331648;
constexpr size_t W_IN = 0, W_UQ = W_IN + (size_t)DIN * 1024, W_UKV = W_UQ + 768 * 384, W_GLU = W_UKV + 1024 * 256,
                 W_BR = W_GLU + 512 * 512, W_OUT = W_BR + 3 * 1024 * 512, W_END = W_OUT + 1024 * 1024;
constexpr size_t OFF_MATS = OFF_W + ((W_END * 2 + 255) / 256) * 256;
constexpr size_t OFF_MY = OFF_MATS + 32 * 256 * 256 * 2;
constexpr size_t OFF_ROPE = OFF_MY + 32 * 256 * 384 * 2;
constexpr size_t OFF_GDEC = OFF_ROPE + 2 * 8192 * 16 * 4;
constexpr size_t OFF_CTL = OFF_GDEC + 2048 * 64 * 4;
constexpr size_t WS_END = OFF_CTL + 4096;
constexpr size_t OFF_FFH = OFF_Z;
constexpr size_t OFF_MERGED = OFF_QRAW;
constexpr size_t OFF_SCR = OFF_GS;
constexpr size_t OFF_WFF1 = OFF_UA, OFF_WFF2 = OFF_UA + (size_t)4096 * 1024 * 2;
static_assert(WS_END <= 536870912ull, "workspace");
static_assert((size_t)T_ * 4096 * 2 <= OFF_KPE2, "ffh overlay");

struct Params { const float* in[30]; float* out; unsigned char* ws; int ph_lo, ph_hi; };

struct Ctx {
  const Params& P;
  const float* const* in; float* out; unsigned char* ws;
  int layer;
  DI const float* inp(int i, size_t per_layer) const { return P.in[i] + (size_t)layer * per_layer; }
};

DI bf16_t f2bf(float x) { unsigned u = __float_as_uint(x); u += 0x7fffu + ((u >> 16) & 1u); return (bf16_t)(u >> 16); }
DI float bf2f(bf16_t b) { return __uint_as_float(((unsigned)b) << 16); }
typedef __bf16 bf2_t __attribute__((ext_vector_type(2)));
typedef float f32x2 __attribute__((ext_vector_type(2)));
DI unsigned pack2(float lo, float hi) { f32x2 v; v.x = lo; v.y = hi; return __builtin_bit_cast(unsigned, __builtin_convertvector(v, bf2_t)); }
DI float wave_sum(float v) {
#pragma unroll
  for (int o = 32; o; o >>= 1) v += __shfl_xor(v, o);
  return v;
}
DI float sigmoidf_(float x) { return 1.f / (1.f + __expf(-x)); }
DI void store4bf(bf16_t* p, const f32x4& v) { uint2 w; w.x = pack2(v[0], v[1]); w.y = pack2(v[2], v[3]); *(uint2*)p = w; }
DI f32x4 load4bf(const bf16_t* p) { uint2 w = *(const uint2*)p; f32x4 v; v[0] = __uint_as_float(w.x << 16); v[1] = __uint_as_float(w.x & 0xffff0000u); v[2] = __uint_as_float(w.y << 16); v[3] = __uint_as_float(w.y & 0xffff0000u); return v; }

constexpr int BK = 64, HALF = 128, HT = HALF * BK;
DI int lds_byte(int r, int c) { int st = (r >> 4) * 2 + (c >> 5), rr = r & 15, cc = c & 31, ob = rr * 64 + cc * 2; return st * 1024 + (ob ^ (((ob >> 9) & 1) << 5)); }
DI void stage_rc(int b, int& R, int& C) { int st = b / 1024, sb = b % 1024, swz = sb ^ (((sb >> 9) & 1) << 5); R = (st >> 1) * 16 + swz / 64; C = (st & 1) * 32 + (swz % 64) / 2; }

#define FOR_ACC(...) \
  _Pragma("unroll") for (int ai = 0; ai < 2; ++ai) { _Pragma("unroll") for (int m = 0; m < 4; ++m) { const int row = brow + ai * 128 + wr * 64 + m * 16 + fr; \
  _Pragma("unroll") for (int bj = 0; bj < 2; ++bj) _Pragma("unroll") for (int n = 0; n < 2; ++n) { const int col = bcol + bj * 128 + wc * 32 + n * 16 + fq * 4; const f32x4 v = acc[ai][bj][m][n]; __VA_ARGS__ } } asm volatile("" ::: "memory"); }

#define SA(b, h) (shm + ((b) * 2 + (h)) * HT)
#define SB(b, h) (shm + (4 + (b) * 2 + (h)) * HT)
#define STAGE(P, BASE, LD, VO, br, kt) do { const char* _g = (const char*)((BASE) + (long)(br) * (LD) + (long)(kt) * BK); \
    for (int _i = 0; _i < 2; ++_i) { \
      __builtin_amdgcn_global_load_lds((const unsigned*)(_g + VO[_i]), (unsigned*)((char*)(P) + tidx * 16 + _i * 8192), 16, 0, 0); } } while (0)
#define LDA(dst, b, h) for (int m = 0; m < 4; ++m) for (int k = 0; k < 2; ++k) \
    dst[m][k] = *reinterpret_cast<const bf16x8*>((char*)SA(b, h) + lds_byte(wr * 64 + m * 16 + fr, k * 32 + fq * 8))
#define LDB(dst, b, h) for (int n = 0; n < 2; ++n) for (int k = 0; k < 2; ++k) \
    dst[n][k] = *reinterpret_cast<const bf16x8*>((char*)SB(b, h) + lds_byte(wc * 32 + n * 16 + fr, k * 32 + fq * 8))
#define MMA(ai, bj, At, Bf) do { __builtin_amdgcn_s_setprio(1); \
    for (int m = 0; m < 4; ++m) for (int n = 0; n < 2; ++n) for (int k = 0; k < 2; ++k) \
      acc[ai][bj][m][n] = __builtin_amdgcn_mfma_f32_16x16x32_bf16(Bf[n][k], At[m][k], acc[ai][bj][m][n], 0, 0, 0); \
    __builtin_amdgcn_s_setprio(0); } while (0)
#define WAIT_V(n) asm volatile("s_waitcnt vmcnt(" #n ")" ::: "memory")
#define WAIT_L(n) asm volatile("s_waitcnt lgkmcnt(" #n ")" ::: "memory")
#define BAR __builtin_amdgcn_s_barrier()
#define SCHED __builtin_amdgcn_sched_barrier(0)
#define GEMM_TID \
  int tidx; asm volatile("v_mov_b32 %0, %1" : "=v"(tidx) : "v"(threadIdx.x)); \
  unsigned voA[2], voB[2]; \
  for (int i = 0; i < 2; ++i) { int r_, c_; stage_rc(tidx * 16 + i * 8192, r_, c_); voA[i] = (unsigned)(r_ * lda + c_) * 2u; voB[i] = (unsigned)(r_ * ldb + c_) * 2u; }

template <int lda, int ldb>
DI void gemm_issue(const bf16_t* __restrict__ A, const bf16_t* __restrict__ Bt, int brow, int bcol) {
  extern __shared__ __attribute__((aligned(16))) unsigned char smem[];
  bf16_t* shm = (bf16_t*)smem;
  GEMM_TID
  STAGE(SB(0, 0), Bt, ldb, voB, bcol, 0); STAGE(SA(0, 0), A, lda, voA, brow, 0);
  STAGE(SB(0, 1), Bt, ldb, voB, bcol + HALF, 0); STAGE(SA(0, 1), A, lda, voA, brow + HALF, 0);
}

template <int lda, int ldb, int K>
DI void gemm_main(const bf16_t* __restrict__ A, const bf16_t* __restrict__ Bt, int brow, int bcol, f32x4 (&acc)[2][2][4][2]) {
  extern __shared__ __attribute__((aligned(16))) unsigned char smem[];
  bf16_t* shm = (bf16_t*)smem;
  GEMM_TID
  const int wid = tidx >> 6, lane = tidx & 63, wr = wid >> 2, wc = wid & 3, fr = lane & 15, fq = lane >> 4;
#pragma unroll
  for (int a = 0; a < 2; ++a)
#pragma unroll
    for (int b = 0; b < 2; ++b)
#pragma unroll
      for (int m = 0; m < 4; ++m)
#pragma unroll
        for (int n = 0; n < 2; ++n) acc[a][b][m][n] = (f32x4){0.f, 0.f, 0.f, 0.f};
  bf16x8 At[4][2], B0[2][2], B1[2][2];
  const int nt = K / BK;
  if (wr == 1) BAR;
  WAIT_V(4); BAR;
  STAGE(SB(1, 0), Bt, ldb, voB, bcol, 1); STAGE(SA(1, 0), A, lda, voA, brow, 1); STAGE(SB(1, 1), Bt, ldb, voB, bcol + HALF, 1);
  WAIT_V(6); BAR;
  for (int t = 0; t < nt - 2; t += 2) {
    LDB(B0, 0, 0); SCHED; LDA(At, 0, 0); STAGE(SA(1, 1), A, lda, voA, brow + HALF, t + 1);
    WAIT_L(8); BAR; WAIT_L(0); MMA(0, 0, At, B0); BAR; SCHED;
    LDB(B1, 0, 1); STAGE(SB(0, 0), Bt, ldb, voB, bcol, t + 2);
    BAR; WAIT_L(0); MMA(0, 1, At, B1); BAR;
    LDA(At, 0, 1); STAGE(SA(0, 0), A, lda, voA, brow, t + 2);
    BAR; WAIT_L(0); MMA(1, 0, At, B0); BAR; SCHED;
    STAGE(SB(0, 1), Bt, ldb, voB, bcol + HALF, t + 2);
    WAIT_V(6); BAR; MMA(1, 1, At, B1); BAR;
    LDB(B0, 1, 0); SCHED; LDA(At, 1, 0); STAGE(SA(0, 1), A, lda, voA, brow + HALF, t + 2);
    WAIT_L(8); BAR; WAIT_L(0); MMA(0, 0, At, B0); BAR; SCHED;
    LDB(B1, 1, 1); STAGE(SB(1, 0), Bt, ldb, voB, bcol, t + 3);
    BAR; WAIT_L(0); MMA(0, 1, At, B1); BAR;
    LDA(At, 1, 1); STAGE(SA(1, 0), A, lda, voA, brow, t + 3);
    BAR; WAIT_L(0); MMA(1, 0, At, B0); BAR; SCHED;
    STAGE(SB(1, 1), Bt, ldb, voB, bcol + HALF, t + 3);
    WAIT_V(6); BAR; MMA(1, 1, At, B1); BAR;
  }
  { LDB(B0, 0, 0); LDA(At, 0, 0); STAGE(SA(1, 1), A, lda, voA, brow + HALF, nt - 1);
    BAR; WAIT_L(0); MMA(0, 0, At, B0); BAR;
    LDB(B1, 0, 1); BAR; WAIT_L(0); MMA(0, 1, At, B1); BAR;
    LDA(At, 0, 1); WAIT_V(4); BAR; WAIT_L(0); MMA(1, 0, At, B0); MMA(1, 1, At, B1); BAR; }
  { LDB(B0, 1, 0); LDA(At, 1, 0); WAIT_V(2); BAR; WAIT_L(0); MMA(0, 0, At, B0); BAR;
    LDB(B1, 1, 1); WAIT_V(0); BAR; WAIT_L(0); MMA(0, 1, At, B1); BAR;
    LDA(At, 1, 1); BAR; WAIT_L(0); MMA(1, 0, At, B0); MMA(1, 1, At, B1); BAR; }
  if (wr == 0) BAR;
}

template <int lda, int ldb, int K, class Epi>
DI void gemm_tile(const bf16_t* __restrict__ A, const bf16_t* __restrict__ Bt, int brow, int bcol, const Epi& epi) {
  asm volatile("s_waitcnt vmcnt(0) lgkmcnt(0)" ::: "memory");
  __builtin_amdgcn_s_barrier();
  gemm_issue<lda, ldb>(A, Bt, brow, bcol);
  f32x4 acc[2][2][4][2];
  gemm_main<lda, ldb, K>(A, Bt, brow, bcol, acc);
  int tidx; asm volatile("v_mov_b32 %0, %1" : "=v"(tidx) : "v"(threadIdx.x));
  const int wid = tidx >> 6, lane = tidx & 63;
  epi(acc, brow, bcol, wid >> 2, wid & 3, lane & 15, lane >> 4);
}

DI int vcu_id();
template <int lda, int ldb, int K, class Epi>
DI void gemm_phase(const bf16_t* __restrict__ A, const bf16_t* __restrict__ Bt, int ntiles, int nN, const Epi& epi) {
  const int G = gridDim.x; int u = vcu_id();
  if (u >= ntiles) return;
  asm volatile("s_waitcnt vmcnt(0) lgkmcnt(0)" ::: "memory");
  __builtin_amdgcn_s_barrier();
  gemm_issue<lda, ldb>(A, Bt, (u / nN) * 256, (u % nN) * 256);
  for (; u < ntiles; u += G) {
    const int brow = (u / nN) * 256, bcol = (u % nN) * 256;
    f32x4 acc[2][2][4][2];
    gemm_main<lda, ldb, K>(A, Bt, brow, bcol, acc);
    const int un = u + G;
    if (un < ntiles) gemm_issue<lda, ldb>(A, Bt, (un / nN) * 256, (un % nN) * 256);
    int tidx; asm volatile("v_mov_b32 %0, %1" : "=v"(tidx) : "v"(threadIdx.x));
    const int wid = tidx >> 6, lane = tidx & 63;
    epi(acc, brow, bcol, wid >> 2, wid & 3, lane & 15, lane >> 4);
  }
}

DI int vcu_id() { const int G = gridDim.x, bx = blockIdx.x; return (G % 8 == 0) ? (bx % 8) * (G / 8) + bx / 8 : bx; }

typedef const f32x4 (&AccRef)[2][2][4][2];
struct EpiG1 { bf16_t* Z; bf16_t* UA;
  DI void operator()(AccRef acc, int brow, int bcol, int wr, int wc, int fr, int fq) const {
    FOR_ACC(
      if (col < C_SU) { store4bf(Z + (size_t)row * ZLD + col, v); }
      else if (col < ZLD) { const int cc = col - C_SU, g = cc >> 4, i = cc & 15; store4bf(UA + ((size_t)(g * 2048 + (row >> 4)) * 384 + (row & 15) * 16 + i), v); }
    )
  } };
struct EpiBf16 { bf16_t* O; int ldc;
  DI void operator()(AccRef acc, int brow, int bcol, int wr, int wc, int fr, int fq) const {
    FOR_ACC( store4bf(O + (size_t)row * ldc + col, v); )
  } };
struct EpiS5E { float* E;
  DI void operator()(AccRef acc, int brow, int bcol, int wr, int wc, int fr, int fq) const {
    FOR_ACC( if (col < 128) { *(f32x4*)(E + (size_t)row * 128 + col) = v; } )
  } };
DI float gelu_tanh(float x) { const float z = 0.7978845608028654f * (x + 0.044715f * x * x * x); const float t = 1.f - 2.f / (__expf(2.f * z) + 1.f); return 0.5f * x * (1.f + t); }
struct EpiS5Y { bf16_t* Z; int g;
  DI void operator()(AccRef acc, int brow, int bcol, int wr, int wc, int fr, int fq) const {
    FOR_ACC(
      const int j = col >> 4, i = col & 15;
      const size_t t = (size_t)(row >> 9) * 8192 + (size_t)(row & 511) * 16 + j;
      f32x4 o; o[0] = gelu_tanh(v[0]); o[1] = gelu_tanh(v[1]); o[2] = gelu_tanh(v[2]); o[3] = gelu_tanh(v[3]);
      store4bf(Z + t * ZLD + C_SU + g * 16 + i, o);
    )
  } };
struct EpiGLU { bf16_t* Z; const float* bias;
  DI void operator()(AccRef acc, int brow, int bcol, int wr, int wc, int fr, int fq) const {
    FOR_ACC(
      const f32x4 y = load4bf(Z + (size_t)row * ZLD + C_SU + col);
      const f32x4 b = *(const f32x4*)(bias + col);
      f32x4 o; for (int q = 0; q < 4; ++q) o[q] = y[q] * sigmoidf_(v[q] + b[q]);
      store4bf(Z + (size_t)row * ZLD + C_GR + col, o);
    )
  } };
struct EpiScr { uint2* scr;
  DI void operator()(AccRef acc, int brow, int bcol, int wr, int wc, int fr, int fq) const {
    FOR_ACC( uint2 w; w.x = pack2(v[0], v[1]); w.y = pack2(v[2], v[3]); scr[(((ai * 2 + bj) * 4 + m) * 2 + n) * NTHR + threadIdx.x] = w; )
  } };
struct EpiGate { const uint2* scr; bf16_t* M; const float* gb; int br;
  DI void operator()(AccRef acc, int brow, int bcol, int wr, int wc, int fr, int fq) const {
    FOR_ACC(
      const uint2 w = scr[(((ai * 2 + bj) * 4 + m) * 2 + n) * NTHR + threadIdx.x];
      f32x4 p; p[0] = __uint_as_float(w.x << 16); p[1] = __uint_as_float(w.x & 0xffff0000u); p[2] = __uint_as_float(w.y << 16); p[3] = __uint_as_float(w.y & 0xffff0000u);
      const f32x4 b = *(const f32x4*)(gb + col);
      bf16_t* dst = M + (size_t)row * 1024 + col;
      f32x4 o = {0.f, 0.f, 0.f, 0.f};
      if (br > 0) o = load4bf(dst);
      for (int q = 0; q < 4; ++q) o[q] += sigmoidf_(v[q] + b[q]) * p[q];
      store4bf(dst, o);
    )
  } };
struct EpiP2 { int kind; bf16_t* O; int ldc; float* E;
  DI void operator()(AccRef acc, int brow, int bcol, int wr, int wc, int fr, int fq) const {
    if (kind == 0) { FOR_ACC( store4bf(O + (size_t)row * ldc + col, v); ) }
    else { FOR_ACC( if (col < 128) { *(f32x4*)(E + (size_t)row * 128 + col) = v; } ) }
  } };
struct EpiP6 { int kind; uint2* scr; bf16_t* M; const float* gb; int br;
  DI void operator()(AccRef acc, int brow, int bcol, int wr, int wc, int fr, int fq) const {
    uint2* sl = scr + (((wr * 4 + wc) * 4 + fq) * 16 + fr);
    asm volatile("" : "+v"(sl));
    if (kind == 0) { FOR_ACC( uint2 w; w.x = pack2(v[0], v[1]); w.y = pack2(v[2], v[3]); sl[(((ai * 2 + bj) * 4 + m) * 2 + n) * NTHR] = w; ) }
    else {
      FOR_ACC(
        const uint2 w = sl[(((ai * 2 + bj) * 4 + m) * 2 + n) * NTHR];
        f32x4 p; p[0] = __uint_as_float(w.x << 16); p[1] = __uint_as_float(w.x & 0xffff0000u); p[2] = __uint_as_float(w.y << 16); p[3] = __uint_as_float(w.y & 0xffff0000u);
        const f32x4 b = *(const f32x4*)(gb + col);
        bf16_t* dst = M + (size_t)row * 1024 + col;
        f32x4 o = {0.f, 0.f, 0.f, 0.f};
        if (br > 0) o = load4bf(dst);
        for (int q = 0; q < 4; ++q) o[q] += sigmoidf_(v[q] + b[q]) * p[q];
        store4bf(dst, o);
      )
    }
  } };
struct EpiResid { const float* src; float* dst;
  DI void operator()(AccRef acc, int brow, int bcol, int wr, int wc, int fr, int fq) const {
    FOR_ACC(
      const f32x4 x = *(const f32x4*)(src + (size_t)row * 1024 + col);
      *(f32x4*)(dst + (size_t)row * 1024 + col) = x + v;
    )
  } };
struct EpiRelu2 { bf16_t* O;
  DI void operator()(AccRef acc, int brow, int bcol, int wr, int wc, int fr, int fq) const {
    FOR_ACC( f32x4 o; for (int q = 0; q < 4; ++q) { const float r = fmaxf(v[q], 0.f); o[q] = r * r; } store4bf(O + (size_t)row * DFF + col, o); )
  } };

DI void rmsnorm_rows(const float* __restrict__ src, const float* __restrict__ g, bf16_t* __restrict__ dst) {
  const int wave = threadIdx.x >> 6, lane = threadIdx.x & 63;
  f32x4 gv[4];
#pragma unroll
  for (int i = 0; i < 4; ++i) gv[i] = *(const f32x4*)(g + lane * 4 + 256 * i);
  for (int row = (blockIdx.x * 8 + wave) * 2; row < T_; row += gridDim.x * 16) {
    f32x4 x[8]; float ss0 = 0.f, ss1 = 0.f;
#pragma unroll
    for (int i = 0; i < 8; ++i) x[i] = *(const f32x4*)(src + (size_t)(row + (i >> 2)) * 1024 + lane * 4 + 256 * (i & 3));
#pragma unroll
    for (int i = 0; i < 4; ++i) { ss0 += x[i][0] * x[i][0] + x[i][1] * x[i][1] + x[i][2] * x[i][2] + x[i][3] * x[i][3]; ss1 += x[i + 4][0] * x[i + 4][0] + x[i + 4][1] * x[i + 4][1] + x[i + 4][2] * x[i + 4][2] + x[i + 4][3] * x[i + 4][3]; }
    ss0 = wave_sum(ss0); ss1 = wave_sum(ss1);
    const float rs0 = rsqrtf(ss0 * (1.f / 1024.f) + EPS), rs1 = rsqrtf(ss1 * (1.f / 1024.f) + EPS);
#pragma unroll
    for (int i = 0; i < 8; ++i) { f32x4 o = x[i] * ((i >> 2) ? rs1 : rs0) * gv[i & 3]; store4bf(dst + (size_t)(row + (i >> 2)) * 1024 + lane * 4 + 256 * (i & 3), o); }
  }
}

DI void xpose_tile(const float* __restrict__ src, int Kd, int Nd, bf16_t* __restrict__ dst, const float* __restrict__ gs, int tix) {
  extern __shared__ __attribute__((aligned(16))) unsigned char smem[];
  float* tile = (float*)smem;
  const int tk = Kd >> 7;
  const int k0 = (tix % tk) * 128, n0 = (tix / tk) * 128;
  const int tid = threadIdx.x;
  __syncthreads();
  f32x4 v[8];
#pragma unroll
  for (int i = 0; i < 8; ++i) { const int r = (tid >> 5) + 16 * i, cq = (tid & 31) * 4; const int n = n0 + cq;
    v[i] = (n + 3 < Nd) ? *(const f32x4*)(src + (size_t)(k0 + r) * Nd + n) : (f32x4){0.f, 0.f, 0.f, 0.f}; }
#pragma unroll
  for (int i = 0; i < 8; ++i) { const int r = (tid >> 5) + 16 * i, cq = (tid & 31) * 4; const float sc = gs ? gs[k0 + r] : 1.f;
    tile[r * 129 + cq] = v[i][0] * sc; tile[r * 129 + cq + 1] = v[i][1] * sc; tile[r * 129 + cq + 2] = v[i][2] * sc; tile[r * 129 + cq + 3] = v[i][3] * sc; }
  __syncthreads();
#pragma unroll
  for (int i = 0; i < 4; ++i) { const int n = tid & 127, kc = ((tid >> 7) + 4 * i) * 8;
    if (n0 + n < Nd) { uint4 w;
      w.x = pack2(tile[(kc + 0) * 129 + n], tile[(kc + 1) * 129 + n]); w.y = pack2(tile[(kc + 2) * 129 + n], tile[(kc + 3) * 129 + n]);
      w.z = pack2(tile[(kc + 4) * 129 + n], tile[(kc + 5) * 129 + n]); w.w = pack2(tile[(kc + 6) * 129 + n], tile[(kc + 7) * 129 + n]);
      *(uint4*)(dst + (size_t)(n0 + n) * Kd + k0 + kc) = w; } }
}

DI void s5_mats_unit(const Ctx& c, int unit) {
  extern __shared__ __attribute__((aligned(16))) unsigned char smem[];
  float* lp_re = (float*)smem;
  float* lp_im = lp_re + 17 * 64;
  float* bb_re = lp_im + 17 * 64;
  float* bb_im = bb_re + 1024;
  float* cr = bb_im + 1024;
  float* ci = cr + 1024;
  float* Kt = ci + 1024;
  float* dv = Kt + 4096;
  const int tid = threadIdx.x;
  bf16_t* ME = (bf16_t*)(c.ws + OFF_MATS);
  bf16_t* MY = (bf16_t*)(c.ws + OFF_MY);
  const int g = unit >> 3, qpart = unit & 7;
  {
    __syncthreads();
    if (tid < 64) {
      const int p = tid;
      const float lre = fminf(c.inp(12, 2048)[g * 64 + p], -1e-4f), lim = c.inp(13, 2048)[g * 64 + p];
      const float step = expf(c.inp(19, 32)[g]);
      for (int d = 0; d <= 16; ++d) { const float mag = expf(lre * step * d); float s, co; sincosf(lim * step * d, &s, &co); lp_re[d * 64 + p] = mag * co; lp_im[d * 64 + p] = mag * s; }
      const float nr = lp_re[64 + p] - 1.f, ni = lp_im[64 + p];
      const float den = 1.f / (lre * lre + lim * lim);
      const float kr = (nr * lre + ni * lim) * den, ki = (ni * lre - nr * lim) * den;
      for (int i = 0; i < 16; ++i) { const float br = c.inp(14, 32768)[(g * 64 + p) * 16 + i], bi = c.inp(15, 32768)[(g * 64 + p) * 16 + i]; bb_re[p * 16 + i] = kr * br - ki * bi; bb_im[p * 16 + i] = kr * bi + ki * br; }
    }
    for (int i = tid; i < 1024; i += NTHR) { cr[i] = c.inp(16, 32768)[g * 1024 + i]; ci[i] = c.inp(17, 32768)[g * 1024 + i]; }
    if (tid < 16) dv[tid] = c.inp(18, 512)[g * 16 + tid];
    __syncthreads();
    for (int idx = tid; idx < 512 * (qpart + 1); idx += NTHR) {
      const int d = idx >> 8, i = (idx >> 4) & 15, i2 = idx & 15; float s = 0.f;
      for (int p = 0; p < 64; ++p) { const float lr = lp_re[d * 64 + p], li = lp_im[d * 64 + p], br = bb_re[p * 16 + i2], bi = bb_im[p * 16 + i2];
        const float wre = lr * br - li * bi, wim = lr * bi + li * br; s += cr[i * 64 + p] * wre - ci[i * 64 + p] * wim; }
      Kt[idx] = s;
    }
    __syncthreads();
    for (int idx = qpart * 32 * 384 + tid; idx < (qpart + 1) * 32 * 384; idx += NTHR) {
      const int n = idx / 384, k = idx % 384, j = n >> 4, i = n & 15; float val;
      if (k < 256) { const int j2 = k >> 4, i2 = k & 15; val = (j >= j2) ? Kt[((j - j2) * 16 + i) * 16 + i2] + ((j == j2 && i == i2) ? dv[i] : 0.f) : 0.f; }
      else if (k < 320) { const int p = k - 256; val = cr[i * 64 + p] * lp_re[(j + 1) * 64 + p] - ci[i * 64 + p] * lp_im[(j + 1) * 64 + p]; }
      else { const int p = k - 320; val = -(cr[i * 64 + p] * lp_im[(j + 1) * 64 + p] + ci[i * 64 + p] * lp_re[(j + 1) * 64 + p]); }
      MY[(size_t)g * 256 * 384 + idx] = f2bf(val);
    }
    for (int idx = qpart * 32 * 256 + tid; idx < (qpart + 1) * 32 * 256; idx += NTHR) {
      const int n = idx >> 8, k = idx & 255, j2 = k >> 4, i2 = k & 15; float val = 0.f;
      if (n < 128) { const int p = n & 63; const float lr = lp_re[(15 - j2) * 64 + p], li = lp_im[(15 - j2) * 64 + p], br = bb_re[p * 16 + i2], bi = bb_im[p * 16 + i2];
        val = (n < 64) ? (lr * br - li * bi) : (lr * bi + li * br); }
      ME[(size_t)g * 65536 + idx] = f2bf(val);
    }
  }
}

DI void rope_table(const Ctx& c) {
  float* cs = (float*)(c.ws + OFF_ROPE); float* sn = cs + 8192 * 16;
  for (int idx = blockIdx.x * NTHR + threadIdx.x; idx < 8192 * 16; idx += gridDim.x * NTHR) {
    const int pos = idx >> 4, i = idx & 15;
    const float invf = powf(10000.f, -(float)(2 * i) / 32.f);
    const float ang = (float)pos * invf;
    cs[idx] = (float)cos((double)ang); sn[idx] = (float)sin((double)ang);
  }
}

DI void unpack8(const uint4& w, float* f) {
  f[0] = __uint_as_float(w.x << 16); f[1] = __uint_as_float(w.x & 0xffff0000u); f[2] = __uint_as_float(w.y << 16); f[3] = __uint_as_float(w.y & 0xffff0000u);
  f[4] = __uint_as_float(w.z << 16); f[5] = __uint_as_float(w.z & 0xffff0000u); f[6] = __uint_as_float(w.w << 16); f[7] = __uint_as_float(w.w & 0xffff0000u);
}
struct GlaPre { uint4 glr; float wg0, wg1, bgv; };
DI GlaPre gla_preload(const Ctx& c, const bf16_t* Z, int t0, int h, int tid) {
  const float* wg = c.inp(9, 16 * 256); const float* bg = c.inp(10, 256);
  GlaPre p; p.glr = make_uint4(0, 0, 0, 0);
  if (tid < 128) p.glr = *(const uint4*)(Z + (size_t)(t0 + (tid >> 1)) * ZLD + C_GLR + (tid & 1) * 8);
  p.wg0 = wg[(tid >> 6) * 256 + h * 64 + (tid & 63)]; p.wg1 = wg[((tid + NTHR) >> 6) * 256 + h * 64 + (tid & 63)];
  p.bgv = bg[h * 64 + (tid & 63)];
  return p;
}
DI void gla_bc(const GlaPre& pre, int tid, float* glr_s, float* wg_s, float* bc_s) {
  if (tid < 128) { const int cc = tid >> 1, r0 = (tid & 1) * 8; float f[8]; unpack8(pre.glr, f);
#pragma unroll
    for (int i = 0; i < 8; ++i) glr_s[cc * 16 + r0 + i] = f[i]; }
  wg_s[tid] = pre.wg0; wg_s[tid + NTHR] = pre.wg1;
  __syncthreads();
  const int d = tid & 63, seg = tid >> 6;
  const float bgv = pre.bgv;
  float wv[16];
#pragma unroll
  for (int r = 0; r < 16; ++r) wv[r] = wg_s[r * 64 + d];
  float run = 0.f, loc[8];
#pragma unroll
  for (int i = 0; i < 8; ++i) {
    const int cc = seg * 8 + i; float a = bgv;
#pragma unroll
    for (int r = 0; r < 16; ++r) a += glr_s[cc * 16 + r] * wv[r];
    run += (fminf(a, 0.f) - __logf(1.f + __expf(-fabsf(a)))) * (1.f / 16.f);
    loc[i] = run;
  }
  __syncthreads();
  glr_s[seg * 64 + d] = run;
  __syncthreads();
  float off = 0.f;
  for (int s2 = 0; s2 < seg; ++s2) off += glr_s[s2 * 64 + d];
#pragma unroll
  for (int i = 0; i < 8; ++i) bc_s[(seg * 8 + i) * 64 + d] = loc[i] + off;
  __syncthreads();
}

constexpr int GQS = 72;
DI void gla_pass1(const Ctx& c, int unit) {
  extern __shared__ __attribute__((aligned(16))) unsigned char smem[];
  float* glr_s = (float*)smem; float* wg_s = glr_s + 1024; float* bc_s = wg_s + 1024;
  bf16_t* vT = (bf16_t*)(smem + 24576);
  bf16_t* keT = (bf16_t*)(smem + 43008);
  const bf16_t* Z = (const bf16_t*)(c.ws + OFF_Z);
  int tid_; asm volatile("v_mov_b32 %0, %1" : "=v"(tid_) : "v"(threadIdx.x));
  const int tid = tid_, n = unit & 127, bh = unit >> 7, h = bh & 3, b = bh >> 2, t0 = b * L_ + n * 64;
  const int cc = tid & 63, ch = tid >> 6;
  const GlaPre pre = gla_preload(c, Z, t0, h, tid);
  const uint4 wkk = *(const uint4*)(Z + (size_t)(t0 + cc) * ZLD + C_GK + h * 64 + ch * 8);
  const uint4 wv0 = *(const uint4*)(Z + (size_t)(t0 + cc) * ZLD + C_GV + h * 128 + ch * 8), wv1 = *(const uint4*)(Z + (size_t)(t0 + cc) * ZLD + C_GV + h * 128 + (ch + 8) * 8);
  __syncthreads();
  gla_bc(pre, tid, glr_s, wg_s, bc_s);
  { const int d0 = ch * 8; float f[8]; unpack8(wkk, f);
#pragma unroll
    for (int i = 0; i < 8; ++i) keT[(d0 + i) * GQS + cc] = f2bf(f[i] * __expf(bc_s[63 * 64 + d0 + i] - bc_s[cc * 64 + d0 + i])); }
#pragma unroll
  for (int k = 0; k < 2; ++k) { const int e0 = (ch + 8 * k) * 8; const uint4 w = k ? wv1 : wv0;
    const unsigned ww[4] = {w.x, w.y, w.z, w.w};
#pragma unroll
    for (int i = 0; i < 4; ++i) { vT[(e0 + 2 * i) * GQS + cc] = (bf16_t)(ww[i] & 0xffffu); vT[(e0 + 2 * i + 1) * GQS + cc] = (bf16_t)(ww[i] >> 16); } }
  __syncthreads();
  const int wave = tid >> 6, lane = tid & 63, l32 = lane & 31, hb = lane >> 5, mt = wave >> 1, nt = wave & 1;
  f32x16 acc;
#pragma unroll
  for (int i = 0; i < 16; ++i) acc[i] = 0.f;
#pragma unroll
  for (int ks = 0; ks < 4; ++ks) {
    const bf16x8 a = *(const bf16x8*)(vT + (mt * 32 + l32) * GQS + ks * 16 + hb * 8);
    const bf16x8 bq = *(const bf16x8*)(keT + (nt * 32 + l32) * GQS + ks * 16 + hb * 8);
    acc = __builtin_amdgcn_mfma_f32_32x32x16_bf16(a, bq, acc, 0, 0, 0);
  }
  bf16_t* GS = (bf16_t*)(c.ws + OFF_GS) + (size_t)unit * 8192;
#pragma unroll
  for (int r = 0; r < 16; ++r) { const int e = mt * 32 + (r & 3) + 8 * (r >> 2) + 4 * hb; GS[e * 64 + nt * 32 + l32] = f2bf(acc[r]); }
  if (tid < 64) ((float*)(c.ws + OFF_GDEC))[unit * 64 + tid] = __expf(bc_s[63 * 64 + tid]);
}

DI void gla_scan(const Ctx& c, int first_block, int nblocks) {
  bf16_t* GS = (bf16_t*)(c.ws + OFF_GS); const float* dec = (const float*)(c.ws + OFF_GDEC);
  for (int idx = (blockIdx.x - first_block) * NTHR + threadIdx.x; idx < 8 * 8192; idx += nblocks * NTHR) {
    const int bh = idx >> 13, ed = idx & 8191, d = ed & 63;
    float S0 = 0.f, S1 = 0.f;
    bf16_t* p0 = GS + (size_t)bh * 128 * 8192 + ed; const float* dp0 = dec + bh * 128 * 64 + d;
    bf16_t* p1 = p0 + (size_t)8 * 128 * 8192; const float* dp1 = dp0 + 8 * 128 * 64;
#pragma unroll 8
    for (int n = 0; n < 128; ++n) {
      const float ds0 = bf2f(p0[(size_t)n * 8192]), ds1 = bf2f(p1[(size_t)n * 8192]); const float dc0 = dp0[n * 64], dc1 = dp1[n * 64];
      p0[(size_t)n * 8192] = f2bf(S0); p1[(size_t)n * 8192] = f2bf(S1); S0 = dc0 * S0 + ds0; S1 = dc1 * S1 + ds1; }
  }
}

DI void gla_pass3(const Ctx& c, int unit) {
  extern __shared__ __attribute__((aligned(16))) unsigned char smem[];
  float* glr_s = (float*)smem; float* wg_s = glr_s + 1024; float* bc_s = wg_s + 1024;
  bf16_t* qt = (bf16_t*)(smem + 24576);
  bf16_t* kt = (bf16_t*)(smem + 33792);
  bf16_t* vT = (bf16_t*)(smem + 43008);
  bf16_t* ST = (bf16_t*)(smem + 61440);
  bf16_t* As = (bf16_t*)(smem + 79872);
  float* o_s = (float*)(smem + 89088);
  float* red_s = (float*)(smem + 122880);
  bf16_t* Z = (bf16_t*)(c.ws + OFF_Z);
  int tid_; asm volatile("v_mov_b32 %0, %1" : "=v"(tid_) : "v"(threadIdx.x));
  const int tid = tid_, n = unit & 127, bh = unit >> 7, h = bh & 3, b = bh >> 2, t0 = b * L_ + n * 64;
  const bf16_t* GS = (const bf16_t*)(c.ws + OFF_GS) + (size_t)unit * 8192;
  const int cr_ = tid >> 3, d0_ = (tid & 7) * 8, cc_ = tid & 63, ch_ = tid >> 6;
  const GlaPre pre = gla_preload(c, Z, t0, h, tid);
  const uint4 wq = *(const uint4*)(Z + (size_t)(t0 + cr_) * ZLD + C_GQ + h * 64 + d0_), wk = *(const uint4*)(Z + (size_t)(t0 + cr_) * ZLD + C_GK + h * 64 + d0_);
  const uint4 wv0 = *(const uint4*)(Z + (size_t)(t0 + cc_) * ZLD + C_GV + h * 128 + ch_ * 8), wv1 = *(const uint4*)(Z + (size_t)(t0 + cc_) * ZLD + C_GV + h * 128 + (ch_ + 8) * 8);
  const uint4 wS0 = *(const uint4*)(GS + (tid >> 3) * 64 + (tid & 7) * 8), wS1 = *(const uint4*)(GS + ((tid + NTHR) >> 3) * 64 + (tid & 7) * 8);
  const uint4 wr0 = *(const uint4*)(Z + (size_t)(t0 + cc_) * ZLD + C_GR + h * 128 + ch_ * 16), wr1 = *(const uint4*)(Z + (size_t)(t0 + cc_) * ZLD + C_GR + h * 128 + ch_ * 16 + 8);
  __syncthreads();
  gla_bc(pre, tid, glr_s, wg_s, bc_s);
  { const int cr = cr_, d0 = d0_;
    float fq_[8], fk_[8]; unpack8(wq, fq_); unpack8(wk, fk_);
#pragma unroll
    for (int i = 0; i < 8; ++i) { const float ex = __expf(bc_s[cr * 64 + d0 + i]); fq_[i] = fq_[i] * 0.125f * ex; fk_[i] = fk_[i] * __builtin_amdgcn_rcpf(ex); }
    uint4 oq, ok; oq.x = pack2(fq_[0], fq_[1]); oq.y = pack2(fq_[2], fq_[3]); oq.z = pack2(fq_[4], fq_[5]); oq.w = pack2(fq_[6], fq_[7]);
    ok.x = pack2(fk_[0], fk_[1]); ok.y = pack2(fk_[2], fk_[3]); ok.z = pack2(fk_[4], fk_[5]); ok.w = pack2(fk_[6], fk_[7]);
    *(uint4*)(qt + cr * GQS + d0) = oq; *(uint4*)(kt + cr * GQS + d0) = ok; }
  { const int cc = cc_, ch = ch_;
#pragma unroll
    for (int k = 0; k < 2; ++k) { const int e0 = (ch + 8 * k) * 8; const uint4 w = k ? wv1 : wv0;
      const unsigned ww[4] = {w.x, w.y, w.z, w.w};
#pragma unroll
      for (int i = 0; i < 4; ++i) { vT[(e0 + 2 * i) * GQS + cc] = (bf16_t)(ww[i] & 0xffffu); vT[(e0 + 2 * i + 1) * GQS + cc] = (bf16_t)(ww[i] >> 16); } }
    *(uint4*)(ST + (tid >> 3) * GQS + (tid & 7) * 8) = wS0; *(uint4*)(ST + ((tid + NTHR) >> 3) * GQS + (tid & 7) * 8) = wS1; }
  __syncthreads();
  const int wave = tid >> 6, lane = tid & 63, l32 = lane & 31, hb = lane >> 5;
  if (wave < 4) {
    const int mt = wave >> 1, nt = wave & 1;
    f32x16 acc;
#pragma unroll
    for (int i = 0; i < 16; ++i) acc[i] = 0.f;
#pragma unroll
    for (int ks = 0; ks < 4; ++ks) {
      const bf16x8 a = *(const bf16x8*)(qt + (mt * 32 + l32) * GQS + ks * 16 + hb * 8);
      const bf16x8 bq = *(const bf16x8*)(kt + (nt * 32 + l32) * GQS + ks * 16 + hb * 8);
      acc = __builtin_amdgcn_mfma_f32_32x32x16_bf16(a, bq, acc, 0, 0, 0);
    }
#pragma unroll
    for (int r = 0; r < 16; ++r) { const int cr = mt * 32 + (r & 3) + 8 * (r >> 2) + 4 * hb, sc = nt * 32 + l32; As[cr * GQS + sc] = (sc <= cr) ? f2bf(acc[r]) : (bf16_t)0; }
  }
  __syncthreads();
  {
    const int mt = wave >> 2, nt = wave & 3;
    f32x16 acc;
#pragma unroll
    for (int i = 0; i < 16; ++i) acc[i] = 0.f;
#pragma unroll
    for (int ks = 0; ks < 4; ++ks) {
      const bf16x8 a = *(const bf16x8*)(As + (mt * 32 + l32) * GQS + ks * 16 + hb * 8);
      const bf16x8 bq = *(const bf16x8*)(vT + (nt * 32 + l32) * GQS + ks * 16 + hb * 8);
      acc = __builtin_amdgcn_mfma_f32_32x32x16_bf16(a, bq, acc, 0, 0, 0);
    }
#pragma unroll
    for (int ks = 0; ks < 4; ++ks) {
      const bf16x8 a = *(const bf16x8*)(qt + (mt * 32 + l32) * GQS + ks * 16 + hb * 8);
      const bf16x8 bq = *(const bf16x8*)(ST + (nt * 32 + l32) * GQS + ks * 16 + hb * 8);
      acc = __builtin_amdgcn_mfma_f32_32x32x16_bf16(a, bq, acc, 0, 0, 0);
    }
#pragma unroll
    for (int r = 0; r < 16; ++r) { const int cr = mt * 32 + (r & 3) + 8 * (r >> 2) + 4 * hb; o_s[cr * 132 + nt * 32 + l32] = acc[r]; }
  }
  __syncthreads();
  const int cc = tid & 63, wg8 = tid >> 6, e0 = wg8 * 16;
  float o[16];
#pragma unroll
  for (int q = 0; q < 4; ++q) { const f32x4 v = *(const f32x4*)(o_s + cc * 132 + e0 + q * 4); o[q * 4] = v[0]; o[q * 4 + 1] = v[1]; o[q * 4 + 2] = v[2]; o[q * 4 + 3] = v[3]; }
  float ss = 0.f;
#pragma unroll
  for (int i = 0; i < 16; ++i) ss += o[i] * o[i];
  red_s[wg8 * 64 + cc] = ss;
  __syncthreads();
  float tot = 0.f;
#pragma unroll
  for (int i = 0; i < 8; ++i) tot += red_s[i * 64 + cc];
  const float rinv = rsqrtf(tot * (1.f / 128.f) + EPS);
  const float* og = c.inp(11, 128);
  bf16_t* op = Z + (size_t)(t0 + cc) * ZLD + C_GV + h * 128 + e0;
  float rr[16]; unpack8(wr0, rr); unpack8(wr1, rr + 8);
#pragma unroll
  for (int q = 0; q < 4; ++q) {
    f32x4 w;
#pragma unroll
    for (int i = 0; i < 4; ++i) { const float rv = rr[q * 4 + i]; w[i] = o[q * 4 + i] * rinv * og[e0 + q * 4 + i] * (rv / (1.f + __expf(-rv))); }
    store4bf(op + q * 4, w);
  }
}

DI void s5_scan(const Ctx& c) {
  extern __shared__ __attribute__((aligned(16))) unsigned char smem[];
  float* end_s = (float*)smem;
  const float* E = (const float*)(c.ws + OFF_EOA); bf16_t* UA = (bf16_t*)(c.ws + OFF_UA);
  const int tid = threadIdx.x, p = tid & 63, seg = tid >> 6, g = blockIdx.x >> 2, b = blockIdx.x & 3;
  const float lre = fminf(c.inp(12, 2048)[g * 64 + p], -1e-4f), lim = c.inp(13, 2048)[g * 64 + p];
  const float step = expf(c.inp(19, 32)[g]);
  const float mag = expf(lre * step * 16.f); float sn, cs; sincosf(lim * step * 16.f, &sn, &cs);
  const float ar = mag * cs, ai = mag * sn;
  const size_t row0 = (size_t)g * 2048 + (size_t)b * 512 + (size_t)seg * 64;
  float sr = 0.f, si = 0.f;
#pragma unroll 16
  for (int ch = 0; ch < 64; ++ch) {
    const float er = E[(row0 + ch) * 128 + p], ei = E[(row0 + ch) * 128 + 64 + p];
    const float nr = ar * sr - ai * si + er, ni = ar * si + ai * sr + ei; sr = nr; si = ni;
  }
  __syncthreads();
  end_s[(seg * 64 + p) * 2] = sr; end_s[(seg * 64 + p) * 2 + 1] = si;
  __syncthreads();
  float a64r = ar, a64i = ai;
#pragma unroll
  for (int q = 0; q < 6; ++q) { const float nr = a64r * a64r - a64i * a64i, ni = 2.f * a64r * a64i; a64r = nr; a64i = ni; }
  sr = 0.f; si = 0.f;
  for (int s2 = 0; s2 < seg; ++s2) { const float er = end_s[(s2 * 64 + p) * 2], ei = end_s[(s2 * 64 + p) * 2 + 1]; const float nr = a64r * sr - a64i * si + er, ni = a64r * si + a64i * sr + ei; sr = nr; si = ni; }
#pragma unroll 16
  for (int ch = 0; ch < 64; ++ch) {
    const float er = E[(row0 + ch) * 128 + p], ei = E[(row0 + ch) * 128 + 64 + p];
    UA[(row0 + ch) * 384 + 256 + p] = f2bf(sr); UA[(row0 + ch) * 384 + 320 + p] = f2bf(si);
    const float nr = ar * sr - ai * si + er, ni = ar * si + ai * sr + ei; sr = nr; si = ni;
  }
  __syncthreads();
}

template <int CTRL> DI float dpp_mov(float v) { return __builtin_bit_cast(float, __builtin_amdgcn_update_dpp(0, __builtin_bit_cast(int, v), CTRL, 0xf, 0xf, true)); }
DI void mla_finalize_unit(const Ctx& c, int unit) {
  extern __shared__ __attribute__((aligned(16))) unsigned char smem[];
  constexpr int TOKE = 2464;
  bf16_t* lds = (bf16_t*)smem;
  const int tid = threadIdx.x, wave = tid >> 6, lane = tid & 63;
  const bf16_t* Z = (const bf16_t*)(c.ws + OFF_Z);
  bf16_t* Q = (bf16_t*)(c.ws + OFF_QRAW); bf16_t* KV = (bf16_t*)(c.ws + OFF_KVRAW); bf16_t* KP = (bf16_t*)(c.ws + OFF_KPE2);
  const float* cs = (const float*)(c.ws + OFF_ROPE); const float* sn = cs + 8192 * 16;
  const float* qg = c.inp(7, 96); const float* kg = c.inp(8, 96);
  const int l31 = lane & 31, lpar = l31 ^ 16;
  const float qg0 = qg[lane], qg1 = qg[64 + l31], qg1p = qg[64 + lpar], kg0 = kg[lane], kg1 = kg[64 + l31], kg1p = kg[64 + lpar];
  const float qscale = 0.10206207261596575f * 1.4426950408889634f;
  const size_t tbase = (size_t)unit * 16;
  __syncthreads();
  for (int idx = tid; idx < 16 * 308; idx += NTHR) {
    const int tok = idx / 308, ch = idx - tok * 308; const size_t t = tbase + tok;
    const bf16_t* src = (ch < 84) ? Z + t * ZLD + ch * 8 : (ch < 180 ? Q + t * 768 + (ch - 84) * 8 : KV + t * 1024 + (ch - 180) * 8);
    *(uint4*)(lds + tok * TOKE + ch * 8) = *(const uint4*)src;
  }
  __syncthreads();
#pragma unroll
  for (int ti = 0; ti < 2; ++ti) {
    const int tok = wave * 2 + ti; const int t = (int)tbase + tok;
    const int pos = t & (L_ - 1);
    bf16_t* zr = lds + tok * TOKE; bf16_t* qr = zr + 672; bf16_t* kr = zr + 1440;
    float a0[8], a1[8], a1p[8], k0[8], vv[8], red[19];
    float scq = 0.f, sckv = 0.f;
#pragma unroll
    for (int i = 0; i < 6; ++i) { const float v = bf2f(zr[C_CQ + lane + 64 * i]); scq += v * v; }
#pragma unroll
    for (int i = 0; i < 4; ++i) { const float v = bf2f(zr[C_CKV + lane + 64 * i]); sckv += v * v; }
    const float kpe = (lane < 32) ? bf2f(zr[C_KPE + l31]) : 0.f, kpep = bf2f(zr[C_KPE + lpar]);
#pragma unroll
    for (int h = 0; h < 8; ++h) { a0[h] = bf2f(qr[h * 96 + lane]); a1[h] = (lane < 32) ? bf2f(qr[h * 96 + 64 + l31]) : 0.f; a1p[h] = bf2f(qr[h * 96 + 64 + lpar]);
      k0[h] = bf2f(kr[h * 128 + lane]); vv[h] = bf2f(kr[h * 128 + 64 + lane]); }
    const float cv = cs[pos * 16 + (lane & 15)], sv = sn[pos * 16 + (lane & 15)];
    red[0] = scq; red[1] = sckv; red[2] = kpe * kpe;
#pragma unroll
    for (int h = 0; h < 8; ++h) { red[3 + h] = a0[h] * a0[h] + a1[h] * a1[h]; red[11 + h] = k0[h] * k0[h]; }
#pragma unroll
    for (int k = 0; k < 19; ++k) red[k] += dpp_mov<0xB1>(red[k]);
#pragma unroll
    for (int k = 0; k < 19; ++k) red[k] += dpp_mov<0x4E>(red[k]);
#pragma unroll
    for (int k = 0; k < 19; ++k) red[k] += dpp_mov<0x141>(red[k]);
#pragma unroll
    for (int k = 0; k < 19; ++k) red[k] += dpp_mov<0x140>(red[k]);
    { float tmp[19];
#pragma unroll
      for (int k = 0; k < 19; ++k) tmp[k] = __shfl_xor(red[k], 16);
#pragma unroll
      for (int k = 0; k < 19; ++k) red[k] += tmp[k];
#pragma unroll
      for (int k = 0; k < 19; ++k) tmp[k] = __shfl_xor(red[k], 32);
#pragma unroll
      for (int k = 0; k < 19; ++k) red[k] += tmp[k]; }
    const float rsq = rsqrtf(red[0] * (1.f / 384.f) + EPS), rskv = rsqrtf(red[1] * (1.f / 256.f) + EPS);
#pragma unroll
    for (int h = 0; h < 8; ++h) {
      const float rq = rsq * rsqrtf(rsq * rsq * red[3 + h] * (1.f / 96.f) + EPS);
      const float rk = rsqrtf((rskv * rskv * red[11 + h] + red[2]) * (1.f / 96.f) + EPS);
      const float q0o = a0[h] * rq * qg0 * qscale;
      const float n1 = a1[h] * rq * qg1, n1p = a1p[h] * rq * qg1p;
      const float q1o = ((l31 < 16) ? (n1 * cv - n1p * sv) : (n1p * sv + n1 * cv)) * qscale;
      const float k0o = k0[h] * rskv * rk * kg0;
      const float p1 = kpe * rk * kg1, p1p = kpep * rk * kg1p;
      const float kpo = (l31 < 16) ? (p1 * cv - p1p * sv) : (p1p * sv + p1 * cv);
      qr[h * 96 + lane] = f2bf(q0o);
      if (lane < 32) { qr[h * 96 + 64 + lane] = f2bf(q1o); zr[h * 32 + lane] = f2bf(kpo); }
      kr[h * 128 + lane] = f2bf(k0o); kr[h * 128 + 64 + lane] = f2bf(vv[h] * rskv);
    }
  }
  __syncthreads();
  for (int idx = tid; idx < 16 * 256; idx += NTHR) {
    const int tok = idx >> 8, ch = idx & 255; const size_t t = tbase + tok;
    bf16_t* dst = (ch < 32) ? KP + t * 256 + ch * 8 : (ch < 128 ? Q + t * 768 + (ch - 32) * 8 : KV + t * 1024 + (ch - 128) * 8);
    const int so = (ch < 32) ? ch * 8 : (ch < 128 ? 672 + (ch - 32) * 8 : 1440 + (ch - 128) * 8);
    *(uint4*)dst = *(const uint4*)(lds + tok * TOKE + so);
  }
}

constexpr int KSTR = 104, VSTR = 72;
constexpr int KS_BYTES = 64 * KSTR * 2, VT_BYTES = 64 * VSTR * 2;
DI bf16x8 pack8(const f32x16& x, int s) {
  union { unsigned u[4]; bf16x8 v; } r;
  r.u[0] = pack2(x[8 * s + 0], x[8 * s + 1]); r.u[1] = pack2(x[8 * s + 2], x[8 * s + 3]); r.u[2] = pack2(x[8 * s + 4], x[8 * s + 5]); r.u[3] = pack2(x[8 * s + 6], x[8 * s + 7]);
  return r.v;
}
DI void attn_unit(const Ctx& c, int unit) {
  extern __shared__ __attribute__((aligned(16))) unsigned char smem[];
  int tid_; asm volatile("v_mov_b32 %0, %1" : "=v"(tid_) : "v"(threadIdx.x));
  const int tid = tid_, wave = tid >> 6, lane = tid & 63, l32 = lane & 31, hb = lane >> 5;
  const int ugrp = unit >> 8, uidx = unit & 255, qb = 31 - (uidx >> 3), bh = ugrp * 8 + (uidx & 7), b = bh >> 3, h = bh & 7;
  const size_t tb = (size_t)b * L_;
  const bf16_t* Q = (const bf16_t*)(c.ws + OFF_QRAW); const bf16_t* KV = (const bf16_t*)(c.ws + OFF_KVRAW); const bf16_t* KP = (const bf16_t*)(c.ws + OFF_KPE2);
  bf16_t* OA = (bf16_t*)(c.ws + OFF_Z);
  const int q0 = qb * 256, qw0 = q0 + wave * 32;
  bf16x8 qf[6];
#pragma unroll
  for (int s = 0; s < 6; ++s) qf[s] = *(const bf16x8*)(Q + (tb + qw0 + l32) * 768 + h * 96 + s * 16 + hb * 8);
  f32x16 ot[2];
#pragma unroll
  for (int i = 0; i < 16; ++i) { ot[0][i] = 0.f; ot[1][i] = 0.f; }
  float lrun = 0.f, shift;
  { const float* qg = c.inp(7, 96); const float* kg = c.inp(8, 96);
    float gq = fmaxf(fabsf(qg[lane]), fabsf(qg[64 + l32])), gk = fmaxf(fabsf(kg[lane]), fabsf(kg[64 + l32]));
#pragma unroll
    for (int o = 32; o; o >>= 1) { gq = fmaxf(gq, __shfl_xor(gq, o)); gk = fmaxf(gk, __shfl_xor(gk, o)); }
    shift = fmaxf(9.797959f * 1.442695f * gq * gk - 40.f, 0.f); }
  const int nkt = (q0 + 256) / 64;
  const int kn_row = tid >> 3, kn_ch = tid & 7, kp_row = tid >> 2, kp_ch = tid & 3, v_key = tid & 63, v_ch = tid >> 6;
  const int v_pos = (v_key & ~15) | (8 * ((v_key >> 2) & 1) + 4 * ((v_key >> 3) & 1) + (v_key & 3));
  struct Stg { uint4 kn, kp, v; };
  Stg sA, sB; sA.kp = make_uint4(0, 0, 0, 0); sB.kp = sA.kp;
  auto gload = [&](Stg& g, int k0) {
    g.kn = *(const uint4*)(KV + (tb + k0 + kn_row) * 1024 + h * 128 + kn_ch * 8);
    if (tid < 256) g.kp = *(const uint4*)(KP + ((tb + k0 + kp_row) * 8 + h) * 32 + kp_ch * 8);
    g.v = *(const uint4*)(KV + (tb + k0 + v_key) * 1024 + h * 128 + 64 + v_ch * 8);
  };
  auto lstore = [&](const Stg& g, int buf) {
    unsigned char* ks = smem + buf * KS_BYTES; bf16_t* vt = (bf16_t*)(smem + 4 * KS_BYTES + buf * VT_BYTES);
    *(uint4*)(ks + (kn_row * KSTR + kn_ch * 8) * 2) = g.kn;
    if (tid < 256) *(uint4*)(ks + (kp_row * KSTR + 64 + kp_ch * 8) * 2) = g.kp;
    const unsigned w[4] = {g.v.x, g.v.y, g.v.z, g.v.w};
#pragma unroll
    for (int i = 0; i < 4; ++i) { vt[(v_ch * 8 + 2 * i) * VSTR + v_pos] = (bf16_t)(w[i] & 0xffffu); vt[(v_ch * 8 + 2 * i + 1) * VSTR + v_pos] = (bf16_t)(w[i] >> 16); }
  };
  auto compute = [&](int kt) {
    const int k0 = kt * 64, buf = kt & 3;
    if (k0 <= qw0 + 31) {
      const unsigned char* ks = smem + buf * KS_BYTES; const bf16_t* vt = (const bf16_t*)(smem + 4 * KS_BYTES + buf * VT_BYTES);
      f32x16 st[2];
#pragma unroll
      for (int i = 0; i < 16; ++i) { st[0][i] = 0.f; st[1][i] = 0.f; }
      bf16x8 kf[2][6], vf[2][2][2];
#pragma unroll
      for (int ksub = 0; ksub < 2; ++ksub)
#pragma unroll
        for (int s = 0; s < 6; ++s) kf[ksub][s] = *(const bf16x8*)(ks + ((ksub * 32 + l32) * KSTR + s * 16 + hb * 8) * 2);
#pragma unroll
      for (int ksub = 0; ksub < 2; ++ksub)
#pragma unroll
        for (int s2 = 0; s2 < 2; ++s2)
#pragma unroll
          for (int dt = 0; dt < 2; ++dt) {
            vf[ksub][s2][dt] = *(const bf16x8*)(vt + (dt * 32 + l32) * VSTR + ksub * 32 + 16 * s2 + 8 * hb);
          }
      __builtin_amdgcn_sched_barrier(0);
#pragma unroll
      for (int ksub = 0; ksub < 2; ++ksub)
#pragma unroll
        for (int s = 0; s < 6; ++s) st[ksub] = __builtin_amdgcn_mfma_f32_32x32x16_bf16(kf[ksub][s], qf[s], st[ksub], 0, 0, 0);
      if (k0 + 63 > qw0) {
        const int qpos = qw0 + l32;
#pragma unroll
        for (int ksub = 0; ksub < 2; ++ksub)
#pragma unroll
          for (int r = 0; r < 16; ++r) { const int key = k0 + ksub * 32 + (r & 3) + 8 * (r >> 2) + 4 * hb; if (key > qpos) st[ksub][r] = -1e30f; }
      }
      if (shift > 0.f) {
#pragma unroll
        for (int r = 0; r < 16; ++r) { st[0][r] -= shift; st[1][r] -= shift; }
      }
#pragma unroll
      for (int ksub = 0; ksub < 2; ++ksub) {
        float rs = 0.f;
#pragma unroll
        for (int r = 0; r < 16; ++r) { st[ksub][r] = __builtin_amdgcn_exp2f(st[ksub][r]); rs += st[ksub][r]; }
        lrun += rs;
#pragma unroll
        for (int s2 = 0; s2 < 2; ++s2) {
          const bf16x8 pf = pack8(st[ksub], s2);
#pragma unroll
          for (int dt = 0; dt < 2; ++dt) ot[dt] = __builtin_amdgcn_mfma_f32_32x32x16_bf16(vf[ksub][s2][dt], pf, ot[dt], 0, 0, 0);
        }
      }
    }
  };
  __syncthreads();
  gload(sA, 0); gload(sB, 64);
  lstore(sA, 0); lstore(sB, 1);
  gload(sA, 128); gload(sB, 192);
  __syncthreads();
  for (int kt = 0; kt < nkt; kt += 2) {
    compute(kt);
    compute(kt + 1);
    if (kt + 2 < nkt) { lstore(sA, (kt + 2) & 3); lstore(sB, (kt + 3) & 3); }
    if (kt + 4 < nkt) { gload(sA, (kt + 4) * 64); gload(sB, (kt + 5) * 64); }
    __syncthreads();
  }
  lrun += __shfl_xor(lrun, 32);
  const float inv = 1.f / lrun;
  bf16_t* op = OA + (tb + qw0 + l32) * ZLD + h * 64;
#pragma unroll
  for (int dt = 0; dt < 2; ++dt)
#pragma unroll
    for (int g4 = 0; g4 < 4; ++g4) {
      f32x4 v; v[0] = ot[dt][g4 * 4 + 0] * inv; v[1] = ot[dt][g4 * 4 + 1] * inv; v[2] = ot[dt][g4 * 4 + 2] * inv; v[3] = ot[dt][g4 * 4 + 3] * inv;
      store4bf(op + dt * 32 + 8 * g4 + 4 * hb, v);
    }
}

#ifndef PROBE_A
#define PROBE_A -1
#define PROBE_B -1
#endif
DI void mark(int k) {
  if (PROBE_A >= 0) {
    extern __shared__ __attribute__((aligned(16))) unsigned char smem[];
    if (blockIdx.x == 0 && threadIdx.x == 0) ((volatile unsigned long long*)(smem + LDS_UNIT_OFF - 8 * 33))[k] = wall_clock64();
  }
}
constexpr int N_PH_LAYER = 11;
DI int next_unit(unsigned* ctr) {
  extern __shared__ __attribute__((aligned(16))) unsigned char smem[];
  volatile int* su = (volatile int*)(smem + LDS_UNIT_OFF);
  __syncthreads();
  if (threadIdx.x == 0) *su = (int)atomicAdd(ctr, 1u);
  __syncthreads();
  return *su;
}

DI void run_phase(const Ctx& c, int k) {
  unsigned char* ws = c.ws;
  bf16_t* Z = (bf16_t*)(ws + OFF_Z); bf16_t* H = (bf16_t*)(ws + OFF_H); bf16_t* W = (bf16_t*)(ws + OFF_W); bf16_t* UA = (bf16_t*)(ws + OFF_UA);
  const int G = gridDim.x, vcu = vcu_id();
  const float* xsrc = (c.layer == 0) ? c.in[0] : c.out;
  switch (k) {
    case 0: {
      if (c.layer == 0) mark(0);
      rmsnorm_rows(xsrc, c.inp(1, 1024), H);
      if (c.layer == 0) mark(1);
      if (c.layer == 0) rope_table(c);
      if (c.layer == 0) mark(2);
      if (c.layer == 0) mark(3);
      unsigned* ctr = (unsigned*)(ws + OFF_CTL) + 4 + c.layer;
      for (;;) {
        const int u = next_unit(ctr);
        if (u >= 578 + 256) break;
        if (u >= 578) s5_mats_unit(c, u - 578);
        else if (u < 368) xpose_tile(c.inp(2, (size_t)1024 * DIN), 1024, DIN, W + W_IN, nullptr, u);
        else if (u < 386) xpose_tile(c.inp(4, 384 * 768), 384, 768, W + W_UQ, c.inp(3, 384), u - 368);
        else if (u < 402) xpose_tile(c.inp(6, 256 * 1024), 256, 1024, W + W_UKV, c.inp(5, 256), u - 386);
        else if (u < 418) xpose_tile(c.inp(20, 512 * 512), 512, 512, W + W_GLU, nullptr, u - 402);
        else if (u < 514) { const int v = u - 418, br = v >> 5; xpose_tile(c.inp(22 + br, 512 * 1024), 512, 1024, W + W_BR + (size_t)br * 1024 * 512, nullptr, v & 31); }
        else xpose_tile(c.inp(26, 1024 * 1024), 1024, 1024, W + W_OUT, nullptr, u - 514);
      }
      if (c.layer == 0) mark(4);
    } break;
    case 1: {
      const EpiG1 e{Z, UA};
      gemm_phase<1024, 1024, 1024>(H, W + W_IN, 128 * 11, 11, e);
    } break;
    case 2: {
      for (int u = vcu; u < 896 + 256 + 2048; u += G) {
        if (u < 384) { const EpiP2 e{0, (bf16_t*)(ws + OFF_QRAW), 768, nullptr}; gemm_tile<ZLD, 384, 384>(Z + C_CQ, W + W_UQ, (u / 3) * 256, (u % 3) * 256, e); }
        else if (u < 896) { const int v = u - 384; const EpiP2 e{0, (bf16_t*)(ws + OFF_KVRAW), 1024, nullptr}; gemm_tile<ZLD, 256, 256>(Z + C_CKV, W + W_UKV, (v / 4) * 256, (v % 4) * 256, e); }
        else if (u < 1152) { const int v = u - 896, g = v >> 3, pm = v & 7; const EpiP2 e{1, nullptr, 0, (float*)(ws + OFF_EOA) + (size_t)g * 2048 * 128};
          gemm_tile<384, 256, 256>(UA + (size_t)g * 2048 * 384, (const bf16_t*)(ws + OFF_MATS) + (size_t)g * 65536, pm * 256, 0, e); }
        else gla_pass1(c, u - 1152);
      }
    } break;
    case 3: {
      if (c.layer == 0) mark(5);
      if (blockIdx.x < 128) s5_scan(c); else gla_scan(c, 128, G - 128);
      if (c.layer == 0) mark(6);
      unsigned* ctr = (unsigned*)(ws + OFF_CTL) + 2 + c.layer;
      for (int u = blockIdx.x; u < 2048; u += G) mla_finalize_unit(c, u);
      if (c.layer == 0) mark(7);
    } break;
    case 4: {
      unsigned* ctr = (unsigned*)(ws + OFF_CTL) + c.layer;
      for (;;) {
        const int u = next_unit(ctr);
        if (u >= 1024 + 256 + 2048) break;
        if (u < 1024) attn_unit(c, u);
        else if (u < 1280) { const int v = u - 1024, g = v >> 3, pm = v & 7; const EpiS5Y e{Z, g};
          gemm_tile<384, 384, 384>(UA + (size_t)g * 2048 * 384, (const bf16_t*)(ws + OFF_MY) + (size_t)g * 256 * 384, pm * 256, 0, e); }
        else gla_pass3(c, u - 1280);
      }
    } break;
    case 5: {
      const EpiGLU e{Z, c.inp(21, 512)};
      gemm_phase<ZLD, 512, 512>(Z + C_SU, W + W_GLU, 256, 2, e);
    } break;
    case 6: {
      uint2* scr = (uint2*)(ws + OFF_SCR) + (size_t)blockIdx.x * 16384;
      bf16_t* M = (bf16_t*)(ws + OFF_MERGED);
      int u = vcu;
      if (u < 512) {
        asm volatile("s_waitcnt vmcnt(0) lgkmcnt(0)" ::: "memory");
        __builtin_amdgcn_s_barrier();
        gemm_issue<ZLD, 512>(Z, W + W_BR, (u / 4) * 256, (u % 4) * 256);
        for (; u < 512; u += G) {
          const int brow = (u / 4) * 256, bcol = (u % 4) * 256;
          for (int br = 0; br < 3; ++br) {
            int tidx; asm volatile("v_mov_b32 %0, %1" : "=v"(tidx) : "v"(threadIdx.x));
            const int wid = tidx >> 6, lane = tidx & 63;
            const bf16_t* Wg = W + W_IN + (size_t)(ZLD + br * 1024) * 1024;
            const bf16_t* Wb = W + W_BR + (size_t)br * 1024 * 512;
            const bf16_t* Ab = Z + (br == 0 ? 0 : (br == 1 ? C_GV : C_GR));
            const bf16_t* Abn = Z + (br == 0 ? C_GV : (br == 1 ? C_GR : 0));
            {
              f32x4 acc[2][2][4][2];
              gemm_main<ZLD, 512, 512>(Ab, Wb, brow, bcol, acc);
              gemm_issue<1024, 1024>(H, Wg, brow, bcol);
              const EpiP6 e0{0, scr, M, c.inp(25, 3072) + br * 1024, br};
              e0(acc, brow, bcol, wid >> 2, wid & 3, lane & 15, lane >> 4);
            }
            {
              f32x4 acc[2][2][4][2];
              gemm_main<1024, 1024, 1024>(H, Wg, brow, bcol, acc);
              if (br < 2) gemm_issue<ZLD, 512>(Abn, Wb + 1024 * 512, brow, bcol);
              else if (u + G < 512) gemm_issue<ZLD, 512>(Abn, W + W_BR, ((u + G) / 4) * 256, ((u + G) % 4) * 256);
              const EpiP6 e1{1, scr, M, c.inp(25, 3072) + br * 1024, br};
              e1(acc, brow, bcol, wid >> 2, wid & 3, lane & 15, lane >> 4);
            }
          }
        }
      }
    } break;
    case 7: {
      const EpiResid e{xsrc, c.out};
      gemm_phase<1024, 1024, 1024>((const bf16_t*)(ws + OFF_MERGED), W + W_OUT, 512, 4, e);
    } break;
    case 8: {
      rmsnorm_rows(c.out, c.inp(27, 1024), H);
      for (int u = vcu; u < 512; u += G) {
        if (u < 256) xpose_tile(c.inp(28, (size_t)1024 * 4096), 1024, 4096, (bf16_t*)(ws + OFF_WFF1), nullptr, u);
        else xpose_tile(c.inp(29, (size_t)4096 * 1024), 4096, 1024, (bf16_t*)(ws + OFF_WFF2), nullptr, u - 256);
      }
    } break;
    case 9: {
      const EpiRelu2 e{(bf16_t*)(ws + OFF_FFH)};
      gemm_phase<1024, 1024, 1024>(H, (const bf16_t*)(ws + OFF_WFF1), 128 * 16, 16, e);
    } break;
    case 10: {
      const EpiResid e{c.out, c.out};
      gemm_phase<4096, 4096, 4096>((const bf16_t*)(ws + OFF_FFH), (const bf16_t*)(ws + OFF_WFF2), 512, 4, e);
    } break;
  }
}

DI void grid_barrier(unsigned* ctr, unsigned target) {
  asm volatile("s_waitcnt vmcnt(0)" ::: "memory");
  __syncthreads();
  if (threadIdx.x == 0) {
    __builtin_amdgcn_fence(__ATOMIC_RELEASE, "agent");
    asm volatile("s_waitcnt vmcnt(0)" ::: "memory");
    __hip_atomic_fetch_add(ctr, 1u, __ATOMIC_RELAXED, __HIP_MEMORY_SCOPE_AGENT);
    while (__hip_atomic_load(ctr, __ATOMIC_RELAXED, __HIP_MEMORY_SCOPE_AGENT) < target) __builtin_amdgcn_s_sleep(2);
    __builtin_amdgcn_fence(__ATOMIC_ACQUIRE, "agent");
    asm volatile("s_waitcnt vmcnt(0)" ::: "memory");
  }
  __syncthreads();
}

__global__ void __launch_bounds__(NTHR) mega(Params p) {
  cg::grid_group grid = cg::this_grid();
  Ctx c{p, p.in, p.out, p.ws, 0};
  const int lo = p.ph_lo, hi = p.ph_hi;
  unsigned* bar = (unsigned*)(p.ws + OFF_CTL) + 64;
  const unsigned G_ = gridDim.x;
#define PH(k) if (lo <= (k) && (k) < hi) { c.layer = (k) / N_PH_LAYER; run_phase(c, (k) % N_PH_LAYER); \
    if ((k) + 1 < hi) { if ((k) == lo) grid.sync(); else grid_barrier(bar, (unsigned)((k) - lo) * G_); } }
  PH(0) PH(1) PH(2) PH(3) PH(4) PH(5) PH(6) PH(7) PH(8) PH(9) PH(10)
  PH(11) PH(12) PH(13) PH(14) PH(15) PH(16) PH(17) PH(18) PH(19) PH(20) PH(21)
#undef PH
  if (PROBE_A >= 0 && blockIdx.x == 0) {
    extern __shared__ __attribute__((aligned(16))) unsigned char smem[];
    volatile unsigned long long* mk = (volatile unsigned long long*)(smem + LDS_UNIT_OFF - 8 * 33);
    const unsigned long long dt = mk[PROBE_B] - mk[PROBE_A];
    const unsigned long long t0 = wall_clock64(); while (wall_clock64() - t0 < dt * 4ull) { __builtin_amdgcn_s_sleep(8); }
  }
}

#ifndef MULTI_LAUNCH
#define MULTI_LAUNCH 0
#endif

extern "C" void kernel_launch(void* const* d_in, const int* in_sizes, int n_in,
                              void* d_out, int out_size, void* d_ws, size_t ws_size,
                              hipStream_t stream) {
  static int grid_blocks = 0;
  if (!grid_blocks) {
    if (n_in != 30 || out_size != T_ * D_ || ws_size < WS_END) { fprintf(stderr, "kernel_launch: unexpected shapes n_in=%d out=%d ws=%zu (need %zu)\n", n_in, out_size, ws_size, (size_t)WS_END); grid_blocks = -1; return; }
    int dev = 0, cus = 0, per_cu = 0;
    hipGetDevice(&dev);
    hipDeviceGetAttribute(&cus, hipDeviceAttributeMultiprocessorCount, dev);
    hipFuncSetAttribute((const void*)mega, hipFuncAttributeMaxDynamicSharedMemorySize, LDS_BYTES);
    hipOccupancyMaxActiveBlocksPerMultiprocessor(&per_cu, (const void*)mega, NTHR, LDS_BYTES);
    fprintf(stderr, "cus=%d per_cu=%d ws_size=%zu\n", cus, per_cu, ws_size);
    if (per_cu < 1) { fprintf(stderr, "kernel_launch: occupancy query says 0 blocks/CU\n"); grid_blocks = -1; return; }
    grid_blocks = cus;
  }
  if (grid_blocks < 0) return;
  hipMemsetAsync((char*)d_ws + OFF_CTL, 0, 4096, stream);
  Params p{};
  for (int i = 0; i < 30; ++i) p.in[i] = (const float*)d_in[i];
  p.out = (float*)d_out; p.ws = (unsigned char*)d_ws;
#if MULTI_LAUNCH
  for (int ph = 0; ph < 2 * N_PH_LAYER; ++ph) {
    p.ph_lo = ph; p.ph_hi = ph + 1;
    hipLaunchKernelGGL(mega, dim3(grid_blocks), dim3(NTHR), LDS_BYTES, stream, p);
  }
#else
  p.ph_lo = 0; p.ph_hi = 2 * N_PH_LAYER;
  void* args[] = {&p};
  hipError_t e = hipLaunchCooperativeKernel((void*)mega, dim3(grid_blocks), dim3(NTHR), args, LDS_BYTES, stream);
  if (e != hipSuccess) fprintf(stderr, "coop launch failed: %s\n", hipGetErrorString(e));
#endif
}
```

```cpp
#include <hip/hip_runtime.h>
#include <hip/hip_cooperative_groups.h>
#include <cstdio>
#include <cstdint>
namespace cg = cooperative_groups;

#define DI __device__ __forceinline__
typedef unsigned short bf16_t;
typedef short bf16x8 __attribute__((ext_vector_type(8)));
typedef short s16x4 __attribute__((ext_vector_type(4)));
typedef float f32x4 __attribute__((ext_vector_type(4)));
typedef float f32x16 __attribute__((ext_vector_type(16)));

constexpr int T_ = 32768, L_ = 8192, D_ = 1024, DIN = 5808, DFF = 4096;
constexpr int ZLD = 2736;
constexpr int C_CQ = 0, C_CKV = 384, C_KPE = 640, C_GQ = 672, C_GK = 928, C_GV = 1184, C_GLR = 1696, C_GR = 1712, C_SU = 2224;
constexpr float EPS = 1e-6f;
constexpr int NTHR = 512;
constexpr int LDS_BYTES = 147456;
constexpr int LDS_UNIT_OFF = LDS_BYTES - 16;

constexpr size_t OFF_Z = 0;
constexpr size_t OFF_QRAW = 179306496;
constexpr size_t OFF_KVRAW = OFF_QRAW + 50331648;
constexpr size_t OFF_KPE2 = OFF_KVRAW + 67108864;
constexpr size_t OFF_EOA = OFF_KPE2 + 16777216;
constexpr size_t OFF_H = OFF_EOA + 33554432;
constexpr size_t OFF_GS = OFF_H + 67108864;
constexpr size_t OFF_UA = OFF_GS + 33554432;
constexpr size_t OFF_W = OFF_UA + 50331648;
constexpr size_t W_IN = 0, W_UQ = W_IN + (size_t)DIN * 1024, W_UKV = W_UQ + 768 * 384, W_GLU = W_UKV + 1024 * 256,
                 W_BR = W_GLU + 512 * 512, W_OUT = W_BR + 3 * 1024 * 512, W_END = W_OUT + 1024 * 1024;
constexpr size_t OFF_MATS = OFF_W + ((W_END * 2 + 255) / 256) * 256;
constexpr size_t OFF_MY = OFF_MATS + 32 * 256 * 256 * 2;
constexpr size_t OFF_ROPE = OFF_MY + 32 * 256 * 384 * 2;
constexpr size_t OFF_GDEC = OFF_ROPE + 2 * 8192 * 16 * 4;
constexpr size_t OFF_CTL = OFF_GDEC + 2048 * 64 * 4;
constexpr size_t WS_END = OFF_CTL + 4096;
constexpr size_t OFF_FFH = OFF_Z;
constexpr size_t OFF_MERGED = OFF_QRAW;
constexpr size_t OFF_SCR = OFF_GS;
constexpr size_t OFF_WFF1 = OFF_UA, OFF_WFF2 = OFF_UA + (size_t)4096 * 1024 * 2;
static_assert(WS_END <= 536870912ull, "workspace");
static_assert((size_t)T_ * 4096 * 2 <= OFF_KPE2, "ffh overlay");

struct Params { const float* in[30]; float* out; unsigned char* ws; int ph_lo, ph_hi; };

struct Ctx {
  const Params& P;
  const float* const* in; float* out; unsigned char* ws;
  int layer;
  DI const float* inp(int i, size_t per_layer) const { return P.in[i] + (size_t)layer * per_layer; }
};

DI bf16_t f2bf(float x) { unsigned u = __float_as_uint(x); u += 0x7fffu + ((u >> 16) & 1u); return (bf16_t)(u >> 16); }
DI float bf2f(bf16_t b) { return __uint_as_float(((unsigned)b) << 16); }
typedef __bf16 bf2_t __attribute__((ext_vector_type(2)));
typedef float f32x2 __attribute__((ext_vector_type(2)));
DI unsigned pack2(float lo, float hi) { f32x2 v; v.x = lo; v.y = hi; return __builtin_bit_cast(unsigned, __builtin_convertvector(v, bf2_t)); }
DI float wave_sum(float v) {
#pragma unroll
  for (int o = 32; o; o >>= 1) v += __shfl_xor(v, o);
  return v;
}
DI float sigmoidf_(float x) { return 1.f / (1.f + __expf(-x)); }
DI void store4bf(bf16_t* p, const f32x4& v) { uint2 w; w.x = pack2(v[0], v[1]); w.y = pack2(v[2], v[3]); *(uint2*)p = w; }
DI f32x4 load4bf(const bf16_t* p) { uint2 w = *(const uint2*)p; f32x4 v; v[0] = __uint_as_float(w.x << 16); v[1] = __uint_as_float(w.x & 0xffff0000u); v[2] = __uint_as_float(w.y << 16); v[3] = __uint_as_float(w.y & 0xffff0000u); return v; }

constexpr int BK = 64, HALF = 128, HT = HALF * BK;
DI int lds_byte(int r, int c) { int st = (r >> 4) * 2 + (c >> 5), rr = r & 15, cc = c & 31, ob = rr * 64 + cc * 2; return st * 1024 + (ob ^ (((ob >> 9) & 1) << 5)); }
DI void stage_rc(int b, int& R, int& C) { int st = b / 1024, sb = b % 1024, swz = sb ^ (((sb >> 9) & 1) << 5); R = (st >> 1) * 16 + swz / 64; C = (st & 1) * 32 + (swz % 64) / 2; }

#define FOR_ACC(...) \
  _Pragma("unroll") for (int ai = 0; ai < 2; ++ai) { _Pragma("unroll") for (int m = 0; m < 4; ++m) { const int row = brow + ai * 128 + wr * 64 + m * 16 + fr; \
  _Pragma("unroll") for (int bj = 0; bj < 2; ++bj) _Pragma("unroll") for (int n = 0; n < 2; ++n) { const int col = bcol + bj * 128 + wc * 32 + n * 16 + fq * 4; const f32x4 v = acc[ai][bj][m][n]; __VA_ARGS__ } } asm volatile("" ::: "memory"); }

#define SA(b, h) (shm + ((b) * 2 + (h)) * HT)
#define SB(b, h) (shm + (4 + (b) * 2 + (h)) * HT)
#define STAGE(P, BASE, LD, VO, br, kt) do { const char* _g = (const char*)((BASE) + (long)(br) * (LD) + (long)(kt) * BK); \
    for (int _i = 0; _i < 2; ++_i) { \
      __builtin_amdgcn_global_load_lds((const unsigned*)(_g + VO[_i]), (unsigned*)((char*)(P) + tidx * 16 + _i * 8192), 16, 0, 0); } } while (0)
#define LDA(dst, b, h) for (int m = 0; m < 4; ++m) for (int k = 0; k < 2; ++k) \
    dst[m][k] = *reinterpret_cast<const bf16x8*>((char*)SA(b, h) + lds_byte(wr * 64 + m * 16 + fr, k * 32 + fq * 8))
#define LDB(dst, b, h) for (int n = 0; n < 2; ++n) for (int k = 0; k < 2; ++k) \
    dst[n][k] = *reinterpret_cast<const bf16x8*>((char*)SB(b, h) + lds_byte(wc * 32 + n * 16 + fr, k * 32 + fq * 8))
#define MMA(ai, bj, At, Bf) do { __builtin_amdgcn_s_setprio(1); \
    for (int m = 0; m < 4; ++m) for (int n = 0; n < 2; ++n) for (int k = 0; k < 2; ++k) \
      acc[ai][bj][m][n] = __builtin_amdgcn_mfma_f32_16x16x32_bf16(Bf[n][k], At[m][k], acc[ai][bj][m][n], 0, 0, 0); \
    __builtin_amdgcn_s_setprio(0); } while (0)
#define WAIT_V(n) asm volatile("s_waitcnt vmcnt(" #n ")" ::: "memory")
#define WAIT_L(n) asm volatile("s_waitcnt lgkmcnt(" #n ")" ::: "memory")
#define BAR __builtin_amdgcn_s_barrier()
#define SCHED __builtin_amdgcn_sched_barrier(0)
#define GEMM_TID \
  int tidx; asm volatile("v_mov_b32 %0, %1" : "=v"(tidx) : "v"(threadIdx.x)); \
  unsigned voA[2], voB[2]; \
  for (int i = 0; i < 2; ++i) { int r_, c_; stage_rc(tidx * 16 + i * 8192, r_, c_); voA[i] = (unsigned)(r_ * lda + c_) * 2u; voB[i] = (unsigned)(r_ * ldb + c_) * 2u; }

template <int lda, int ldb>
DI void gemm_issue(const bf16_t* __restrict__ A, const bf16_t* __restrict__ Bt, int brow, int bcol) {
  extern __shared__ __attribute__((aligned(16))) unsigned char smem[];
  bf16_t* shm = (bf16_t*)smem;
  GEMM_TID
  STAGE(SB(0, 0), Bt, ldb, voB, bcol, 0); STAGE(SA(0, 0), A, lda, voA, brow, 0);
  STAGE(SB(0, 1), Bt, ldb, voB, bcol + HALF, 0); STAGE(SA(0, 1), A, lda, voA, brow + HALF, 0);
}

template <int lda, int ldb, int K>
DI void gemm_main(const bf16_t* __restrict__ A, const bf16_t* __restrict__ Bt, int brow, int bcol, f32x4 (&acc)[2][2][4][2]) {
  extern __shared__ __attribute__((aligned(16))) unsigned char smem[];
  bf16_t* shm = (bf16_t*)smem;
  GEMM_TID
  const int wid = tidx >> 6, lane = tidx & 63, wr = wid >> 2, wc = wid & 3, fr = lane & 15, fq = lane >> 4;
#pragma unroll
  for (int a = 0; a < 2; ++a)
#pragma unroll
    for (int b = 0; b < 2; ++b)
#pragma unroll
      for (int m = 0; m < 4; ++m)
#pragma unroll
        for (int n = 0; n < 2; ++n) acc[a][b][m][n] = (f32x4){0.f, 0.f, 0.f, 0.f};
  bf16x8 At[4][2], B0[2][2], B1[2][2];
  const int nt = K / BK;
  if (wr == 1) BAR;
  WAIT_V(4); BAR;
  STAGE(SB(1, 0), Bt, ldb, voB, bcol, 1); STAGE(SA(1, 0), A, lda, voA, brow, 1); STAGE(SB(1, 1), Bt, ldb, voB, bcol + HALF, 1);
  WAIT_V(6); BAR;
  for (int t = 0; t < nt - 2; t += 2) {
    LDB(B0, 0, 0); SCHED; LDA(At, 0, 0); STAGE(SA(1, 1), A, lda, voA, brow + HALF, t + 1);
    WAIT_L(8); BAR; WAIT_L(0); MMA(0, 0, At, B0); BAR; SCHED;
    LDB(B1, 0, 1); STAGE(SB(0, 0), Bt, ldb, voB, bcol, t + 2);
    BAR; WAIT_L(0); MMA(0, 1, At, B1); BAR;
    LDA(At, 0, 1); STAGE(SA(0, 0), A, lda, voA, brow, t + 2);
    BAR; WAIT_L(0); MMA(1, 0, At, B0); BAR; SCHED;
    STAGE(SB(0, 1), Bt, ldb, voB, bcol + HALF, t + 2);
    WAIT_V(6); BAR; MMA(1, 1, At, B1); BAR;
    LDB(B0, 1, 0); SCHED; LDA(At, 1, 0); STAGE(SA(0, 1), A, lda, voA, brow + HALF, t + 2);
    WAIT_L(8); BAR; WAIT_L(0); MMA(0, 0, At, B0); BAR; SCHED;
    LDB(B1, 1, 1); STAGE(SB(1, 0), Bt, ldb, voB, bcol, t + 3);
    BAR; WAIT_L(0); MMA(0, 1, At, B1); BAR;
    LDA(At, 1, 1); STAGE(SA(1, 0), A, lda, voA, brow, t + 3);
    BAR; WAIT_L(0); MMA(1, 0, At, B0); BAR; SCHED;
    STAGE(SB(1, 1), Bt, ldb, voB, bcol + HALF, t + 3);
    WAIT_V(6); BAR; MMA(1, 1, At, B1); BAR;
  }
  { LDB(B0, 0, 0); LDA(At, 0, 0); STAGE(SA(1, 1), A, lda, voA, brow + HALF, nt - 1);
    BAR; WAIT_L(0); MMA(0, 0, At, B0); BAR;
    LDB(B1, 0, 1); BAR; WAIT_L(0); MMA(0, 1, At, B1); BAR;
    LDA(At, 0, 1); WAIT_V(4); BAR; WAIT_L(0); MMA(1, 0, At, B0); MMA(1, 1, At, B1); BAR; }
  { LDB(B0, 1, 0); LDA(At, 1, 0); WAIT_V(2); BAR; WAIT_L(0); MMA(0, 0, At, B0); BAR;
    LDB(B1, 1, 1); WAIT_V(0); BAR; WAIT_L(0); MMA(0, 1, At, B1); BAR;
    LDA(At, 1, 1); BAR; WAIT_L(0); MMA(1, 0, At, B0); MMA(1, 1, At, B1); BAR; }
  if (wr == 0) BAR;
}

template <int lda, int ldb, int K, class Epi>
DI void gemm_tile(const bf16_t* __restrict__ A, const bf16_t* __restrict__ Bt, int brow, int bcol, const Epi& epi) {
  asm volatile("s_waitcnt vmcnt(0) lgkmcnt(0)" ::: "memory");
  __builtin_amdgcn_s_barrier();
  gemm_issue<lda, ldb>(A, Bt, brow, bcol);
  f32x4 acc[2][2][4][2];
  gemm_main<lda, ldb, K>(A, Bt, brow, bcol, acc);
  int tidx; asm volatile("v_mov_b32 %0, %1" : "=v"(tidx) : "v"(threadIdx.x));
  const int wid = tidx >> 6, lane = tidx & 63;
  epi(acc, brow, bcol, wid >> 2, wid & 3, lane & 15, lane >> 4);
}

DI int vcu_id();
template <int lda, int ldb, int K, class Epi>
DI void gemm_phase(const bf16_t* __restrict__ A, const bf16_t* __restrict__ Bt, int ntiles, int nN, const Epi& epi) {
  const int G = gridDim.x; int u = vcu_id();
  if (u >= ntiles) return;
  asm volatile("s_waitcnt vmcnt(0) lgkmcnt(0)" ::: "memory");
  __builtin_amdgcn_s_barrier();
  gemm_issue<lda, ldb>(A, Bt, (u / nN) * 256, (u % nN) * 256);
  for (; u < ntiles; u += G) {
    const int brow = (u / nN) * 256, bcol = (u % nN) * 256;
    f32x4 acc[2][2][4][2];
    gemm_main<lda, ldb, K>(A, Bt, brow, bcol, acc);
    const int un = u + G;
    if (un < ntiles) gemm_issue<lda, ldb>(A, Bt, (un / nN) * 256, (un % nN) * 256);
    int tidx; asm volatile("v_mov_b32 %0, %1" : "=v"(tidx) : "v"(threadIdx.x));
    const int wid = tidx >> 6, lane = tidx & 63;
    epi(acc, brow, bcol, wid >> 2, wid & 3, lane & 15, lane >> 4);
  }
}

DI int vcu_id() { const int G = gridDim.x, bx = blockIdx.x; return (G % 8 == 0) ? (bx % 8) * (G / 8) + bx / 8 : bx; }

typedef const f32x4 (&AccRef)[2][2][4][2];
struct EpiG1 { bf16_t* Z; bf16_t* UA;
  DI void operator()(AccRef acc, int brow, int bcol, int wr, int wc, int fr, int fq) const {
    FOR_ACC(
      if (col < C_SU) { store4bf(Z + (size_t)row * ZLD + col, v); }
      else if (col < ZLD) { const int cc = col - C_SU, g = cc >> 4, i = cc & 15; store4bf(UA + ((size_t)(g * 2048 + (row >> 4)) * 384 + (row & 15) * 16 + i), v); }
    )
  } };
struct EpiBf16 { bf16_t* O; int ldc;
  DI void operator()(AccRef acc, int brow, int bcol, int wr, int wc, int fr, int fq) const {
    FOR_ACC( store4bf(O + (size_t)row * ldc + col, v); )
  } };
struct EpiS5E { float* E;
  DI void operator()(AccRef acc, int brow, int bcol, int wr, int wc, int fr, int fq) const {
    FOR_ACC( if (col < 128) { *(f32x4*)(E + (size_t)row * 128 + col) = v; } )
  } };
DI float gelu_tanh(float x) { const float z = 0.7978845608028654f * (x + 0.044715f * x * x * x); const float t = 1.f - 2.f / (__expf(2.f * z) + 1.f); return 0.5f * x * (1.f + t); }
struct EpiS5Y { bf16_t* Z; int g;
  DI void operator()(AccRef acc, int brow, int bcol, int wr, int wc, int fr, int fq) const {
    FOR_ACC(
      const int j = col >> 4, i = col & 15;
      const size_t t = (size_t)(row >> 9) * 8192 + (size_t)(row & 511) * 16 + j;
      f32x4 o; o[0] = gelu_tanh(v[0]); o[1] = gelu_tanh(v[1]); o[2] = gelu_tanh(v[2]); o[3] = gelu_tanh(v[3]);
      store4bf(Z + t * ZLD + C_SU + g * 16 + i, o);
    )
  } };
struct EpiGLU { bf16_t* Z; const float* bias;
  DI void operator()(AccRef acc, int brow, int bcol, int wr, int wc, int fr, int fq) const {
    FOR_ACC(
      const f32x4 y = load4bf(Z + (size_t)row * ZLD + C_SU + col);
      const f32x4 b = *(const f32x4*)(bias + col);
      f32x4 o; for (int q = 0; q < 4; ++q) o[q] = y[q] * sigmoidf_(v[q] + b[q]);
      store4bf(Z + (size_t)row * ZLD + C_GR + col, o);
    )
  } };
struct EpiScr { uint2* scr;
  DI void operator()(AccRef acc, int brow, int bcol, int wr, int wc, int fr, int fq) const {
    FOR_ACC( uint2 w; w.x = pack2(v[0], v[1]); w.y = pack2(v[2], v[3]); scr[(((ai * 2 + bj) * 4 + m) * 2 + n) * NTHR + threadIdx.x] = w; )
  } };
struct EpiGate { const uint2* scr; bf16_t* M; const float* gb; int br;
  DI void operator()(AccRef acc, int brow, int bcol, int wr, int wc, int fr, int fq) const {
    FOR_ACC(
      const uint2 w = scr[(((ai * 2 + bj) * 4 + m) * 2 + n) * NTHR + threadIdx.x];
      f32x4 p; p[0] = __uint_as_float(w.x << 16); p[1] = __uint_as_float(w.x & 0xffff0000u); p[2] = __uint_as_float(w.y << 16); p[3] = __uint_as_float(w.y & 0xffff0000u);
      const f32x4 b = *(const f32x4*)(gb + col);
      bf16_t* dst = M + (size_t)row * 1024 + col;
      f32x4 o = {0.f, 0.f, 0.f, 0.f};
      if (br > 0) o = load4bf(dst);
      for (int q = 0; q < 4; ++q) o[q] += sigmoidf_(v[q] + b[q]) * p[q];
      store4bf(dst, o);
    )
  } };
struct EpiP2 { int kind; bf16_t* O; int ldc; float* E;
  DI void operator()(AccRef acc, int brow, int bcol, int wr, int wc, int fr, int fq) const {
    if (kind == 0) { FOR_ACC( store4bf(O + (size_t)row * ldc + col, v); ) }
    else { FOR_ACC( if (col < 128) { *(f32x4*)(E + (size_t)row * 128 + col) = v; } ) }
  } };
struct EpiP6 { int kind; uint2* scr; bf16_t* M; const float* gb; int br;
  DI void operator()(AccRef acc, int brow, int bcol, int wr, int wc, int fr, int fq) const {
    uint2* sl = scr + (((wr * 4 + wc) * 4 + fq) * 16 + fr);
    asm volatile("" : "+v"(sl));
    if (kind == 0) { FOR_ACC( uint2 w; w.x = pack2(v[0], v[1]); w.y = pack2(v[2], v[3]); sl[(((ai * 2 + bj) * 4 + m) * 2 + n) * NTHR] = w; ) }
    else {
      FOR_ACC(
        const uint2 w = sl[(((ai * 2 + bj) * 4 + m) * 2 + n) * NTHR];
        f32x4 p; p[0] = __uint_as_float(w.x << 16); p[1] = __uint_as_float(w.x & 0xffff0000u); p[2] = __uint_as_float(w.y << 16); p[3] = __uint_as_float(w.y & 0xffff0000u);
        const f32x4 b = *(const f32x4*)(gb + col);
        bf16_t* dst = M + (size_t)row * 1024 + col;
        f32x4 o = {0.f, 0.f, 0.f, 0.f};
        if (br > 0) o = load4bf(dst);
        for (int q = 0; q < 4; ++q) o[q] += sigmoidf_(v[q] + b[q]) * p[q];
        store4bf(dst, o);
      )
    }
  } };
struct EpiResid { const float* src; float* dst;
  DI void operator()(AccRef acc, int brow, int bcol, int wr, int wc, int fr, int fq) const {
    FOR_ACC(
      const f32x4 x = *(const f32x4*)(src + (size_t)row * 1024 + col);
      *(f32x4*)(dst + (size_t)row * 1024 + col) = x + v;
    )
  } };
struct EpiRelu2 { bf16_t* O;
  DI void operator()(AccRef acc, int brow, int bcol, int wr, int wc, int fr, int fq) const {
    FOR_ACC( f32x4 o; for (int q = 0; q < 4; ++q) { const float r = fmaxf(v[q], 0.f); o[q] = r * r; } store4bf(O + (size_t)row * DFF + col, o); )
  } };

DI void rmsnorm_rows(const float* __restrict__ src, const float* __restrict__ g, bf16_t* __restrict__ dst) {
  const int wave = threadIdx.x >> 6, lane = threadIdx.x & 63;
  f32x4 gv[4];
#pragma unroll
  for (int i = 0; i < 4; ++i) gv[i] = *(const f32x4*)(g + lane * 4 + 256 * i);
  for (int row = (blockIdx.x * 8 + wave) * 2; row < T_; row += gridDim.x * 16) {
    f32x4 x[8]; float ss0 = 0.f, ss1 = 0.f;
#pragma unroll
    for (int i = 0; i < 8; ++i) x[i] = *(const f32x4*)(src + (size_t)(row + (i >> 2)) * 1024 + lane * 4 + 256 * (i & 3));
#pragma unroll
    for (int i = 0; i < 4; ++i) { ss0 += x[i][0] * x[i][0] + x[i][1] * x[i][1] + x[i][2] * x[i][2] + x[i][3] * x[i][3]; ss1 += x[i + 4][0] * x[i + 4][0] + x[i + 4][1] * x[i + 4][1] + x[i + 4][2] * x[i + 4][2] + x[i + 4][3] * x[i + 4][3]; }
    ss0 = wave_sum(ss0); ss1 = wave_sum(ss1);
    const float rs0 = rsqrtf(ss0 * (1.f / 1024.f) + EPS), rs1 = rsqrtf(ss1 * (1.f / 1024.f) + EPS);
#pragma unroll
    for (int i = 0; i < 8; ++i) { f32x4 o = x[i] * ((i >> 2) ? rs1 : rs0) * gv[i & 3]; store4bf(dst + (size_t)(row + (i >> 2)) * 1024 + lane * 4 + 256 * (i & 3), o); }
  }
}

DI void xpose_tile(const float* __restrict__ src, int Kd, int Nd, bf16_t* __restrict__ dst, const float* __restrict__ gs, int tix) {
  extern __shared__ __attribute__((aligned(16))) unsigned char smem[];
  float* tile = (float*)smem;
  const int tk = Kd >> 7;
  const int k0 = (tix % tk) * 128, n0 = (tix / tk) * 128;
  const int tid = threadIdx.x;
  __syncthreads();
  f32x4 v[8];
#pragma unroll
  for (int i = 0; i < 8; ++i) { const int r = (tid >> 5) + 16 * i, cq = (tid & 31) * 4; const int n = n0 + cq;
    v[i] = (n + 3 < Nd) ? *(const f32x4*)(src + (size_t)(k0 + r) * Nd + n) : (f32x4){0.f, 0.f, 0.f, 0.f}; }
#pragma unroll
  for (int i = 0; i < 8; ++i) { const int r = (tid >> 5) + 16 * i, cq = (tid & 31) * 4; const float sc = gs ? gs[k0 + r] : 1.f;
    tile[r * 129 + cq] = v[i][0] * sc; tile[r * 129 + cq + 1] = v[i][1] * sc; tile[r * 129 + cq + 2] = v[i][2] * sc; tile[r * 129 + cq + 3] = v[i][3] * sc; }
  __syncthreads();
#pragma unroll
  for (int i = 0; i < 4; ++i) { const int n = tid & 127, kc = ((tid >> 7) + 4 * i) * 8;
    if (n0 + n < Nd) { uint4 w;
      w.x = pack2(tile[(kc + 0) * 129 + n], tile[(kc + 1) * 129 + n]); w.y = pack2(tile[(kc + 2) * 129 + n], tile[(kc + 3) * 129 + n]);
      w.z = pack2(tile[(kc + 4) * 129 + n], tile[(kc + 5) * 129 + n]); w.w = pack2(tile[(kc + 6) * 129 + n], tile[(kc + 7) * 129 + n]);
      *(uint4*)(dst + (size_t)(n0 + n) * Kd + k0 + kc) = w; } }
}

DI void s5_mats_unit(const Ctx& c, int unit) {
  extern __shared__ __attribute__((aligned(16))) unsigned char smem[];
  float* lp_re = (float*)smem;
  float* lp_im = lp_re + 17 * 64;
  float* bb_re = lp_im + 17 * 64;
  float* bb_im = bb_re + 1024;
  float* cr = bb_im + 1024;
  float* ci = cr + 1024;
  float* Kt = ci + 1024;
  float* dv = Kt + 4096;
  const int tid = threadIdx.x;
  bf16_t* ME = (bf16_t*)(c.ws + OFF_MATS);
  bf16_t* MY = (bf16_t*)(c.ws + OFF_MY);
  const int g = unit >> 3, qpart = unit & 7;
  {
    __syncthreads();
    if (tid < 64) {
      const int p = tid;
      const float lre = fminf(c.inp(12, 2048)[g * 64 + p], -1e-4f), lim = c.inp(13, 2048)[g * 64 + p];
      const float step = expf(c.inp(19, 32)[g]);
      for (int d = 0; d <= 16; ++d) { const float mag = expf(lre * step * d); float s, co; sincosf(lim * step * d, &s, &co); lp_re[d * 64 + p] = mag * co; lp_im[d * 64 + p] = mag * s; }
      const float nr = lp_re[64 + p] - 1.f, ni = lp_im[64 + p];
      const float den = 1.f / (lre * lre + lim * lim);
      const float kr = (nr * lre + ni * lim) * den, ki = (ni * lre - nr * lim) * den;
      for (int i = 0; i < 16; ++i) { const float br = c.inp(14, 32768)[(g * 64 + p) * 16 + i], bi = c.inp(15, 32768)[(g * 64 + p) * 16 + i]; bb_re[p * 16 + i] = kr * br - ki * bi; bb_im[p * 16 + i] = kr * bi + ki * br; }
    }
    for (int i = tid; i < 1024; i += NTHR) { cr[i] = c.inp(16, 32768)[g * 1024 + i]; ci[i] = c.inp(17, 32768)[g * 1024 + i]; }
    if (tid < 16) dv[tid] = c.inp(18, 512)[g * 16 + tid];
    __syncthreads();
    for (int idx = tid; idx < 512 * (qpart + 1); idx += NTHR) {
      const int d = idx >> 8, i = (idx >> 4) & 15, i2 = idx & 15; float s = 0.f;
      for (int p = 0; p < 64; ++p) { const float lr = lp_re[d * 64 + p], li = lp_im[d * 64 + p], br = bb_re[p * 16 + i2], bi = bb_im[p * 16 + i2];
        const float wre = lr * br - li * bi, wim = lr * bi + li * br; s += cr[i * 64 + p] * wre - ci[i * 64 + p] * wim; }
      Kt[idx] = s;
    }
    __syncthreads();
    for (int idx = qpart * 32 * 384 + tid; idx < (qpart + 1) * 32 * 384; idx += NTHR) {
      const int n = idx / 384, k = idx % 384, j = n >> 4, i = n & 15; float val;
      if (k < 256) { const int j2 = k >> 4, i2 = k & 15; val = (j >= j2) ? Kt[((j - j2) * 16 + i) * 16 + i2] + ((j == j2 && i == i2) ? dv[i] : 0.f) : 0.f; }
      else if (k < 320) { const int p = k - 256; val = cr[i * 64 + p] * lp_re[(j + 1) * 64 + p] - ci[i * 64 + p] * lp_im[(j + 1) * 64 + p]; }
      else { const int p = k - 320; val = -(cr[i * 64 + p] * lp_im[(j + 1) * 64 + p] + ci[i * 64 + p] * lp_re[(j + 1) * 64 + p]); }
      MY[(size_t)g * 256 * 384 + idx] = f2bf(val);
    }
    for (int idx = qpart * 32 * 256 + tid; idx < (qpart + 1) * 32 * 256; idx += NTHR) {
      const int n = idx >> 8, k = idx & 255, j2 = k >> 4, i2 = k & 15; float val = 0.f;
      if (n < 128) { const int p = n & 63; const float lr = lp_re[(15 - j2) * 64 + p], li = lp_im[(15 - j2) * 64 + p], br = bb_re[p * 16 + i2], bi = bb_im[p * 16 + i2];
        val = (n < 64) ? (lr * br - li * bi) : (lr * bi + li * br); }
      ME[(size_t)g * 65536 + idx] = f2bf(val);
    }
  }
}

DI void rope_table(const Ctx& c) {
  float* cs = (float*)(c.ws + OFF_ROPE); float* sn = cs + 8192 * 16;
  for (int idx = blockIdx.x * NTHR + threadIdx.x; idx < 8192 * 16; idx += gridDim.x * NTHR) {
    const int pos = idx >> 4, i = idx & 15;
    const float invf = powf(10000.f, -(float)(2 * i) / 32.f);
    const float ang = (float)pos * invf;
    cs[idx] = (float)cos((double)ang); sn[idx] = (float)sin((double)ang);
  }
}

DI void unpack8(const uint4& w, float* f) {
  f[0] = __uint_as_float(w.x << 16); f[1] = __uint_as_float(w.x & 0xffff0000u); f[2] = __uint_as_float(w.y << 16); f[3] = __uint_as_float(w.y & 0xffff0000u);
  f[4] = __uint_as_float(w.z << 16); f[5] = __uint_as_float(w.z & 0xffff0000u); f[6] = __uint_as_float(w.w << 16); f[7] = __uint_as_float(w.w & 0xffff0000u);
}
struct GlaPre { uint4 glr; float wg0, wg1, bgv; };
DI GlaPre gla_preload(const Ctx& c, const bf16_t* Z, int t0, int h, int tid) {
  const float* wg = c.inp(9, 16 * 256); const float* bg = c.inp(10, 256);
  GlaPre p; p.glr = make_uint4(0, 0, 0, 0);
  if (tid < 128) p.glr = *(const uint4*)(Z + (size_t)(t0 + (tid >> 1)) * ZLD + C_GLR + (tid & 1) * 8);
  p.wg0 = wg[(tid >> 6) * 256 + h * 64 + (tid & 63)]; p.wg1 = wg[((tid + NTHR) >> 6) * 256 + h * 64 + (tid & 63)];
  p.bgv = bg[h * 64 + (tid & 63)];
  return p;
}
DI void gla_bc(const GlaPre& pre, int tid, float* glr_s, float* wg_s, float* bc_s) {
  if (tid < 128) { const int cc = tid >> 1, r0 = (tid & 1) * 8; float f[8]; unpack8(pre.glr, f);
#pragma unroll
    for (int i = 0; i < 8; ++i) glr_s[cc * 16 + r0 + i] = f[i]; }
  wg_s[tid] = pre.wg0; wg_s[tid + NTHR] = pre.wg1;
  __syncthreads();
  const int d = tid & 63, seg = tid >> 6;
  const float bgv = pre.bgv;
  float wv[16];
#pragma unroll
  for (int r = 0; r < 16; ++r) wv[r] = wg_s[r * 64 + d];
  float run = 0.f, loc[8];
#pragma unroll
  for (int i = 0; i < 8; ++i) {
    const int cc = seg * 8 + i; float a = bgv;
#pragma unroll
    for (int r = 0; r < 16; ++r) a += glr_s[cc * 16 + r] * wv[r];
    run += (fminf(a, 0.f) - __logf(1.f + __expf(-fabsf(a)))) * (1.f / 16.f);
    loc[i] = run;
  }
  __syncthreads();
  glr_s[seg * 64 + d] = run;
  __syncthreads();
  float off = 0.f;
  for (int s2 = 0; s2 < seg; ++s2) off += glr_s[s2 * 64 + d];
#pragma unroll
  for (int i = 0; i < 8; ++i) bc_s[(seg * 8 + i) * 64 + d] = loc[i] + off;
  __syncthreads();
}

constexpr int GQS = 72;
DI void gla_pass1(const Ctx& c, int unit) {
  extern __shared__ __attribute__((aligned(16))) unsigned char smem[];
  float* glr_s = (float*)smem; float* wg_s = glr_s + 1024; float* bc_s = wg_s + 1024;
  bf16_t* vT = (bf16_t*)(smem + 24576);
  bf16_t* keT = (bf16_t*)(smem + 43008);
  const bf16_t* Z = (const bf16_t*)(c.ws + OFF_Z);
  int tid_; asm volatile("v_mov_b32 %0, %1" : "=v"(tid_) : "v"(threadIdx.x));
  const int tid = tid_, n = unit & 127, bh = unit >> 7, h = bh & 3, b = bh >> 2, t0 = b * L_ + n * 64;
  const int cc = tid & 63, ch = tid >> 6;
  const GlaPre pre = gla_preload(c, Z, t0, h, tid);
  const uint4 wkk = *(const uint4*)(Z + (size_t)(t0 + cc) * ZLD + C_GK + h * 64 + ch * 8);
  const uint4 wv0 = *(const uint4*)(Z + (size_t)(t0 + cc) * ZLD + C_GV + h * 128 + ch * 8), wv1 = *(const uint4*)(Z + (size_t)(t0 + cc) * ZLD + C_GV + h * 128 + (ch + 8) * 8);
  __syncthreads();
  gla_bc(pre, tid, glr_s, wg_s, bc_s);
  { const int d0 = ch * 8; float f[8]; unpack8(wkk, f);
#pragma unroll
    for (int i = 0; i < 8; ++i) keT[(d0 + i) * GQS + cc] = f2bf(f[i] * __expf(bc_s[63 * 64 + d0 + i] - bc_s[cc * 64 + d0 + i])); }
#pragma unroll
  for (int k = 0; k < 2; ++k) { const int e0 = (ch + 8 * k) * 8; const uint4 w = k ? wv1 : wv0;
    const unsigned ww[4] = {w.x, w.y, w.z, w.w};
#pragma unroll
    for (int i = 0; i < 4; ++i) { vT[(e0 + 2 * i) * GQS + cc] = (bf16_t)(ww[i] & 0xffffu); vT[(e0 + 2 * i + 1) * GQS + cc] = (bf16_t)(ww[i] >> 16); } }
  __syncthreads();
  const int wave = tid >> 6, lane = tid & 63, l32 = lane & 31, hb = lane >> 5, mt = wave >> 1, nt = wave & 1;
  f32x16 acc;
#pragma unroll
  for (int i = 0; i < 16; ++i) acc[i] = 0.f;
#pragma unroll
  for (int ks = 0; ks < 4; ++ks) {
    const bf16x8 a = *(const bf16x8*)(vT + (mt * 32 + l32) * GQS + ks * 16 + hb * 8);
    const bf16x8 bq = *(const bf16x8*)(keT + (nt * 32 + l32) * GQS + ks * 16 + hb * 8);
    acc = __builtin_amdgcn_mfma_f32_32x32x16_bf16(a, bq, acc, 0, 0, 0);
  }
  bf16_t* GS = (bf16_t*)(c.ws + OFF_GS) + (size_t)unit * 8192;
#pragma unroll
  for (int r = 0; r < 16; ++r) { const int e = mt * 32 + (r & 3) + 8 * (r >> 2) + 4 * hb; GS[e * 64 + nt * 32 + l32] = f2bf(acc[r]); }
  if (tid < 64) ((float*)(c.ws + OFF_GDEC))[unit * 64 + tid] = __expf(bc_s[63 * 64 + tid]);
}

DI void gla_scan(const Ctx& c, int first_block, int nblocks) {
  bf16_t* GS = (bf16_t*)(c.ws + OFF_GS); const float* dec = (const float*)(c.ws + OFF_GDEC);
  for (int idx = (blockIdx.x - first_block) * NTHR + threadIdx.x; idx < 8 * 8192; idx += nblocks * NTHR) {
    const int bh = idx >> 13, ed = idx & 8191, d = ed & 63;
    float S0 = 0.f, S1 = 0.f;
    bf16_t* p0 = GS + (size_t)bh * 128 * 8192 + ed; const float* dp0 = dec + bh * 128 * 64 + d;
    bf16_t* p1 = p0 + (size_t)8 * 128 * 8192; const float* dp1 = dp0 + 8 * 128 * 64;
#pragma unroll 8
    for (int n = 0; n < 128; ++n) {
      const float ds0 = bf2f(p0[(size_t)n * 8192]), ds1 = bf2f(p1[(size_t)n * 8192]); const float dc0 = dp0[n * 64], dc1 = dp1[n * 64];
      p0[(size_t)n * 8192] = f2bf(S0); p1[(size_t)n * 8192] = f2bf(S1); S0 = dc0 * S0 + ds0; S1 = dc1 * S1 + ds1; }
  }
}

DI void gla_pass3(const Ctx& c, int unit) {
  extern __shared__ __attribute__((aligned(16))) unsigned char smem[];
  float* glr_s = (float*)smem; float* wg_s = glr_s + 1024; float* bc_s = wg_s + 1024;
  bf16_t* qt = (bf16_t*)(smem + 24576);
  bf16_t* kt = (bf16_t*)(smem + 33792);
  bf16_t* vT = (bf16_t*)(smem + 43008);
  bf16_t* ST = (bf16_t*)(smem + 61440);
  bf16_t* As = (bf16_t*)(smem + 79872);
  float* o_s = (float*)(smem + 89088);
  float* red_s = (float*)(smem + 122880);
  bf16_t* Z = (bf16_t*)(c.ws + OFF_Z);
  int tid_; asm volatile("v_mov_b32 %0, %1" : "=v"(tid_) : "v"(threadIdx.x));
  const int tid = tid_, n = unit & 127, bh = unit >> 7, h = bh & 3, b = bh >> 2, t0 = b * L_ + n * 64;
  const bf16_t* GS = (const bf16_t*)(c.ws + OFF_GS) + (size_t)unit * 8192;
  const int cr_ = tid >> 3, d0_ = (tid & 7) * 8, cc_ = tid & 63, ch_ = tid >> 6;
  const GlaPre pre = gla_preload(c, Z, t0, h, tid);
  const uint4 wq = *(const uint4*)(Z + (size_t)(t0 + cr_) * ZLD + C_GQ + h * 64 + d0_), wk = *(const uint4*)(Z + (size_t)(t0 + cr_) * ZLD + C_GK + h * 64 + d0_);
  const uint4 wv0 = *(const uint4*)(Z + (size_t)(t0 + cc_) * ZLD + C_GV + h * 128 + ch_ * 8), wv1 = *(const uint4*)(Z + (size_t)(t0 + cc_) * ZLD + C_GV + h * 128 + (ch_ + 8) * 8);
  const uint4 wS0 = *(const uint4*)(GS + (tid >> 3) * 64 + (tid & 7) * 8), wS1 = *(const uint4*)(GS + ((tid + NTHR) >> 3) * 64 + (tid & 7) * 8);
  const uint4 wr0 = *(const uint4*)(Z + (size_t)(t0 + cc_) * ZLD + C_GR + h * 128 + ch_ * 16), wr1 = *(const uint4*)(Z + (size_t)(t0 + cc_) * ZLD + C_GR + h * 128 + ch_ * 16 + 8);
  __syncthreads();
  gla_bc(pre, tid, glr_s, wg_s, bc_s);
  { const int cr = cr_, d0 = d0_;
    float fq_[8], fk_[8]; unpack8(wq, fq_); unpack8(wk, fk_);
#pragma unroll
    for (int i = 0; i < 8; ++i) { const float ex = __expf(bc_s[cr * 64 + d0 + i]); fq_[i] = fq_[i] * 0.125f * ex; fk_[i] = fk_[i] * __builtin_amdgcn_rcpf(ex); }
    uint4 oq, ok; oq.x = pack2(fq_[0], fq_[1]); oq.y = pack2(fq_[2], fq_[3]); oq.z = pack2(fq_[4], fq_[5]); oq.w = pack2(fq_[6], fq_[7]);
    ok.x = pack2(fk_[0], fk_[1]); ok.y = pack2(fk_[2], fk_[3]); ok.z = pack2(fk_[4], fk_[5]); ok.w = pack2(fk_[6], fk_[7]);
    *(uint4*)(qt + cr * GQS + d0) = oq; *(uint4*)(kt + cr * GQS + d0) = ok; }
  { const int cc = cc_, ch = ch_;
#pragma unroll
    for (int k = 0; k < 2; ++k) { const int e0 = (ch + 8 * k) * 8; const uint4 w = k ? wv1 : wv0;
      const unsigned ww[4] = {w.x, w.y, w.z, w.w};
#pragma unroll
      for (int i = 0; i < 4; ++i) { vT[(e0 + 2 * i) * GQS + cc] = (bf16_t)(ww[i] & 0xffffu); vT[(e0 + 2 * i + 1) * GQS + cc] = (bf16_t)(ww[i] >> 16); } }
    *(uint4*)(ST + (tid >> 3) * GQS + (tid & 7) * 8) = wS0; *(uint4*)(ST + ((tid + NTHR) >> 3) * GQS + (tid & 7) * 8) = wS1; }
  __syncthreads();
  const int wave = tid >> 6, lane = tid & 63, l32 = lane & 31, hb = lane >> 5;
  if (wave < 4) {
    const int mt = wave >> 1, nt = wave & 1;
    f32x16 acc;
#pragma unroll
    for (int i = 0; i < 16; ++i) acc[i] = 0.f;
#pragma unroll
    for (int ks = 0; ks < 4; ++ks) {
      const bf16x8 a = *(const bf16x8*)(qt + (mt * 32 + l32) * GQS + ks * 16 + hb * 8);
      const bf16x8 bq = *(const bf16x8*)(kt + (nt * 32 + l32) * GQS + ks * 16 + hb * 8);
      acc = __builtin_amdgcn_mfma_f32_32x32x16_bf16(a, bq, acc, 0, 0, 0);
    }
#pragma unroll
    for (int r = 0; r < 16; ++r) { const int cr = mt * 32 + (r & 3) + 8 * (r >> 2) + 4 * hb, sc = nt * 32 + l32; As[cr * GQS + sc] = (sc <= cr) ? f2bf(acc[r]) : (bf16_t)0; }
  }
  __syncthreads();
  {
    const int mt = wave >> 2, nt = wave & 3;
    f32x16 acc;
#pragma unroll
    for (int i = 0; i < 16; ++i) acc[i] = 0.f;
#pragma unroll
    for (int ks = 0; ks < 4; ++ks) {
      const bf16x8 a = *(const bf16x8*)(As + (mt * 32 + l32) * GQS + ks * 16 + hb * 8);
      const bf16x8 bq = *(const bf16x8*)(vT + (nt * 32 + l32) * GQS + ks * 16 + hb * 8);
      acc = __builtin_amdgcn_mfma_f32_32x32x16_bf16(a, bq, acc, 0, 0, 0);
    }
#pragma unroll
    for (int ks = 0; ks < 4; ++ks) {
      const bf16x8 a = *(const bf16x8*)(qt + (mt * 32 + l32) * GQS + ks * 16 + hb * 8);
      const bf16x8 bq = *(const bf16x8*)(ST + (nt * 32 + l32) * GQS + ks * 16 + hb * 8);
      acc = __builtin_amdgcn_mfma_f32_32x32x16_bf16(a, bq, acc, 0, 0, 0);
    }
#pragma unroll
    for (int r = 0; r < 16; ++r) { const int cr = mt * 32 + (r & 3) + 8 * (r >> 2) + 4 * hb; o_s[cr * 132 + nt * 32 + l32] = acc[r]; }
  }
  __syncthreads();
  const int cc = tid & 63, wg8 = tid >> 6, e0 = wg8 * 16;
  float o[16];
#pragma unroll
  for (int q = 0; q < 4; ++q) { const f32x4 v = *(const f32x4*)(o_s + cc * 132 + e0 + q * 4); o[q * 4] = v[0]; o[q * 4 + 1] = v[1]; o[q * 4 + 2] = v[2]; o[q * 4 + 3] = v[3]; }
  float ss = 0.f;
#pragma unroll
  for (int i = 0; i < 16; ++i) ss += o[i] * o[i];
  red_s[wg8 * 64 + cc] = ss;
  __syncthreads();
  float tot = 0.f;
#pragma unroll
  for (int i = 0; i < 8; ++i) tot += red_s[i * 64 + cc];
  const float rinv = rsqrtf(tot * (1.f / 128.f) + EPS);
  const float* og = c.inp(11, 128);
  bf16_t* op = Z + (size_t)(t0 + cc) * ZLD + C_GV + h * 128 + e0;
  float rr[16]; unpack8(wr0, rr); unpack8(wr1, rr + 8);
#pragma unroll
  for (int q = 0; q < 4; ++q) {
    f32x4 w;
#pragma unroll
    for (int i = 0; i < 4; ++i) { const float rv = rr[q * 4 + i]; w[i] = o[q * 4 + i] * rinv * og[e0 + q * 4 + i] * (rv / (1.f + __expf(-rv))); }
    store4bf(op + q * 4, w);
  }
}

DI void s5_scan(const Ctx& c) {
  extern __shared__ __attribute__((aligned(16))) unsigned char smem[];
  float* end_s = (float*)smem;
  const float* E = (const float*)(c.ws + OFF_EOA); bf16_t* UA = (bf16_t*)(c.ws + OFF_UA);
  const int tid = threadIdx.x, p = tid & 63, seg = tid >> 6, g = blockIdx.x >> 2, b = blockIdx.x & 3;
  const float lre = fminf(c.inp(12, 2048)[g * 64 + p], -1e-4f), lim = c.inp(13, 2048)[g * 64 + p];
  const float step = expf(c.inp(19, 32)[g]);
  const float mag = expf(lre * step * 16.f); float sn, cs; sincosf(lim * step * 16.f, &sn, &cs);
  const float ar = mag * cs, ai = mag * sn;
  const size_t row0 = (size_t)g * 2048 + (size_t)b * 512 + (size_t)seg * 64;
  float sr = 0.f, si = 0.f;
#pragma unroll 16
  for (int ch = 0; ch < 64; ++ch) {
    const float er = E[(row0 + ch) * 128 + p], ei = E[(row0 + ch) * 128 + 64 + p];
    const float nr = ar * sr - ai * si + er, ni = ar * si + ai * sr + ei; sr = nr; si = ni;
  }
  __syncthreads();
  end_s[(seg * 64 + p) * 2] = sr; end_s[(seg * 64 + p) * 2 + 1] = si;
  __syncthreads();
  float a64r = ar, a64i = ai;
#pragma unroll
  for (int q = 0; q < 6; ++q) { const float nr = a64r * a64r - a64i * a64i, ni = 2.f * a64r * a64i; a64r = nr; a64i = ni; }
  sr = 0.f; si = 0.f;
  for (int s2 = 0; s2 < seg; ++s2) { const float er = end_s[(s2 * 64 + p) * 2], ei = end_s[(s2 * 64 + p) * 2 + 1]; const float nr = a64r * sr - a64i * si + er, ni = a64r * si + a64i * sr + ei; sr = nr; si = ni; }
#pragma unroll 16
  for (int ch = 0; ch < 64; ++ch) {
    const float er = E[(row0 + ch) * 128 + p], ei = E[(row0 + ch) * 128 + 64 + p];
    UA[(row0 + ch) * 384 + 256 + p] = f2bf(sr); UA[(row0 + ch) * 384 + 320 + p] = f2bf(si);
    const float nr = ar * sr - ai * si + er, ni = ar * si + ai * sr + ei; sr = nr; si = ni;
  }
  __syncthreads();
}

template <int CTRL> DI float dpp_mov(float v) { return __builtin_bit_cast(float, __builtin_amdgcn_update_dpp(0, __builtin_bit_cast(int, v), CTRL, 0xf, 0xf, true)); }
DI void mla_finalize_unit(const Ctx& c, int unit) {
  extern __shared__ __attribute__((aligned(16))) unsigned char smem[];
  constexpr int TOKE = 2464;
  bf16_t* lds = (bf16_t*)smem;
  const int tid = threadIdx.x, wave = tid >> 6, lane = tid & 63;
  const bf16_t* Z = (const bf16_t*)(c.ws + OFF_Z);
  bf16_t* Q = (bf16_t*)(c.ws + OFF_QRAW); bf16_t* KV = (bf16_t*)(c.ws + OFF_KVRAW); bf16_t* KP = (bf16_t*)(c.ws + OFF_KPE2);
  const float* cs = (const float*)(c.ws + OFF_ROPE); const float* sn = cs + 8192 * 16;
  const float* qg = c.inp(7, 96); const float* kg = c.inp(8, 96);
  const int l31 = lane & 31, lpar = l31 ^ 16;
  const float qg0 = qg[lane], qg1 = qg[64 + l31], qg1p = qg[64 + lpar], kg0 = kg[lane], kg1 = kg[64 + l31], kg1p = kg[64 + lpar];
  const float qscale = 0.10206207261596575f * 1.4426950408889634f;
  const size_t tbase = (size_t)unit * 16;
  __syncthreads();
  for (int idx = tid; idx < 16 * 308; idx += NTHR) {
    const int tok = idx / 308, ch = idx - tok * 308; const size_t t = tbase + tok;
    const bf16_t* src = (ch < 84) ? Z + t * ZLD + ch * 8 : (ch < 180 ? Q + t * 768 + (ch - 84) * 8 : KV + t * 1024 + (ch - 180) * 8);
    *(uint4*)(lds + tok * TOKE + ch * 8) = *(const uint4*)src;
  }
  __syncthreads();
#pragma unroll
  for (int ti = 0; ti < 2; ++ti) {
    const int tok = wave * 2 + ti; const int t = (int)tbase + tok;
    const int pos = t & (L_ - 1);
    bf16_t* zr = lds + tok * TOKE; bf16_t* qr = zr + 672; bf16_t* kr = zr + 1440;
    float a0[8], a1[8], a1p[8], k0[8], vv[8], red[19];
    float scq = 0.f, sckv = 0.f;
#pragma unroll
    for (int i = 0; i < 6; ++i) { const float v = bf2f(zr[C_CQ + lane + 64 * i]); scq += v * v; }
#pragma unroll
    for (int i = 0; i < 4; ++i) { const float v = bf2f(zr[C_CKV + lane + 64 * i]); sckv += v * v; }
    const float kpe = (lane < 32) ? bf2f(zr[C_KPE + l31]) : 0.f, kpep = bf2f(zr[C_KPE + lpar]);
#pragma unroll
    for (int h = 0; h < 8; ++h) { a0[h] = bf2f(qr[h * 96 + lane]); a1[h] = (lane < 32) ? bf2f(qr[h * 96 + 64 + l31]) : 0.f; a1p[h] = bf2f(qr[h * 96 + 64 + lpar]);
      k0[h] = bf2f(kr[h * 128 + lane]); vv[h] = bf2f(kr[h * 128 + 64 + lane]); }
    const float cv = cs[pos * 16 + (lane & 15)], sv = sn[pos * 16 + (lane & 15)];
    red[0] = scq; red[1] = sckv; red[2] = kpe * kpe;
#pragma unroll
    for (int h = 0; h < 8; ++h) { red[3 + h] = a0[h] * a0[h] + a1[h] * a1[h]; red[11 + h] = k0[h] * k0[h]; }
#pragma unroll
    for (int k = 0; k < 19; ++k) red[k] += dpp_mov<0xB1>(red[k]);
#pragma unroll
    for (int k = 0; k < 19; ++k) red[k] += dpp_mov<0x4E>(red[k]);
#pragma unroll
    for (int k = 0; k < 19; ++k) red[k] += dpp_mov<0x141>(red[k]);
#pragma unroll
    for (int k = 0; k < 19; ++k) red[k] += dpp_mov<0x140>(red[k]);
    { float tmp[19];
#pragma unroll
      for (int k = 0; k < 19; ++k) tmp[k] = __shfl_xor(red[k], 16);
#pragma unroll
      for (int k = 0; k < 19; ++k) red[k] += tmp[k];
#pragma unroll
      for (int k = 0; k < 19; ++k) tmp[k] = __shfl_xor(red[k], 32);
#pragma unroll
      for (int k = 0; k < 19; ++k) red[k] += tmp[k]; }
    const float rsq = rsqrtf(red[0] * (1.f / 384.f) + EPS), rskv = rsqrtf(red[1] * (1.f / 256.f) + EPS);
#pragma unroll
    for (int h = 0; h < 8; ++h) {
      const float rq = rsq * rsqrtf(rsq * rsq * red[3 + h] * (1.f / 96.f) + EPS);
      const float rk = rsqrtf((rskv * rskv * red[11 + h] + red[2]) * (1.f / 96.f) + EPS);
      const float q0o = a0[h] * rq * qg0 * qscale;
      const float n1 = a1[h] * rq * qg1, n1p = a1p[h] * rq * qg1p;
      const float q1o = ((l31 < 16) ? (n1 * cv - n1p * sv) : (n1p * sv + n1 * cv)) * qscale;
      const float k0o = k0[h] * rskv * rk * kg0;
      const float p1 = kpe * rk * kg1, p1p = kpep * rk * kg1p;
      const float kpo = (l31 < 16) ? (p1 * cv - p1p * sv) : (p1p * sv + p1 * cv);
      qr[h * 96 + lane] = f2bf(q0o);
      if (lane < 32) { qr[h * 96 + 64 + lane] = f2bf(q1o); zr[h * 32 + lane] = f2bf(kpo); }
      kr[h * 128 + lane] = f2bf(k0o); kr[h * 128 + 64 + lane] = f2bf(vv[h] * rskv);
    }
  }
  __syncthreads();
  for (int idx = tid; idx < 16 * 256; idx += NTHR) {
    const int tok = idx >> 8, ch = idx & 255; const size_t t = tbase + tok;
    bf16_t* dst = (ch < 32) ? KP + t * 256 + ch * 8 : (ch < 128 ? Q + t * 768 + (ch - 32) * 8 : KV + t * 1024 + (ch - 128) * 8);
    const int so = (ch < 32) ? ch * 8 : (ch < 128 ? 672 + (ch - 32) * 8 : 1440 + (ch - 128) * 8);
    *(uint4*)dst = *(const uint4*)(lds + tok * TOKE + so);
  }
}

constexpr int KSTR = 104, VSTR = 72;
constexpr int KS_BYTES = 64 * KSTR * 2, VT_BYTES = 64 * VSTR * 2;
DI bf16x8 pack8(const f32x16& x, int s) {
  union { unsigned u[4]; bf16x8 v; } r;
  r.u[0] = pack2(x[8 * s + 0], x[8 * s + 1]); r.u[1] = pack2(x[8 * s + 2], x[8 * s + 3]); r.u[2] = pack2(x[8 * s + 4], x[8 * s + 5]); r.u[3] = pack2(x[8 * s + 6], x[8 * s + 7]);
  return r.v;
}
DI void attn_unit(const Ctx& c, int unit) {
  extern __shared__ __attribute__((aligned(16))) unsigned char smem[];
  int tid_; asm volatile("v_mov_b32 %0, %1" : "=v"(tid_) : "v"(threadIdx.x));
  const int tid = tid_, wave = tid >> 6, lane = tid & 63, l32 = lane & 31, hb = lane >> 5;
  const int qb = unit & 31, bh = unit >> 5, b = bh >> 3, h = bh & 7;
  const size_t tb = (size_t)b * L_;
  const bf16_t* Q = (const bf16_t*)(c.ws + OFF_QRAW); const bf16_t* KV = (const bf16_t*)(c.ws + OFF_KVRAW); const bf16_t* KP = (const bf16_t*)(c.ws + OFF_KPE2);
  bf16_t* OA = (bf16_t*)(c.ws + OFF_Z);
  const int q0 = qb * 256, qw0 = q0 + wave * 32;
  bf16x8 qf[6];
#pragma unroll
  for (int s = 0; s < 6; ++s) qf[s] = *(const bf16x8*)(Q + (tb + qw0 + l32) * 768 + h * 96 + s * 16 + hb * 8);
  f32x16 ot[2];
#pragma unroll
  for (int i = 0; i < 16; ++i) { ot[0][i] = 0.f; ot[1][i] = 0.f; }
  float lrun = 0.f, shift;
  { const float* qg = c.inp(7, 96); const float* kg = c.inp(8, 96);
    float gq = fmaxf(fabsf(qg[lane]), fabsf(qg[64 + l32])), gk = fmaxf(fabsf(kg[lane]), fabsf(kg[64 + l32]));
#pragma unroll
    for (int o = 32; o; o >>= 1) { gq = fmaxf(gq, __shfl_xor(gq, o)); gk = fmaxf(gk, __shfl_xor(gk, o)); }
    shift = fmaxf(9.797959f * 1.442695f * gq * gk - 40.f, 0.f); }
  const int nkt = (q0 + 256) / 64;
  const int kn_row = tid >> 3, kn_ch = tid & 7, kp_row = tid >> 2, kp_ch = tid & 3, v_key = tid & 63, v_ch = tid >> 6;
  const int v_pos = (v_key & ~15) | (8 * ((v_key >> 2) & 1) + 4 * ((v_key >> 3) & 1) + (v_key & 3));
  struct Stg { uint4 kn, kp, v; };
  Stg sA, sB; sA.kp = make_uint4(0, 0, 0, 0); sB.kp = sA.kp;
  auto gload = [&](Stg& g, int k0) {
    g.kn = *(const uint4*)(KV + (tb + k0 + kn_row) * 1024 + h * 128 + kn_ch * 8);
    if (tid < 256) g.kp = *(const uint4*)(KP + ((tb + k0 + kp_row) * 8 + h) * 32 + kp_ch * 8);
    g.v = *(const uint4*)(KV + (tb + k0 + v_key) * 1024 + h * 128 + 64 + v_ch * 8);
  };
  auto lstore = [&](const Stg& g, int buf) {
    unsigned char* ks = smem + buf * KS_BYTES; bf16_t* vt = (bf16_t*)(smem + 4 * KS_BYTES + buf * VT_BYTES);
    *(uint4*)(ks + (kn_row * KSTR + kn_ch * 8) * 2) = g.kn;
    if (tid < 256) *(uint4*)(ks + (kp_row * KSTR + 64 + kp_ch * 8) * 2) = g.kp;
    const unsigned w[4] = {g.v.x, g.v.y, g.v.z, g.v.w};
#pragma unroll
    for (int i = 0; i < 4; ++i) { vt[(v_ch * 8 + 2 * i) * VSTR + v_pos] = (bf16_t)(w[i] & 0xffffu); vt[(v_ch * 8 + 2 * i + 1) * VSTR + v_pos] = (bf16_t)(w[i] >> 16); }
  };
  auto compute = [&](int kt) {
    const int k0 = kt * 64, buf = kt & 3;
    if (k0 <= qw0 + 31) {
      const unsigned char* ks = smem + buf * KS_BYTES; const bf16_t* vt = (const bf16_t*)(smem + 4 * KS_BYTES + buf * VT_BYTES);
      f32x16 st[2];
#pragma unroll
      for (int i = 0; i < 16; ++i) { st[0][i] = 0.f; st[1][i] = 0.f; }
      bf16x8 kf[2][6], vf[2][2][2];
#pragma unroll
      for (int ksub = 0; ksub < 2; ++ksub)
#pragma unroll
        for (int s = 0; s < 6; ++s) kf[ksub][s] = *(const bf16x8*)(ks + ((ksub * 32 + l32) * KSTR + s * 16 + hb * 8) * 2);
#pragma unroll
      for (int ksub = 0; ksub < 2; ++ksub)
#pragma unroll
        for (int s2 = 0; s2 < 2; ++s2)
#pragma unroll
          for (int dt = 0; dt < 2; ++dt) {
            vf[ksub][s2][dt] = *(const bf16x8*)(vt + (dt * 32 + l32) * VSTR + ksub * 32 + 16 * s2 + 8 * hb);
          }
      __builtin_amdgcn_sched_barrier(0);
#pragma unroll
      for (int ksub = 0; ksub < 2; ++ksub)
#pragma unroll
        for (int s = 0; s < 6; ++s) st[ksub] = __builtin_amdgcn_mfma_f32_32x32x16_bf16(kf[ksub][s], qf[s], st[ksub], 0, 0, 0);
      if (k0 + 63 > qw0) {
        const int qpos = qw0 + l32;
#pragma unroll
        for (int ksub = 0; ksub < 2; ++ksub)
#pragma unroll
          for (int r = 0; r < 16; ++r) { const int key = k0 + ksub * 32 + (r & 3) + 8 * (r >> 2) + 4 * hb; if (key > qpos) st[ksub][r] = -1e30f; }
      }
      if (shift > 0.f) {
#pragma unroll
        for (int r = 0; r < 16; ++r) { st[0][r] -= shift; st[1][r] -= shift; }
      }
#pragma unroll
      for (int ksub = 0; ksub < 2; ++ksub) {
        float rs = 0.f;
#pragma unroll
        for (int r = 0; r < 16; ++r) { st[ksub][r] = __builtin_amdgcn_exp2f(st[ksub][r]); rs += st[ksub][r]; }
        lrun += rs;
#pragma unroll
        for (int s2 = 0; s2 < 2; ++s2) {
          const bf16x8 pf = pack8(st[ksub], s2);
#pragma unroll
          for (int dt = 0; dt < 2; ++dt) ot[dt] = __builtin_amdgcn_mfma_f32_32x32x16_bf16(vf[ksub][s2][dt], pf, ot[dt], 0, 0, 0);
        }
      }
    }
  };
  __syncthreads();
  gload(sA, 0); gload(sB, 64);
  lstore(sA, 0); lstore(sB, 1);
  gload(sA, 128); gload(sB, 192);
  __syncthreads();
  for (int kt = 0; kt < nkt; kt += 2) {
    compute(kt);
    compute(kt + 1);
    if (kt + 2 < nkt) { lstore(sA, (kt + 2) & 3); lstore(sB, (kt + 3) & 3); }
    if (kt + 4 < nkt) { gload(sA, (kt + 4) * 64); gload(sB, (kt + 5) * 64); }
    __syncthreads();
  }
  lrun += __shfl_xor(lrun, 32);
  const float inv = 1.f / lrun;
  bf16_t* op = OA + (tb + qw0 + l32) * ZLD + h * 64;
#pragma unroll
  for (int dt = 0; dt < 2; ++dt)
#pragma unroll
    for (int g4 = 0; g4 < 4; ++g4) {
      f32x4 v; v[0] = ot[dt][g4 * 4 + 0] * inv; v[1] = ot[dt][g4 * 4 + 1] * inv; v[2] = ot[dt][g4 * 4 + 2] * inv; v[3] = ot[dt][g4 * 4 + 3] * inv;
      store4bf(op + dt * 32 + 8 * g4 + 4 * hb, v);
    }
}

#ifndef PROBE_A
#define PROBE_A -1
#define PROBE_B -1
#endif
DI void mark(int k) {
  if (PROBE_A >= 0) {
    extern __shared__ __attribute__((aligned(16))) unsigned char smem[];
    if (blockIdx.x == 0 && threadIdx.x == 0) ((volatile unsigned long long*)(smem + LDS_UNIT_OFF - 8 * 33))[k] = wall_clock64();
  }
}
constexpr int N_PH_LAYER = 11;
DI int next_unit(unsigned* ctr) {
  extern __shared__ __attribute__((aligned(16))) unsigned char smem[];
  volatile int* su = (volatile int*)(smem + LDS_UNIT_OFF);
  __syncthreads();
  if (threadIdx.x == 0) *su = (int)atomicAdd(ctr, 1u);
  __syncthreads();
  return *su;
}

DI void run_phase(const Ctx& c, int k) {
  unsigned char* ws = c.ws;
  bf16_t* Z = (bf16_t*)(ws + OFF_Z); bf16_t* H = (bf16_t*)(ws + OFF_H); bf16_t* W = (bf16_t*)(ws + OFF_W); bf16_t* UA = (bf16_t*)(ws + OFF_UA);
  const int G = gridDim.x, vcu = vcu_id();
  const float* xsrc = (c.layer == 0) ? c.in[0] : c.out;
  switch (k) {
    case 0: {
      if (c.layer == 0) mark(0);
      rmsnorm_rows(xsrc, c.inp(1, 1024), H);
      if (c.layer == 0) mark(1);
      if (c.layer == 0) rope_table(c);
      if (c.layer == 0) mark(2);
      if (c.layer == 0) mark(3);
      unsigned* ctr = (unsigned*)(ws + OFF_CTL) + 4 + c.layer;
      for (;;) {
        const int u = next_unit(ctr);
        if (u >= 578 + 256) break;
        if (u >= 578) s5_mats_unit(c, u - 578);
        else if (u < 368) xpose_tile(c.inp(2, (size_t)1024 * DIN), 1024, DIN, W + W_IN, nullptr, u);
        else if (u < 386) xpose_tile(c.inp(4, 384 * 768), 384, 768, W + W_UQ, c.inp(3, 384), u - 368);
        else if (u < 402) xpose_tile(c.inp(6, 256 * 1024), 256, 1024, W + W_UKV, c.inp(5, 256), u - 386);
        else if (u < 418) xpose_tile(c.inp(20, 512 * 512), 512, 512, W + W_GLU, nullptr, u - 402);
        else if (u < 514) { const int v = u - 418, br = v >> 5; xpose_tile(c.inp(22 + br, 512 * 1024), 512, 1024, W + W_BR + (size_t)br * 1024 * 512, nullptr, v & 31); }
        else xpose_tile(c.inp(26, 1024 * 1024), 1024, 1024, W + W_OUT, nullptr, u - 514);
      }
      if (c.layer == 0) mark(4);
    } break;
    case 1: {
      const EpiG1 e{Z, UA};
      gemm_phase<1024, 1024, 1024>(H, W + W_IN, 128 * 11, 11, e);
    } break;
    case 2: {
      for (int u = vcu; u < 896 + 256 + 2048; u += G) {
        if (u < 384) { const EpiP2 e{0, (bf16_t*)(ws + OFF_QRAW), 768, nullptr}; gemm_tile<ZLD, 384, 384>(Z + C_CQ, W + W_UQ, (u / 3) * 256, (u % 3) * 256, e); }
        else if (u < 896) { const int v = u - 384; const EpiP2 e{0, (bf16_t*)(ws + OFF_KVRAW), 1024, nullptr}; gemm_tile<ZLD, 256, 256>(Z + C_CKV, W + W_UKV, (v / 4) * 256, (v % 4) * 256, e); }
        else if (u < 1152) { const int v = u - 896, g = v >> 3, pm = v & 7; const EpiP2 e{1, nullptr, 0, (float*)(ws + OFF_EOA) + (size_t)g * 2048 * 128};
          gemm_tile<384, 256, 256>(UA + (size_t)g * 2048 * 384, (const bf16_t*)(ws + OFF_MATS) + (size_t)g * 65536, pm * 256, 0, e); }
        else gla_pass1(c, u - 1152);
      }
    } break;
    case 3: {
      if (c.layer == 0) mark(5);
      if (blockIdx.x < 128) s5_scan(c); else gla_scan(c, 128, G - 128);
      if (c.layer == 0) mark(6);
      unsigned* ctr = (unsigned*)(ws + OFF_CTL) + 2 + c.layer;
      for (int u = blockIdx.x; u < 2048; u += G) mla_finalize_unit(c, u);
      if (c.layer == 0) mark(7);
    } break;
    case 4: {
      unsigned* ctr = (unsigned*)(ws + OFF_CTL) + c.layer;
      {
        const int xcd = blockIdx.x & 7;
        unsigned* cx = (unsigned*)(ws + OFF_CTL) + 16 + c.layer * 8 + xcd;
        for (;;) { const int u = next_unit(cx); if (u >= 128) break; attn_unit(c, (xcd * 4 + (u >> 5)) * 32 + (31 - (u & 31))); }
      }
      for (;;) {
        const int u = next_unit(ctr);
        if (u >= 256 + 2048) break;
        if (u < 256) { const int g = u >> 3, pm = u & 7; const EpiS5Y e{Z, g};
          gemm_tile<384, 384, 384>(UA + (size_t)g * 2048 * 384, (const bf16_t*)(ws + OFF_MY) + (size_t)g * 256 * 384, pm * 256, 0, e); }
        else gla_pass3(c, u - 256);
      }
    } break;
    case 5: {
      const EpiGLU e{Z, c.inp(21, 512)};
      gemm_phase<ZLD, 512, 512>(Z + C_SU, W + W_GLU, 256, 2, e);
    } break;
    case 6: {
      uint2* scr = (uint2*)(ws + OFF_SCR) + (size_t)blockIdx.x * 16384;
      bf16_t* M = (bf16_t*)(ws + OFF_MERGED);
      int u = vcu;
      if (u < 512) {
        asm volatile("s_waitcnt vmcnt(0) lgkmcnt(0)" ::: "memory");
        __builtin_amdgcn_s_barrier();
        gemm_issue<ZLD, 512>(Z, W + W_BR, (u / 4) * 256, (u % 4) * 256);
        for (; u < 512; u += G) {
          const int brow = (u / 4) * 256, bcol = (u % 4) * 256;
          for (int br = 0; br < 3; ++br) {
            int tidx; asm volatile("v_mov_b32 %0, %1" : "=v"(tidx) : "v"(threadIdx.x));
            const int wid = tidx >> 6, lane = tidx & 63;
            const bf16_t* Wg = W + W_IN + (size_t)(ZLD + br * 1024) * 1024;
            const bf16_t* Wb = W + W_BR + (size_t)br * 1024 * 512;
            const bf16_t* Ab = Z + (br == 0 ? 0 : (br == 1 ? C_GV : C_GR));
            const bf16_t* Abn = Z + (br == 0 ? C_GV : (br == 1 ? C_GR : 0));
            {
              f32x4 acc[2][2][4][2];
              gemm_main<ZLD, 512, 512>(Ab, Wb, brow, bcol, acc);
              gemm_issue<1024, 1024>(H, Wg, brow, bcol);
              const EpiP6 e0{0, scr, M, c.inp(25, 3072) + br * 1024, br};
              e0(acc, brow, bcol, wid >> 2, wid & 3, lane & 15, lane >> 4);
            }
            {
              f32x4 acc[2][2][4][2];
              gemm_main<1024, 1024, 1024>(H, Wg, brow, bcol, acc);
              if (br < 2) gemm_issue<ZLD, 512>(Abn, Wb + 1024 * 512, brow, bcol);
              else if (u + G < 512) gemm_issue<ZLD, 512>(Abn, W + W_BR, ((u + G) / 4) * 256, ((u + G) % 4) * 256);
              const EpiP6 e1{1, scr, M, c.inp(25, 3072) + br * 1024, br};
              e1(acc, brow, bcol, wid >> 2, wid & 3, lane & 15, lane >> 4);
            }
          }
        }
      }
    } break;
    case 7: {
      const EpiResid e{xsrc, c.out};
      gemm_phase<1024, 1024, 1024>((const bf16_t*)(ws + OFF_MERGED), W + W_OUT, 512, 4, e);
    } break;
    case 8: {
      rmsnorm_rows(c.out, c.inp(27, 1024), H);
      for (int u = vcu; u < 512; u += G) {
        if (u < 256) xpose_tile(c.inp(28, (size_t)1024 * 4096), 1024, 4096, (bf16_t*)(ws + OFF_WFF1), nullptr, u);
        else xpose_tile(c.inp(29, (size_t)4096 * 1024), 4096, 1024, (bf16_t*)(ws + OFF_WFF2), nullptr, u - 256);
      }
    } break;
    case 9: {
      const EpiRelu2 e{(bf16_t*)(ws + OFF_FFH)};
      gemm_phase<1024, 1024, 1024>(H, (const bf16_t*)(ws + OFF_WFF1), 128 * 16, 16, e);
    } break;
    case 10: {
      const EpiResid e{c.out, c.out};
      gemm_phase<4096, 4096, 4096>((const bf16_t*)(ws + OFF_FFH), (const bf16_t*)(ws + OFF_WFF2), 512, 4, e);
    } break;
  }
}

DI void grid_barrier(unsigned* ctr, unsigned target) {
  asm volatile("s_waitcnt vmcnt(0)" ::: "memory");
  __syncthreads();
  if (threadIdx.x == 0) {
    __builtin_amdgcn_fence(__ATOMIC_RELEASE, "agent");
    asm volatile("s_waitcnt vmcnt(0)" ::: "memory");
    __hip_atomic_fetch_add(ctr, 1u, __ATOMIC_RELAXED, __HIP_MEMORY_SCOPE_AGENT);
    while (__hip_atomic_load(ctr, __ATOMIC_RELAXED, __HIP_MEMORY_SCOPE_AGENT) < target) __builtin_amdgcn_s_sleep(2);
    __builtin_amdgcn_fence(__ATOMIC_ACQUIRE, "agent");
    asm volatile("s_waitcnt vmcnt(0)" ::: "memory");
  }
  __syncthreads();
}

__global__ void __launch_bounds__(NTHR) mega(Params p) {
  cg::grid_group grid = cg::this_grid();
  Ctx c{p, p.in, p.out, p.ws, 0};
  const int lo = p.ph_lo, hi = p.ph_hi;
  unsigned* bar = (unsigned*)(p.ws + OFF_CTL) + 64;
  const unsigned G_ = gridDim.x;
#define PH(k) if (lo <= (k) && (k) < hi) { c.layer = (k) / N_PH_LAYER; run_phase(c, (k) % N_PH_LAYER); \
    if ((k) + 1 < hi) { if ((k) == lo) grid.sync(); else grid_barrier(bar, (unsigned)((k) - lo) * G_); } }
  PH(0) PH(1) PH(2) PH(3) PH(4) PH(5) PH(6) PH(7) PH(8) PH(9) PH(10)
  PH(11) PH(12) PH(13) PH(14) PH(15) PH(16) PH(17) PH(18) PH(19) PH(20) PH(21)
#undef PH
  if (PROBE_A >= 0 && blockIdx.x == 0) {
    extern __shared__ __attribute__((aligned(16))) unsigned char smem[];
    volatile unsigned long long* mk = (volatile unsigned long long*)(smem + LDS_UNIT_OFF - 8 * 33);
    const unsigned long long dt = mk[PROBE_B] - mk[PROBE_A];
    const unsigned long long t0 = wall_clock64(); while (wall_clock64() - t0 < dt * 4ull) { __builtin_amdgcn_s_sleep(8); }
  }
}

#ifndef MULTI_LAUNCH
#define MULTI_LAUNCH 0
#endif

extern "C" void kernel_launch(void* const* d_in, const int* in_sizes, int n_in,
                              void* d_out, int out_size, void* d_ws, size_t ws_size,
                              hipStream_t stream) {
  static int grid_blocks = 0;
  if (!grid_blocks) {
    if (n_in != 30 || out_size != T_ * D_ || ws_size < WS_END) { fprintf(stderr, "kernel_launch: unexpected shapes n_in=%d out=%d ws=%zu (need %zu)\n", n_in, out_size, ws_size, (size_t)WS_END); grid_blocks = -1; return; }
    int dev = 0, cus = 0, per_cu = 0;
    hipGetDevice(&dev);
    hipDeviceGetAttribute(&cus, hipDeviceAttributeMultiprocessorCount, dev);
    hipFuncSetAttribute((const void*)mega, hipFuncAttributeMaxDynamicSharedMemorySize, LDS_BYTES);
    hipOccupancyMaxActiveBlocksPerMultiprocessor(&per_cu, (const void*)mega, NTHR, LDS_BYTES);
    fprintf(stderr, "cus=%d per_cu=%d ws_size=%zu\n", cus, per_cu, ws_size);
    if (per_cu < 1) { fprintf(stderr, "kernel_launch: occupancy query says 0 blocks/CU\n"); grid_blocks = -1; return; }
    grid_blocks = cus;
  }
  if (grid_blocks < 0) return;
  hipMemsetAsync((char*)d_ws + OFF_CTL, 0, 4096, stream);
  Params p{};
  for (int i = 0; i < 30; ++i) p.in[i] = (const float*)d_in[i];
  p.out = (float*)d_out; p.ws = (unsigned char*)d_ws;
#if MULTI_LAUNCH
  for (int ph = 0; ph < 2 * N_PH_LAYER; ++ph) {
    p.ph_lo = ph; p.ph_hi = ph + 1;
    hipLaunchKernelGGL(mega, dim3(grid_blocks), dim3(NTHR), LDS_BYTES, stream, p);
  }
#else
  p.ph_lo = 0; p.ph_hi = 2 * N_PH_LAYER;
  void* args[] = {&p};
  hipError_t e = hipLaunchCooperativeKernel((void*)mega, dim3(grid_blocks), dim3(NTHR), args, LDS_BYTES, stream);
  if (e != hipSuccess) fprintf(stderr, "coop launch failed: %s\n", hipGetErrorString(e));
#endif
}
```

```cpp
#include <hip/hip_runtime.h>
#include <hip/hip_cooperative_groups.h>
#include <cstdio>
#include <cstdint>
namespace cg = cooperative_groups;

#define DI __device__ __forceinline__
typedef unsigned short bf16_t;
typedef short bf16x8 __attribute__((ext_vector_type(8)));
typedef short s16x4 __attribute__((ext_vector_type(4)));
typedef float f32x4 __attribute__((ext_vector_type(4)));
typedef float f32x16 __attribute__((ext_vector_type(16)));

constexpr int T_ = 32768, L_ = 8192, D_ = 1024, DIN = 5808, DFF = 4096;
constexpr int ZLD = 2736;
constexpr int C_CQ = 0, C_CKV = 384, C_KPE = 640, C_GQ = 672, C_GK = 928, C_GV = 1184, C_GLR = 1696, C_GR = 1712, C_SU = 2224;
constexpr float EPS = 1e-6f;
constexpr int NTHR = 512;
constexpr int LDS_BYTES = 147456;
constexpr int LDS_UNIT_OFF = LDS_BYTES - 16;

constexpr size_t OFF_Z = 0;
constexpr size_t OFF_QRAW = 179306496;
constexpr size_t OFF_KVRAW = OFF_QRAW + 50331648;
constexpr size_t OFF_KPE2 = OFF_KVRAW + 67108864;
constexpr size_t OFF_EOA = OFF_KPE2 + 16777216;
constexpr size_t OFF_H = OFF_EOA + 33554432;
constexpr size_t OFF_GS = OFF_H + 67108864;
constexpr size_t OFF_UA = OFF_GS + 33554432;
constexpr size_t OFF_W = OFF_UA + 50331648;
constexpr size_t W_IN = 0, W_UQ = W_IN + (size_t)DIN * 1024, W_UKV = W_UQ + 768 * 384, W_GLU = W_UKV + 1024 * 256,
                 W_BR = W_GLU + 512 * 512, W_OUT = W_BR + 3 * 1024 * 512, W_END = W_OUT + 1024 * 1024;
constexpr size_t OFF_MATS = OFF_W + ((W_END * 2 + 255) / 256) * 256;
constexpr size_t OFF_MY = OFF_MATS + 32 * 256 * 256 * 2;
constexpr size_t OFF_ROPE = OFF_MY + 32 * 256 * 384 * 2;
constexpr size_t OFF_GDEC = OFF_ROPE + 2 * 8192 * 16 * 4;
constexpr size_t OFF_CTL = OFF_GDEC + 2048 * 64 * 4;
constexpr size_t WS_END = OFF_CTL + 4096;
constexpr size_t OFF_FFH = OFF_Z;
constexpr size_t OFF_MERGED = OFF_QRAW;
constexpr size_t OFF_SCR = OFF_GS;
constexpr size_t OFF_WFF1 = OFF_UA, OFF_WFF2 = OFF_UA + (size_t)4096 * 1024 * 2;
static_assert(WS_END <= 536870912ull, "workspace");
static_assert((size_t)T_ * 4096 * 2 <= OFF_KPE2, "ffh overlay");

struct Params { const float* in[30]; float* out; unsigned char* ws; int ph_lo, ph_hi; };

struct Ctx {
  const Params& P;
  const float* const* in; float* out; unsigned char* ws;
  int layer;
  DI const float* inp(int i, size_t per_layer) const { return P.in[i] + (size_t)layer * per_layer; }
};

DI bf16_t f2bf(float x) { unsigned u = __float_as_uint(x); u += 0x7fffu + ((u >> 16) & 1u); return (bf16_t)(u >> 16); }
DI float bf2f(bf16_t b) { return __uint_as_float(((unsigned)b) << 16); }
typedef __bf16 bf2_t __attribute__((ext_vector_type(2)));
typedef float f32x2 __attribute__((ext_vector_type(2)));
DI unsigned pack2(float lo, float hi) { f32x2 v; v.x = lo; v.y = hi; return __builtin_bit_cast(unsigned, __builtin_convertvector(v, bf2_t)); }
DI float wave_sum(float v) {
#pragma unroll
  for (int o = 32; o; o >>= 1) v += __shfl_xor(v, o);
  return v;
}
DI float sigmoidf_(float x) { return 1.f / (1.f + __expf(-x)); }
DI void store4bf(bf16_t* p, const f32x4& v) { uint2 w; w.x = pack2(v[0], v[1]); w.y = pack2(v[2], v[3]); *(uint2*)p = w; }
DI f32x4 load4bf(const bf16_t* p) { uint2 w = *(const uint2*)p; f32x4 v; v[0] = __uint_as_float(w.x << 16); v[1] = __uint_as_float(w.x & 0xffff0000u); v[2] = __uint_as_float(w.y << 16); v[3] = __uint_as_float(w.y & 0xffff0000u); return v; }

constexpr int BK = 64, HALF = 128, HT = HALF * BK;
DI int lds_byte(int r, int c) { int st = (r >> 4) * 2 + (c >> 5), rr = r & 15, cc = c & 31, ob = rr * 64 + cc * 2; return st * 1024 + (ob ^ (((ob >> 9) & 1) << 5)); }
DI void stage_rc(int b, int& R, int& C) { int st = b / 1024, sb = b % 1024, swz = sb ^ (((sb >> 9) & 1) << 5); R = (st >> 1) * 16 + swz / 64; C = (st & 1) * 32 + (swz % 64) / 2; }

#define FOR_ACC(...) \
  _Pragma("unroll") for (int ai = 0; ai < 2; ++ai) { _Pragma("unroll") for (int m = 0; m < 4; ++m) { const int row = brow + ai * 128 + wr * 64 + m * 16 + fr; \
  _Pragma("unroll") for (int bj = 0; bj < 2; ++bj) _Pragma("unroll") for (int n = 0; n < 2; ++n) { const int col = bcol + bj * 128 + wc * 32 + n * 16 + fq * 4; const f32x4 v = acc[ai][bj][m][n]; __VA_ARGS__ } } asm volatile("" ::: "memory"); }

#define SA(b, h) (shm + ((b) * 2 + (h)) * HT)
#define SB(b, h) (shm + (4 + (b) * 2 + (h)) * HT)
#define STAGE(P, BASE, LD, VO, br, kt) do { const char* _g = (const char*)((BASE) + (long)(br) * (LD) + (long)(kt) * BK); \
    for (int _i = 0; _i < 2; ++_i) { \
      __builtin_amdgcn_global_load_lds((const unsigned*)(_g + VO[_i]), (unsigned*)((char*)(P) + tidx * 16 + _i * 8192), 16, 0, 0); } } while (0)
#define LDA(dst, b, h) for (int m = 0; m < 4; ++m) for (int k = 0; k < 2; ++k) \
    dst[m][k] = *reinterpret_cast<const bf16x8*>((char*)SA(b, h) + lds_byte(wr * 64 + m * 16 + fr, k * 32 + fq * 8))
#define LDB(dst, b, h) for (int n = 0; n < 2; ++n) for (int k = 0; k < 2; ++k) \
    dst[n][k] = *reinterpret_cast<const bf16x8*>((char*)SB(b, h) + lds_byte(wc * 32 + n * 16 + fr, k * 32 + fq * 8))
#define MMA(ai, bj, At, Bf) do { __builtin_amdgcn_s_setprio(1); \
    for (int m = 0; m < 4; ++m) for (int n = 0; n < 2; ++n) for (int k = 0; k < 2; ++k) \
      acc[ai][bj][m][n] = __builtin_amdgcn_mfma_f32_16x16x32_bf16(Bf[n][k], At[m][k], acc[ai][bj][m][n], 0, 0, 0); \
    __builtin_amdgcn_s_setprio(0); } while (0)
#define WAIT_V(n) asm volatile("s_waitcnt vmcnt(" #n ")" ::: "memory")
#define WAIT_L(n) asm volatile("s_waitcnt lgkmcnt(" #n ")" ::: "memory")
#define BAR __builtin_amdgcn_s_barrier()
#define SCHED __builtin_amdgcn_sched_barrier(0)
#define GEMM_TID \
  int tidx; asm volatile("v_mov_b32 %0, %1" : "=v"(tidx) : "v"(threadIdx.x)); \
  unsigned voA[2], voB[2]; \
  for (int i = 0; i < 2; ++i) { int r_, c_; stage_rc(tidx * 16 + i * 8192, r_, c_); voA[i] = (unsigned)(r_ * lda + c_) * 2u; voB[i] = (unsigned)(r_ * ldb + c_) * 2u; }

template <int lda, int ldb>
DI void gemm_issue(const bf16_t* __restrict__ A, const bf16_t* __restrict__ Bt, int brow, int bcol) {
  extern __shared__ __attribute__((aligned(16))) unsigned char smem[];
  bf16_t* shm = (bf16_t*)smem;
  GEMM_TID
  STAGE(SB(0, 0), Bt, ldb, voB, bcol, 0); STAGE(SA(0, 0), A, lda, voA, brow, 0);
  STAGE(SB(0, 1), Bt, ldb, voB, bcol + HALF, 0); STAGE(SA(0, 1), A, lda, voA, brow + HALF, 0);
}

template <int lda, int ldb, int K>
DI void gemm_main(const bf16_t* __restrict__ A, const bf16_t* __restrict__ Bt, int brow, int bcol, f32x4 (&acc)[2][2][4][2]) {
  extern __shared__ __attribute__((aligned(16))) unsigned char smem[];
  bf16_t* shm = (bf16_t*)smem;
  GEMM_TID
  const int wid = tidx >> 6, lane = tidx & 63, wr = wid >> 2, wc = wid & 3, fr = lane & 15, fq = lane >> 4;
#pragma unroll
  for (int a = 0; a < 2; ++a)
#pragma unroll
    for (int b = 0; b < 2; ++b)
#pragma unroll
      for (int m = 0; m < 4; ++m)
#pragma unroll
        for (int n = 0; n < 2; ++n) acc[a][b][m][n] = (f32x4){0.f, 0.f, 0.f, 0.f};
  bf16x8 At[4][2], B0[2][2], B1[2][2];
  const int nt = K / BK;
  if (wr == 1) BAR;
  WAIT_V(4); BAR;
  STAGE(SB(1, 0), Bt, ldb, voB, bcol, 1); STAGE(SA(1, 0), A, lda, voA, brow, 1); STAGE(SB(1, 1), Bt, ldb, voB, bcol + HALF, 1);
  WAIT_V(6); BAR;
  for (int t = 0; t < nt - 2; t += 2) {
    LDB(B0, 0, 0); SCHED; LDA(At, 0, 0); STAGE(SA(1, 1), A, lda, voA, brow + HALF, t + 1);
    WAIT_L(8); BAR; WAIT_L(0); MMA(0, 0, At, B0); BAR; SCHED;
    LDB(B1, 0, 1); STAGE(SB(0, 0), Bt, ldb, voB, bcol, t + 2);
    BAR; WAIT_L(0); MMA(0, 1, At, B1); BAR;
    LDA(At, 0, 1); STAGE(SA(0, 0), A, lda, voA, brow, t + 2);
    BAR; WAIT_L(0); MMA(1, 0, At, B0); BAR; SCHED;
    STAGE(SB(0, 1), Bt, ldb, voB, bcol + HALF, t + 2);
    WAIT_V(6); BAR; MMA(1, 1, At, B1); BAR;
    LDB(B0, 1, 0); SCHED; LDA(At, 1, 0); STAGE(SA(0, 1), A, lda, voA, brow + HALF, t + 2);
    WAIT_L(8); BAR; WAIT_L(0); MMA(0, 0, At, B0); BAR; SCHED;
    LDB(B1, 1, 1); STAGE(SB(1, 0), Bt, ldb, voB, bcol, t + 3);
    BAR; WAIT_L(0); MMA(0, 1, At, B1); BAR;
    LDA(At, 1, 1); STAGE(SA(1, 0), A, lda, voA, brow, t + 3);
    BAR; WAIT_L(0); MMA(1, 0, At, B0); BAR; SCHED;
    STAGE(SB(1, 1), Bt, ldb, voB, bcol + HALF, t + 3);
    WAIT_V(6); BAR; MMA(1, 1, At, B1); BAR;
  }
  { LDB(B0, 0, 0); LDA(At, 0, 0); STAGE(SA(1, 1), A, lda, voA, brow + HALF, nt - 1);
    BAR; WAIT_L(0); MMA(0, 0, At, B0); BAR;
    LDB(B1, 0, 1); BAR; WAIT_L(0); MMA(0, 1, At, B1); BAR;
    LDA(At, 0, 1); WAIT_V(4); BAR; WAIT_L(0); MMA(1, 0, At, B0); MMA(1, 1, At, B1); BAR; }
  { LDB(B0, 1, 0); LDA(At, 1, 0); WAIT_V(2); BAR; WAIT_L(0); MMA(0, 0, At, B0); BAR;
    LDB(B1, 1, 1); WAIT_V(0); BAR; WAIT_L(0); MMA(0, 1, At, B1); BAR;
    LDA(At, 1, 1); BAR; WAIT_L(0); MMA(1, 0, At, B0); MMA(1, 1, At, B1); BAR; }
  if (wr == 0) BAR;
}

template <int lda, int ldb, int K, class Epi>
DI void gemm_tile(const bf16_t* __restrict__ A, const bf16_t* __restrict__ Bt, int brow, int bcol, const Epi& epi) {
  asm volatile("s_waitcnt vmcnt(0) lgkmcnt(0)" ::: "memory");
  __builtin_amdgcn_s_barrier();
  gemm_issue<lda, ldb>(A, Bt, brow, bcol);
  f32x4 acc[2][2][4][2];
  gemm_main<lda, ldb, K>(A, Bt, brow, bcol, acc);
  int tidx; asm volatile("v_mov_b32 %0, %1" : "=v"(tidx) : "v"(threadIdx.x));
  const int wid = tidx >> 6, lane = tidx & 63;
  epi(acc, brow, bcol, wid >> 2, wid & 3, lane & 15, lane >> 4);
}

DI int vcu_id();
template <int lda, int ldb, int K, class Epi>
DI void gemm_phase(const bf16_t* __restrict__ A, const bf16_t* __restrict__ Bt, int ntiles, int nN, const Epi& epi) {
  const int G = gridDim.x; int u = vcu_id();
  if (u >= ntiles) return;
  asm volatile("s_waitcnt vmcnt(0) lgkmcnt(0)" ::: "memory");
  __builtin_amdgcn_s_barrier();
  gemm_issue<lda, ldb>(A, Bt, (u / nN) * 256, (u % nN) * 256);
  for (; u < ntiles; u += G) {
    const int brow = (u / nN) * 256, bcol = (u % nN) * 256;
    f32x4 acc[2][2][4][2];
    gemm_main<lda, ldb, K>(A, Bt, brow, bcol, acc);
    const int un = u + G;
    if (un < ntiles) gemm_issue<lda, ldb>(A, Bt, (un / nN) * 256, (un % nN) * 256);
    int tidx; asm volatile("v_mov_b32 %0, %1" : "=v"(tidx) : "v"(threadIdx.x));
    const int wid = tidx >> 6, lane = tidx & 63;
    epi(acc, brow, bcol, wid >> 2, wid & 3, lane & 15, lane >> 4);
  }
}

DI int vcu_id() { const int G = gridDim.x, bx = blockIdx.x; return (G % 8 == 0) ? (bx % 8) * (G / 8) + bx / 8 : bx; }

typedef const f32x4 (&AccRef)[2][2][4][2];
struct EpiG1 { bf16_t* Z; bf16_t* UA;
  DI void operator()(AccRef acc, int brow, int bcol, int wr, int wc, int fr, int fq) const {
    FOR_ACC(
      if (col < C_SU) { store4bf(Z + (size_t)row * ZLD + col, v); }
      else if (col < ZLD) { const int cc = col - C_SU, g = cc >> 4, i = cc & 15; store4bf(UA + ((size_t)(g * 2048 + (row >> 4)) * 384 + (row & 15) * 16 + i), v); }
    )
  } };
struct EpiBf16 { bf16_t* O; int ldc;
  DI void operator()(AccRef acc, int brow, int bcol, int wr, int wc, int fr, int fq) const {
    FOR_ACC( store4bf(O + (size_t)row * ldc + col, v); )
  } };
struct EpiS5E { float* E;
  DI void operator()(AccRef acc, int brow, int bcol, int wr, int wc, int fr, int fq) const {
    FOR_ACC( if (col < 128) { *(f32x4*)(E + (size_t)row * 128 + col) = v; } )
  } };
DI float gelu_tanh(float x) { const float z = 0.7978845608028654f * (x + 0.044715f * x * x * x); const float t = 1.f - 2.f / (__expf(2.f * z) + 1.f); return 0.5f * x * (1.f + t); }
struct EpiS5Y { bf16_t* Z; int g;
  DI void operator()(AccRef acc, int brow, int bcol, int wr, int wc, int fr, int fq) const {
    FOR_ACC(
      const int j = col >> 4, i = col & 15;
      const size_t t = (size_t)(row >> 9) * 8192 + (size_t)(row & 511) * 16 + j;
      f32x4 o; o[0] = gelu_tanh(v[0]); o[1] = gelu_tanh(v[1]); o[2] = gelu_tanh(v[2]); o[3] = gelu_tanh(v[3]);
      store4bf(Z + t * ZLD + C_SU + g * 16 + i, o);
    )
  } };
struct EpiGLU { bf16_t* Z; const float* bias;
  DI void operator()(AccRef acc, int brow, int bcol, int wr, int wc, int fr, int fq) const {
    FOR_ACC(
      const f32x4 y = load4bf(Z + (size_t)row * ZLD + C_SU + col);
      const f32x4 b = *(const f32x4*)(bias + col);
      f32x4 o; for (int q = 0; q < 4; ++q) o[q] = y[q] * sigmoidf_(v[q] + b[q]);
      store4bf(Z + (size_t)row * ZLD + C_GR + col, o);
    )
  } };
struct EpiScr { uint2* scr;
  DI void operator()(AccRef acc, int brow, int bcol, int wr, int wc, int fr, int fq) const {
    FOR_ACC( uint2 w; w.x = pack2(v[0], v[1]); w.y = pack2(v[2], v[3]); scr[(((ai * 2 + bj) * 4 + m) * 2 + n) * NTHR + threadIdx.x] = w; )
  } };
struct EpiGate { const uint2* scr; bf16_t* M; const float* gb; int br;
  DI void operator()(AccRef acc, int brow, int bcol, int wr, int wc, int fr, int fq) const {
    FOR_ACC(
      const uint2 w = scr[(((ai * 2 + bj) * 4 + m) * 2 + n) * NTHR + threadIdx.x];
      f32x4 p; p[0] = __uint_as_float(w.x << 16); p[1] = __uint_as_float(w.x & 0xffff0000u); p[2] = __uint_as_float(w.y << 16); p[3] = __uint_as_float(w.y & 0xffff0000u);
      const f32x4 b = *(const f32x4*)(gb + col);
      bf16_t* dst = M + (size_t)row * 1024 + col;
      f32x4 o = {0.f, 0.f, 0.f, 0.f};
      if (br > 0) o = load4bf(dst);
      for (int q = 0; q < 4; ++q) o[q] += sigmoidf_(v[q] + b[q]) * p[q];
      store4bf(dst, o);
    )
  } };
struct EpiP2 { int kind; bf16_t* O; int ldc; float* E;
  DI void operator()(AccRef acc, int brow, int bcol, int wr, int wc, int fr, int fq) const {
    if (kind == 0) { FOR_ACC( store4bf(O + (size_t)row * ldc + col, v); ) }
    else { FOR_ACC( if (col < 128) { *(f32x4*)(E + (size_t)row * 128 + col) = v; } ) }
  } };
struct EpiP6 { int kind; uint2* scr; bf16_t* M; const float* gb; int br;
  DI void operator()(AccRef acc, int brow, int bcol, int wr, int wc, int fr, int fq) const {
    uint2* sl = scr + (((wr * 4 + wc) * 4 + fq) * 16 + fr);
    asm volatile("" : "+v"(sl));
    if (kind == 0) { FOR_ACC( uint2 w; w.x = pack2(v[0], v[1]); w.y = pack2(v[2], v[3]); sl[(((ai * 2 + bj) * 4 + m) * 2 + n) * NTHR] = w; ) }
    else {
      FOR_ACC(
        const uint2 w = sl[(((ai * 2 + bj) * 4 + m) * 2 + n) * NTHR];
        f32x4 p; p[0] = __uint_as_float(w.x << 16); p[1] = __uint_as_float(w.x & 0xffff0000u); p[2] = __uint_as_float(w.y << 16); p[3] = __uint_as_float(w.y & 0xffff0000u);
        const f32x4 b = *(const f32x4*)(gb + col);
        bf16_t* dst = M + (size_t)row * 1024 + col;
        f32x4 o = {0.f, 0.f, 0.f, 0.f};
        if (br > 0) o = load4bf(dst);
        for (int q = 0; q < 4; ++q) o[q] += sigmoidf_(v[q] + b[q]) * p[q];
        store4bf(dst, o);
      )
    }
  } };
struct EpiResid { const float* src; float* dst;
  DI void operator()(AccRef acc, int brow, int bcol, int wr, int wc, int fr, int fq) const {
    FOR_ACC(
      const f32x4 x = *(const f32x4*)(src + (size_t)row * 1024 + col);
      *(f32x4*)(dst + (size_t)row * 1024 + col) = x + v;
    )
  } };
struct EpiRelu2 { bf16_t* O;
  DI void operator()(AccRef acc, int brow, int bcol, int wr, int wc, int fr, int fq) const {
    FOR_ACC( f32x4 o; for (int q = 0; q < 4; ++q) { const float r = fmaxf(v[q], 0.f); o[q] = r * r; } store4bf(O + (size_t)row * DFF + col, o); )
  } };

DI void rmsnorm_rows(const float* __restrict__ src, const float* __restrict__ g, bf16_t* __restrict__ dst) {
  const int wave = threadIdx.x >> 6, lane = threadIdx.x & 63;
  f32x4 gv[4];
#pragma unroll
  for (int i = 0; i < 4; ++i) gv[i] = *(const f32x4*)(g + lane * 4 + 256 * i);
  for (int row = (blockIdx.x * 8 + wave) * 2; row < T_; row += gridDim.x * 16) {
    f32x4 x[8]; float ss0 = 0.f, ss1 = 0.f;
#pragma unroll
    for (int i = 0; i < 8; ++i) x[i] = *(const f32x4*)(src + (size_t)(row + (i >> 2)) * 1024 + lane * 4 + 256 * (i & 3));
#pragma unroll
    for (int i = 0; i < 4; ++i) { ss0 += x[i][0] * x[i][0] + x[i][1] * x[i][1] + x[i][2] * x[i][2] + x[i][3] * x[i][3]; ss1 += x[i + 4][0] * x[i + 4][0] + x[i + 4][1] * x[i + 4][1] + x[i + 4][2] * x[i + 4][2] + x[i + 4][3] * x[i + 4][3]; }
    ss0 = wave_sum(ss0); ss1 = wave_sum(ss1);
    const float rs0 = rsqrtf(ss0 * (1.f / 1024.f) + EPS), rs1 = rsqrtf(ss1 * (1.f / 1024.f) + EPS);
#pragma unroll
    for (int i = 0; i < 8; ++i) { f32x4 o = x[i] * ((i >> 2) ? rs1 : rs0) * gv[i & 3]; store4bf(dst + (size_t)(row + (i >> 2)) * 1024 + lane * 4 + 256 * (i & 3), o); }
  }
}

DI void xpose_tile(const float* __restrict__ src, int Kd, int Nd, bf16_t* __restrict__ dst, const float* __restrict__ gs, int tix) {
  extern __shared__ __attribute__((aligned(16))) unsigned char smem[];
  float* tile = (float*)smem;
  const int tk = Kd >> 7;
  const int k0 = (tix % tk) * 128, n0 = (tix / tk) * 128;
  const int tid = threadIdx.x;
  __syncthreads();
  f32x4 v[8];
#pragma unroll
  for (int i = 0; i < 8; ++i) { const int r = (tid >> 5) + 16 * i, cq = (tid & 31) * 4; const int n = n0 + cq;
    v[i] = (n + 3 < Nd) ? *(const f32x4*)(src + (size_t)(k0 + r) * Nd + n) : (f32x4){0.f, 0.f, 0.f, 0.f}; }
#pragma unroll
  for (int i = 0; i < 8; ++i) { const int r = (tid >> 5) + 16 * i, cq = (tid & 31) * 4; const float sc = gs ? gs[k0 + r] : 1.f;
    tile[r * 129 + cq] = v[i][0] * sc; tile[r * 129 + cq + 1] = v[i][1] * sc; tile[r * 129 + cq + 2] = v[i][2] * sc; tile[r * 129 + cq + 3] = v[i][3] * sc; }
  __syncthreads();
#pragma unroll
  for (int i = 0; i < 4; ++i) { const int n = tid & 127, kc = ((tid >> 7) + 4 * i) * 8;
    if (n0 + n < Nd) { uint4 w;
      w.x = pack2(tile[(kc + 0) * 129 + n], tile[(kc + 1) * 129 + n]); w.y = pack2(tile[(kc + 2) * 129 + n], tile[(kc + 3) * 129 + n]);
      w.z = pack2(tile[(kc + 4) * 129 + n], tile[(kc + 5) * 129 + n]); w.w = pack2(tile[(kc + 6) * 129 + n], tile[(kc + 7) * 129 + n]);
      *(uint4*)(dst + (size_t)(n0 + n) * Kd + k0 + kc) = w; } }
}

DI void s5_mats_unit(const Ctx& c, int unit) {
  extern __shared__ __attribute__((aligned(16))) unsigned char smem[];
  float* lp_re = (float*)smem;
  float* lp_im = lp_re + 17 * 64;
  float* bb_re = lp_im + 17 * 64;
  float* bb_im = bb_re + 1024;
  float* cr = bb_im + 1024;
  float* ci = cr + 1024;
  float* Kt = ci + 1024;
  float* dv = Kt + 4096;
  const int tid = threadIdx.x;
  bf16_t* ME = (bf16_t*)(c.ws + OFF_MATS);
  bf16_t* MY = (bf16_t*)(c.ws + OFF_MY);
  const int g = unit >> 3, qpart = unit & 7;
  {
    __syncthreads();
    if (tid < 64) {
      const int p = tid;
      const float lre = fminf(c.inp(12, 2048)[g * 64 + p], -1e-4f), lim = c.inp(13, 2048)[g * 64 + p];
      const float step = expf(c.inp(19, 32)[g]);
      for (int d = 0; d <= 16; ++d) { const float mag = expf(lre * step * d); float s, co; sincosf(lim * step * d, &s, &co); lp_re[d * 64 + p] = mag * co; lp_im[d * 64 + p] = mag * s; }
      const float nr = lp_re[64 + p] - 1.f, ni = lp_im[64 + p];
      const float den = 1.f / (lre * lre + lim * lim);
      const float kr = (nr * lre + ni * lim) * den, ki = (ni * lre - nr * lim) * den;
      for (int i = 0; i < 16; ++i) { const float br = c.inp(14, 32768)[(g * 64 + p) * 16 + i], bi = c.inp(15, 32768)[(g * 64 + p) * 16 + i]; bb_re[p * 16 + i] = kr * br - ki * bi; bb_im[p * 16 + i] = kr * bi + ki * br; }
    }
    for (int i = tid; i < 1024; i += NTHR) { cr[i] = c.inp(16, 32768)[g * 1024 + i]; ci[i] = c.inp(17, 32768)[g * 1024 + i]; }
    if (tid < 16) dv[tid] = c.inp(18, 512)[g * 16 + tid];
    __syncthreads();
    for (int idx = tid; idx < 512 * (qpart + 1); idx += NTHR) {
      const int d = idx >> 8, i = (idx >> 4) & 15, i2 = idx & 15; float s = 0.f;
      for (int p = 0; p < 64; ++p) { const float lr = lp_re[d * 64 + p], li = lp_im[d * 64 + p], br = bb_re[p * 16 + i2], bi = bb_im[p * 16 + i2];
        const float wre = lr * br - li * bi, wim = lr * bi + li * br; s += cr[i * 64 + p] * wre - ci[i * 64 + p] * wim; }
      Kt[idx] = s;
    }
    __syncthreads();
    for (int idx = qpart * 32 * 384 + tid; idx < (qpart + 1) * 32 * 384; idx += NTHR) {
      const int n = idx / 384, k = idx % 384, j = n >> 4, i = n & 15; float val;
      if (k < 256) { const int j2 = k >> 4, i2 = k & 15; val = (j >= j2) ? Kt[((j - j2) * 16 + i) * 16 + i2] + ((j == j2 && i == i2) ? dv[i] : 0.f) : 0.f; }
      else if (k < 320) { const int p = k - 256; val = cr[i * 64 + p] * lp_re[(j + 1) * 64 + p] - ci[i * 64 + p] * lp_im[(j + 1) * 64 + p]; }
      else { const int p = k - 320; val = -(cr[i * 64 + p] * lp_im[(j + 1) * 64 + p] + ci[i * 64 + p] * lp_re[(j + 1) * 64 + p]); }
      MY[(size_t)g * 256 * 384 + idx] = f2bf(val);
    }
    for (int idx = qpart * 32 * 256 + tid; idx < (qpart + 1) * 32 * 256; idx += NTHR) {
      const int n = idx >> 8, k = idx & 255, j2 = k >> 4, i2 = k & 15; float val = 0.f;
      if (n < 128) { const int p = n & 63; const float lr = lp_re[(15 - j2) * 64 + p], li = lp_im[(15 - j2) * 64 + p], br = bb_re[p * 16 + i2], bi = bb_im[p * 16 + i2];
        val = (n < 64) ? (lr * br - li * bi) : (lr * bi + li * br); }
      ME[(size_t)g * 65536 + idx] = f2bf(val);
    }
  }
}

DI void rope_table(const Ctx& c) {
  float* cs = (float*)(c.ws + OFF_ROPE); float* sn = cs + 8192 * 16;
  for (int idx = blockIdx.x * NTHR + threadIdx.x; idx < 8192 * 16; idx += gridDim.x * NTHR) {
    const int pos = idx >> 4, i = idx & 15;
    const float invf = powf(10000.f, -(float)(2 * i) / 32.f);
    const float ang = (float)pos * invf;
    cs[idx] = (float)cos((double)ang); sn[idx] = (float)sin((double)ang);
  }
}

DI void unpack8(const uint4& w, float* f) {
  f[0] = __uint_as_float(w.x << 16); f[1] = __uint_as_float(w.x & 0xffff0000u); f[2] = __uint_as_float(w.y << 16); f[3] = __uint_as_float(w.y & 0xffff0000u);
  f[4] = __uint_as_float(w.z << 16); f[5] = __uint_as_float(w.z & 0xffff0000u); f[6] = __uint_as_float(w.w << 16); f[7] = __uint_as_float(w.w & 0xffff0000u);
}
struct GlaPre { uint4 glr; float wg0, wg1, bgv; };
DI GlaPre gla_preload(const Ctx& c, const bf16_t* Z, int t0, int h, int tid) {
  const float* wg = c.inp(9, 16 * 256); const float* bg = c.inp(10, 256);
  GlaPre p; p.glr = make_uint4(0, 0, 0, 0);
  if (tid < 128) p.glr = *(const uint4*)(Z + (size_t)(t0 + (tid >> 1)) * ZLD + C_GLR + (tid & 1) * 8);
  p.wg0 = wg[(tid >> 6) * 256 + h * 64 + (tid & 63)]; p.wg1 = wg[((tid + NTHR) >> 6) * 256 + h * 64 + (tid & 63)];
  p.bgv = bg[h * 64 + (tid & 63)];
  return p;
}
DI void gla_bc(const GlaPre& pre, int tid, float* glr_s, float* wg_s, float* bc_s) {
  if (tid < 128) { const int cc = tid >> 1, r0 = (tid & 1) * 8; float f[8]; unpack8(pre.glr, f);
#pragma unroll
    for (int i = 0; i < 8; ++i) glr_s[cc * 16 + r0 + i] = f[i]; }
  wg_s[tid] = pre.wg0; wg_s[tid + NTHR] = pre.wg1;
  __syncthreads();
  const int d = tid & 63, seg = tid >> 6;
  const float bgv = pre.bgv;
  float wv[16];
#pragma unroll
  for (int r = 0; r < 16; ++r) wv[r] = wg_s[r * 64 + d];
  float run = 0.f, loc[8];
#pragma unroll
  for (int i = 0; i < 8; ++i) {
    const int cc = seg * 8 + i; float a = bgv;
#pragma unroll
    for (int r = 0; r < 16; ++r) a += glr_s[cc * 16 + r] * wv[r];
    run += (fminf(a, 0.f) - __logf(1.f + __expf(-fabsf(a)))) * (1.f / 16.f);
    loc[i] = run;
  }
  __syncthreads();
  glr_s[seg * 64 + d] = run;
  __syncthreads();
  float off = 0.f;
  for (int s2 = 0; s2 < seg; ++s2) off += glr_s[s2 * 64 + d];
#pragma unroll
  for (int i = 0; i < 8; ++i) bc_s[(seg * 8 + i) * 64 + d] = loc[i] + off;
  __syncthreads();
}

constexpr int GQS = 72;
DI void gla_pass1(const Ctx& c, int unit) {
  extern __shared__ __attribute__((aligned(16))) unsigned char smem[];
  float* glr_s = (float*)smem; float* wg_s = glr_s + 1024; float* bc_s = wg_s + 1024;
  bf16_t* vT = (bf16_t*)(smem + 24576);
  bf16_t* keT = (bf16_t*)(smem + 43008);
  const bf16_t* Z = (const bf16_t*)(c.ws + OFF_Z);
  int tid_; asm volatile("v_mov_b32 %0, %1" : "=v"(tid_) : "v"(threadIdx.x));
  const int tid = tid_, n = unit & 127, bh = unit >> 7, h = bh & 3, b = bh >> 2, t0 = b * L_ + n * 64;
  const int cc = tid & 63, ch = tid >> 6;
  const GlaPre pre = gla_preload(c, Z, t0, h, tid);
  const uint4 wkk = *(const uint4*)(Z + (size_t)(t0 + cc) * ZLD + C_GK + h * 64 + ch * 8);
  const uint4 wv0 = *(const uint4*)(Z + (size_t)(t0 + cc) * ZLD + C_GV + h * 128 + ch * 8), wv1 = *(const uint4*)(Z + (size_t)(t0 + cc) * ZLD + C_GV + h * 128 + (ch + 8) * 8);
  __syncthreads();
  gla_bc(pre, tid, glr_s, wg_s, bc_s);
  { const int d0 = ch * 8; float f[8]; unpack8(wkk, f);
#pragma unroll
    for (int i = 0; i < 8; ++i) keT[(d0 + i) * GQS + cc] = f2bf(f[i] * __expf(bc_s[63 * 64 + d0 + i] - bc_s[cc * 64 + d0 + i])); }
#pragma unroll
  for (int k = 0; k < 2; ++k) { const int e0 = (ch + 8 * k) * 8; const uint4 w = k ? wv1 : wv0;
    const unsigned ww[4] = {w.x, w.y, w.z, w.w};
#pragma unroll
    for (int i = 0; i < 4; ++i) { vT[(e0 + 2 * i) * GQS + cc] = (bf16_t)(ww[i] & 0xffffu); vT[(e0 + 2 * i + 1) * GQS + cc] = (bf16_t)(ww[i] >> 16); } }
  __syncthreads();
  const int wave = tid >> 6, lane = tid & 63, l32 = lane & 31, hb = lane >> 5, mt = wave >> 1, nt = wave & 1;
  f32x16 acc;
#pragma unroll
  for (int i = 0; i < 16; ++i) acc[i] = 0.f;
#pragma unroll
  for (int ks = 0; ks < 4; ++ks) {
    const bf16x8 a = *(const bf16x8*)(vT + (mt * 32 + l32) * GQS + ks * 16 + hb * 8);
    const bf16x8 bq = *(const bf16x8*)(keT + (nt * 32 + l32) * GQS + ks * 16 + hb * 8);
    acc = __builtin_amdgcn_mfma_f32_32x32x16_bf16(a, bq, acc, 0, 0, 0);
  }
  bf16_t* GS = (bf16_t*)(c.ws + OFF_GS) + (size_t)unit * 8192;
#pragma unroll
  for (int r = 0; r < 16; ++r) { const int e = mt * 32 + (r & 3) + 8 * (r >> 2) + 4 * hb; GS[e * 64 + nt * 32 + l32] = f2bf(acc[r]); }
  if (tid < 64) ((float*)(c.ws + OFF_GDEC))[unit * 64 + tid] = __expf(bc_s[63 * 64 + tid]);
}

DI void gla_scan(const Ctx& c, int first_block, int nblocks) {
  bf16_t* GS = (bf16_t*)(c.ws + OFF_GS); const float* dec = (const float*)(c.ws + OFF_GDEC);
  for (int idx = (blockIdx.x - first_block) * NTHR + threadIdx.x; idx < 8 * 8192; idx += nblocks * NTHR) {
    const int bh = idx >> 13, ed = idx & 8191, d = ed & 63;
    float S0 = 0.f, S1 = 0.f;
    bf16_t* p0 = GS + (size_t)bh * 128 * 8192 + ed; const float* dp0 = dec + bh * 128 * 64 + d;
    bf16_t* p1 = p0 + (size_t)8 * 128 * 8192; const float* dp1 = dp0 + 8 * 128 * 64;
#pragma unroll 8
    for (int n = 0; n < 128; ++n) {
      const float ds0 = bf2f(p0[(size_t)n * 8192]), ds1 = bf2f(p1[(size_t)n * 8192]); const float dc0 = dp0[n * 64], dc1 = dp1[n * 64];
      p0[(size_t)n * 8192] = f2bf(S0); p1[(size_t)n * 8192] = f2bf(S1); S0 = dc0 * S0 + ds0; S1 = dc1 * S1 + ds1; }
  }
}

DI void gla_pass3(const Ctx& c, int unit) {
  extern __shared__ __attribute__((aligned(16))) unsigned char smem[];
  float* glr_s = (float*)smem; float* wg_s = glr_s + 1024; float* bc_s = wg_s + 1024;
  bf16_t* qt = (bf16_t*)(smem + 24576);
  bf16_t* kt = (bf16_t*)(smem + 33792);
  bf16_t* vT = (bf16_t*)(smem + 43008);
  bf16_t* ST = (bf16_t*)(smem + 61440);
  bf16_t* As = (bf16_t*)(smem + 79872);
  float* o_s = (float*)(smem + 89088);
  float* red_s = (float*)(smem + 122880);
  bf16_t* Z = (bf16_t*)(c.ws + OFF_Z);
  int tid_; asm volatile("v_mov_b32 %0, %1" : "=v"(tid_) : "v"(threadIdx.x));
  const int tid = tid_, n = unit & 127, bh = unit >> 7, h = bh & 3, b = bh >> 2, t0 = b * L_ + n * 64;
  const bf16_t* GS = (const bf16_t*)(c.ws + OFF_GS) + (size_t)unit * 8192;
  const int cr_ = tid >> 3, d0_ = (tid & 7) * 8, cc_ = tid & 63, ch_ = tid >> 6;
  const GlaPre pre = gla_preload(c, Z, t0, h, tid);
  const uint4 wq = *(const uint4*)(Z + (size_t)(t0 + cr_) * ZLD + C_GQ + h * 64 + d0_), wk = *(const uint4*)(Z + (size_t)(t0 + cr_) * ZLD + C_GK + h * 64 + d0_);
  const uint4 wv0 = *(const uint4*)(Z + (size_t)(t0 + cc_) * ZLD + C_GV + h * 128 + ch_ * 8), wv1 = *(const uint4*)(Z + (size_t)(t0 + cc_) * ZLD + C_GV + h * 128 + (ch_ + 8) * 8);
  const uint4 wS0 = *(const uint4*)(GS + (tid >> 3) * 64 + (tid & 7) * 8), wS1 = *(const uint4*)(GS + ((tid + NTHR) >> 3) * 64 + (tid & 7) * 8);
  const uint4 wr0 = *(const uint4*)(Z + (size_t)(t0 + cc_) * ZLD + C_GR + h * 128 + ch_ * 16), wr1 = *(const uint4*)(Z + (size_t)(t0 + cc_) * ZLD + C_GR + h * 128 + ch_ * 16 + 8);
  __syncthreads();
  gla_bc(pre, tid, glr_s, wg_s, bc_s);
  { const int cr = cr_, d0 = d0_;
    float fq_[8], fk_[8]; unpack8(wq, fq_); unpack8(wk, fk_);
#pragma unroll
    for (int i = 0; i < 8; ++i) { const float ex = __expf(bc_s[cr * 64 + d0 + i]); fq_[i] = fq_[i] * 0.125f * ex; fk_[i] = fk_[i] * __builtin_amdgcn_rcpf(ex); }
    uint4 oq, ok; oq.x = pack2(fq_[0], fq_[1]); oq.y = pack2(fq_[2], fq_[3]); oq.z = pack2(fq_[4], fq_[5]); oq.w = pack2(fq_[6], fq_[7]);
    ok.x = pack2(fk_[0], fk_[1]); ok.y = pack2(fk_[2], fk_[3]); ok.z = pack2(fk_[4], fk_[5]); ok.w = pack2(fk_[6], fk_[7]);
    *(uint4*)(qt + cr * GQS + d0) = oq; *(uint4*)(kt + cr * GQS + d0) = ok; }
  { const int cc = cc_, ch = ch_;
#pragma unroll
    for (int k = 0; k < 2; ++k) { const int e0 = (ch + 8 * k) * 8; const uint4 w = k ? wv1 : wv0;
      const unsigned ww[4] = {w.x, w.y, w.z, w.w};
#pragma unroll
      for (int i = 0; i < 4; ++i) { vT[(e0 + 2 * i) * GQS + cc] = (bf16_t)(ww[i] & 0xffffu); vT[(e0 + 2 * i + 1) * GQS + cc] = (bf16_t)(ww[i] >> 16); } }
    *(uint4*)(ST + (tid >> 3) * GQS + (tid & 7) * 8) = wS0; *(uint4*)(ST + ((tid + NTHR) >> 3) * GQS + (tid & 7) * 8) = wS1; }
  __syncthreads();
  const int wave = tid >> 6, lane = tid & 63, l32 = lane & 31, hb = lane >> 5;
  if (wave < 4) {
    const int mt = wave >> 1, nt = wave & 1;
    f32x16 acc;
#pragma unroll
    for (int i = 0; i < 16; ++i) acc[i] = 0.f;
#pragma unroll
    for (int ks = 0; ks < 4; ++ks) {
      const bf16x8 a = *(const bf16x8*)(qt + (mt * 32 + l32) * GQS + ks * 16 + hb * 8);
      const bf16x8 bq = *(const bf16x8*)(kt + (nt * 32 + l32) * GQS + ks * 16 + hb * 8);
      acc = __builtin_amdgcn_mfma_f32_32x32x16_bf16(a, bq, acc, 0, 0, 0);
    }
#pragma unroll
    for (int r = 0; r < 16; ++r) { const int cr = mt * 32 + (r & 3) + 8 * (r >> 2) + 4 * hb, sc = nt * 32 + l32; As[cr * GQS + sc] = (sc <= cr) ? f2bf(acc[r]) : (bf16_t)0; }
  }
  __syncthreads();
  {
    const int mt = wave >> 2, nt = wave & 3;
    f32x16 acc;
#pragma unroll
    for (int i = 0; i < 16; ++i) acc[i] = 0.f;
#pragma unroll
    for (int ks = 0; ks < 4; ++ks) {
      const bf16x8 a = *(const bf16x8*)(As + (mt * 32 + l32) * GQS + ks * 16 + hb * 8);
      const bf16x8 bq = *(const bf16x8*)(vT + (nt * 32 + l32) * GQS + ks * 16 + hb * 8);
      acc = __builtin_amdgcn_mfma_f32_32x32x16_bf16(a, bq, acc, 0, 0, 0);
    }
#pragma unroll
    for (int ks = 0; ks < 4; ++ks) {
      const bf16x8 a = *(const bf16x8*)(qt + (mt * 32 + l32) * GQS + ks * 16 + hb * 8);
      const bf16x8 bq = *(const bf16x8*)(ST + (nt * 32 + l32) * GQS + ks * 16 + hb * 8);
      acc = __builtin_amdgcn_mfma_f32_32x32x16_bf16(a, bq, acc, 0, 0, 0);
    }
#pragma unroll
    for (int r = 0; r < 16; ++r) { const int cr = mt * 32 + (r & 3) + 8 * (r >> 2) + 4 * hb; o_s[cr * 132 + nt * 32 + l32] = acc[r]; }
  }
  __syncthreads();
  const int cc = tid & 63, wg8 = tid >> 6, e0 = wg8 * 16;
  float o[16];
#pragma unroll
  for (int q = 0; q < 4; ++q) { const f32x4 v = *(const f32x4*)(o_s + cc * 132 + e0 + q * 4); o[q * 4] = v[0]; o[q * 4 + 1] = v[1]; o[q * 4 + 2] = v[2]; o[q * 4 + 3] = v[3]; }
  float ss = 0.f;
#pragma unroll
  for (int i = 0; i < 16; ++i) ss += o[i] * o[i];
  red_s[wg8 * 64 + cc] = ss;
  __syncthreads();
  float tot = 0.f;
#pragma unroll
  for (int i = 0; i < 8; ++i) tot += red_s[i * 64 + cc];
  const float rinv = rsqrtf(tot * (1.f / 128.f) + EPS);
  const float* og = c.inp(11, 128);
  bf16_t* op = Z + (size_t)(t0 + cc) * ZLD + C_GV + h * 128 + e0;
  float rr[16]; unpack8(wr0, rr); unpack8(wr1, rr + 8);
#pragma unroll
  for (int q = 0; q < 4; ++q) {
    f32x4 w;
#pragma unroll
    for (int i = 0; i < 4; ++i) { const float rv = rr[q * 4 + i]; w[i] = o[q * 4 + i] * rinv * og[e0 + q * 4 + i] * (rv / (1.f + __expf(-rv))); }
    store4bf(op + q * 4, w);
  }
}

DI void s5_scan(const Ctx& c) {
  extern __shared__ __attribute__((aligned(16))) unsigned char smem[];
  float* end_s = (float*)smem;
  const float* E = (const float*)(c.ws + OFF_EOA); bf16_t* UA = (bf16_t*)(c.ws + OFF_UA);
  const int tid = threadIdx.x, p = tid & 63, seg = tid >> 6, g = blockIdx.x >> 2, b = blockIdx.x & 3;
  const float lre = fminf(c.inp(12, 2048)[g * 64 + p], -1e-4f), lim = c.inp(13, 2048)[g * 64 + p];
  const float step = expf(c.inp(19, 32)[g]);
  const float mag = expf(lre * step * 16.f); float sn, cs; sincosf(lim * step * 16.f, &sn, &cs);
  const float ar = mag * cs, ai = mag * sn;
  const size_t row0 = (size_t)g * 2048 + (size_t)b * 512 + (size_t)seg * 64;
  float sr = 0.f, si = 0.f;
#pragma unroll 16
  for (int ch = 0; ch < 64; ++ch) {
    const float er = E[(row0 + ch) * 128 + p], ei = E[(row0 + ch) * 128 + 64 + p];
    const float nr = ar * sr - ai * si + er, ni = ar * si + ai * sr + ei; sr = nr; si = ni;
  }
  __syncthreads();
  end_s[(seg * 64 + p) * 2] = sr; end_s[(seg * 64 + p) * 2 + 1] = si;
  __syncthreads();
  float a64r = ar, a64i = ai;
#pragma unroll
  for (int q = 0; q < 6; ++q) { const float nr = a64r * a64r - a64i * a64i, ni = 2.f * a64r * a64i; a64r = nr; a64i = ni; }
  sr = 0.f; si = 0.f;
  for (int s2 = 0; s2 < seg; ++s2) { const float er = end_s[(s2 * 64 + p) * 2], ei = end_s[(s2 * 64 + p) * 2 + 1]; const float nr = a64r * sr - a64i * si + er, ni = a64r * si + a64i * sr + ei; sr = nr; si = ni; }
#pragma unroll 16
  for (int ch = 0; ch < 64; ++ch) {
    const float er = E[(row0 + ch) * 128 + p], ei = E[(row0 + ch) * 128 + 64 + p];
    UA[(row0 + ch) * 384 + 256 + p] = f2bf(sr); UA[(row0 + ch) * 384 + 320 + p] = f2bf(si);
    const float nr = ar * sr - ai * si + er, ni = ar * si + ai * sr + ei; sr = nr; si = ni;
  }
  __syncthreads();
}

template <int CTRL> DI float dpp_mov(float v) { return __builtin_bit_cast(float, __builtin_amdgcn_update_dpp(0, __builtin_bit_cast(int, v), CTRL, 0xf, 0xf, true)); }
DI void mla_finalize_unit(const Ctx& c, int unit) {
  extern __shared__ __attribute__((aligned(16))) unsigned char smem[];
  constexpr int TOKE = 2464;
  bf16_t* lds = (bf16_t*)smem;
  const int tid = threadIdx.x, wave = tid >> 6, lane = tid & 63;
  const bf16_t* Z = (const bf16_t*)(c.ws + OFF_Z);
  bf16_t* Q = (bf16_t*)(c.ws + OFF_QRAW); bf16_t* KV = (bf16_t*)(c.ws + OFF_KVRAW); bf16_t* KP = (bf16_t*)(c.ws + OFF_KPE2);
  const float* cs = (const float*)(c.ws + OFF_ROPE); const float* sn = cs + 8192 * 16;
  const float* qg = c.inp(7, 96); const float* kg = c.inp(8, 96);
  const int l31 = lane & 31, lpar = l31 ^ 16;
  const float qg0 = qg[lane], qg1 = qg[64 + l31], qg1p = qg[64 + lpar], kg0 = kg[lane], kg1 = kg[64 + l31], kg1p = kg[64 + lpar];
  const float qscale = 0.10206207261596575f * 1.4426950408889634f;
  const size_t tbase = (size_t)unit * 16;
  __syncthreads();
  for (int idx = tid; idx < 16 * 308; idx += NTHR) {
    const int tok = idx / 308, ch = idx - tok * 308; const size_t t = tbase + tok;
    const bf16_t* src = (ch < 84) ? Z + t * ZLD + ch * 8 : (ch < 180 ? Q + t * 768 + (ch - 84) * 8 : KV + t * 1024 + (ch - 180) * 8);
    *(uint4*)(lds + tok * TOKE + ch * 8) = *(const uint4*)src;
  }
  __syncthreads();
#pragma unroll
  for (int ti = 0; ti < 2; ++ti) {
    const int tok = wave * 2 + ti; const int t = (int)tbase + tok;
    const int pos = t & (L_ - 1);
    bf16_t* zr = lds + tok * TOKE; bf16_t* qr = zr + 672; bf16_t* kr = zr + 1440;
    float a0[8], a1[8], a1p[8], k0[8], vv[8], red[19];
    float scq = 0.f, sckv = 0.f;
#pragma unroll
    for (int i = 0; i < 6; ++i) { const float v = bf2f(zr[C_CQ + lane + 64 * i]); scq += v * v; }
#pragma unroll
    for (int i = 0; i < 4; ++i) { const float v = bf2f(zr[C_CKV + lane + 64 * i]); sckv += v * v; }
    const float kpe = (lane < 32) ? bf2f(zr[C_KPE + l31]) : 0.f, kpep = bf2f(zr[C_KPE + lpar]);
#pragma unroll
    for (int h = 0; h < 8; ++h) { a0[h] = bf2f(qr[h * 96 + lane]); a1[h] = (lane < 32) ? bf2f(qr[h * 96 + 64 + l31]) : 0.f; a1p[h] = bf2f(qr[h * 96 + 64 + lpar]);
      k0[h] = bf2f(kr[h * 128 + lane]); vv[h] = bf2f(kr[h * 128 + 64 + lane]); }
    const float cv = cs[pos * 16 + (lane & 15)], sv = sn[pos * 16 + (lane & 15)];
    red[0] = scq; red[1] = sckv; red[2] = kpe * kpe;
#pragma unroll
    for (int h = 0; h < 8; ++h) { red[3 + h] = a0[h] * a0[h] + a1[h] * a1[h]; red[11 + h] = k0[h] * k0[h]; }
#pragma unroll
    for (int k = 0; k < 19; ++k) red[k] += dpp_mov<0xB1>(red[k]);
#pragma unroll
    for (int k = 0; k < 19; ++k) red[k] += dpp_mov<0x4E>(red[k]);
#pragma unroll
    for (int k = 0; k < 19; ++k) red[k] += dpp_mov<0x141>(red[k]);
#pragma unroll
    for (int k = 0; k < 19; ++k) red[k] += dpp_mov<0x140>(red[k]);
    { float tmp[19];
#pragma unroll
      for (int k = 0; k < 19; ++k) tmp[k] = __shfl_xor(red[k], 16);
#pragma unroll
      for (int k = 0; k < 19; ++k) red[k] += tmp[k];
#pragma unroll
      for (int k = 0; k < 19; ++k) tmp[k] = __shfl_xor(red[k], 32);
#pragma unroll
      for (int k = 0; k < 19; ++k) red[k] += tmp[k]; }
    const float rsq = rsqrtf(red[0] * (1.f / 384.f) + EPS), rskv = rsqrtf(red[1] * (1.f / 256.f) + EPS);
#pragma unroll
    for (int h = 0; h < 8; ++h) {
      const float rq = rsq * rsqrtf(rsq * rsq * red[3 + h] * (1.f / 96.f) + EPS);
      const float rk = rsqrtf((rskv * rskv * red[11 + h] + red[2]) * (1.f / 96.f) + EPS);
      const float q0o = a0[h] * rq * qg0 * qscale;
      const float n1 = a1[h] * rq * qg1, n1p = a1p[h] * rq * qg1p;
      const float q1o = ((l31 < 16) ? (n1 * cv - n1p * sv) : (n1p * sv + n1 * cv)) * qscale;
      const float k0o = k0[h] * rskv * rk * kg0;
      const float p1 = kpe * rk * kg1, p1p = kpep * rk * kg1p;
      const float kpo = (l31 < 16) ? (p1 * cv - p1p * sv) : (p1p * sv + p1 * cv);
      qr[h * 96 + lane] = f2bf(q0o);
      if (lane < 32) { qr[h * 96 + 64 + lane] = f2bf(q1o); zr[h * 32 + lane] = f2bf(kpo); }
      kr[h * 128 + lane] = f2bf(k0o); kr[h * 128 + 64 + lane] = f2bf(vv[h] * rskv);
    }
  }
  __syncthreads();
  for (int idx = tid; idx < 16 * 256; idx += NTHR) {
    const int tok = idx >> 8, ch = idx & 255; const size_t t = tbase + tok;
    bf16_t* dst = (ch < 32) ? KP + t * 256 + ch * 8 : (ch < 128 ? Q + t * 768 + (ch - 32) * 8 : KV + t * 1024 + (ch - 128) * 8);
    const int so = (ch < 32) ? ch * 8 : (ch < 128 ? 672 + (ch - 32) * 8 : 1440 + (ch - 128) * 8);
    *(uint4*)dst = *(const uint4*)(lds + tok * TOKE + so);
  }
}

constexpr int KSTR = 104, VSTR = 72;
constexpr int KS_BYTES = 64 * KSTR * 2, VT_BYTES = 64 * VSTR * 2;
DI bf16x8 pack8(const f32x16& x, int s) {
  union { unsigned u[4]; bf16x8 v; } r;
  r.u[0] = pack2(x[8 * s + 0], x[8 * s + 1]); r.u[1] = pack2(x[8 * s + 2], x[8 * s + 3]); r.u[2] = pack2(x[8 * s + 4], x[8 * s + 5]); r.u[3] = pack2(x[8 * s + 6], x[8 * s + 7]);
  return r.v;
}
DI void attn_unit(const Ctx& c, int unit) {
  extern __shared__ __attribute__((aligned(16))) unsigned char smem[];
  int tid_; asm volatile("v_mov_b32 %0, %1" : "=v"(tid_) : "v"(threadIdx.x));
  const int tid = tid_, wave = tid >> 6, lane = tid & 63, l32 = lane & 31, hb = lane >> 5;
  const int qb = unit & 31, bh = unit >> 5, b = bh >> 3, h = bh & 7;
  const size_t tb = (size_t)b * L_;
  const bf16_t* Q = (const bf16_t*)(c.ws + OFF_QRAW); const bf16_t* KV = (const bf16_t*)(c.ws + OFF_KVRAW); const bf16_t* KP = (const bf16_t*)(c.ws + OFF_KPE2);
  bf16_t* OA = (bf16_t*)(c.ws + OFF_Z);
  const int q0 = qb * 256, qw0 = q0 + wave * 32;
  bf16x8 qf[6];
#pragma unroll
  for (int s = 0; s < 6; ++s) qf[s] = *(const bf16x8*)(Q + (tb + qw0 + l32) * 768 + h * 96 + s * 16 + hb * 8);
  f32x16 ot[2];
#pragma unroll
  for (int i = 0; i < 16; ++i) { ot[0][i] = 0.f; ot[1][i] = 0.f; }
  float lrun = 0.f, shift;
  { const float* qg = c.inp(7, 96); const float* kg = c.inp(8, 96);
    float gq = fmaxf(fabsf(qg[lane]), fabsf(qg[64 + l32])), gk = fmaxf(fabsf(kg[lane]), fabsf(kg[64 + l32]));
#pragma unroll
    for (int o = 32; o; o >>= 1) { gq = fmaxf(gq, __shfl_xor(gq, o)); gk = fmaxf(gk, __shfl_xor(gk, o)); }
    shift = fmaxf(9.797959f * 1.442695f * gq * gk - 40.f, 0.f); }
  const int nkt = (q0 + 256) / 64;
  const int kn_row = tid >> 3, kn_ch = tid & 7, kp_row = tid >> 2, kp_ch = tid & 3, v_key = tid & 63, v_ch = tid >> 6;
  const int v_pos = (v_key & ~15) | (8 * ((v_key >> 2) & 1) + 4 * ((v_key >> 3) & 1) + (v_key & 3));
  struct Stg { uint4 kn, kp, v; };
  Stg sA, sB; sA.kp = make_uint4(0, 0, 0, 0); sB.kp = sA.kp;
  auto gload = [&](Stg& g, int k0) {
    g.kn = *(const uint4*)(KV + (tb + k0 + kn_row) * 1024 + h * 128 + kn_ch * 8);
    if (tid < 256) g.kp = *(const uint4*)(KP + ((tb + k0 + kp_row) * 8 + h) * 32 + kp_ch * 8);
    g.v = *(const uint4*)(KV + (tb + k0 + v_key) * 1024 + h * 128 + 64 + v_ch * 8);
  };
  auto lstore = [&](const Stg& g, int buf) {
    unsigned char* ks = smem + buf * KS_BYTES; bf16_t* vt = (bf16_t*)(smem + 4 * KS_BYTES + buf * VT_BYTES);
    *(uint4*)(ks + (kn_row * KSTR + kn_ch * 8) * 2) = g.kn;
    if (tid < 256) *(uint4*)(ks + (kp_row * KSTR + 64 + kp_ch * 8) * 2) = g.kp;
    const unsigned w[4] = {g.v.x, g.v.y, g.v.z, g.v.w};
#pragma unroll
    for (int i = 0; i < 4; ++i) { vt[(v_ch * 8 + 2 * i) * VSTR + v_pos] = (bf16_t)(w[i] & 0xffffu); vt[(v_ch * 8 + 2 * i + 1) * VSTR + v_pos] = (bf16_t)(w[i] >> 16); }
  };
  auto compute = [&](int kt) {
    const int k0 = kt * 64, buf = kt & 3;
    if (k0 <= qw0 + 31) {
      const unsigned char* ks = smem + buf * KS_BYTES; const bf16_t* vt = (const bf16_t*)(smem + 4 * KS_BYTES + buf * VT_BYTES);
      f32x16 st[2];
#pragma unroll
      for (int i = 0; i < 16; ++i) { st[0][i] = 0.f; st[1][i] = 0.f; }
      bf16x8 kf[2][6], vf[2][2][2];
#pragma unroll
      for (int ksub = 0; ksub < 2; ++ksub)
#pragma unroll
        for (int s = 0; s < 6; ++s) kf[ksub][s] = *(const bf16x8*)(ks + ((ksub * 32 + l32) * KSTR + s * 16 + hb * 8) * 2);
#pragma unroll
      for (int ksub = 0; ksub < 2; ++ksub)
#pragma unroll
        for (int s2 = 0; s2 < 2; ++s2)
#pragma unroll
          for (int dt = 0; dt < 2; ++dt) {
            vf[ksub][s2][dt] = *(const bf16x8*)(vt + (dt * 32 + l32) * VSTR + ksub * 32 + 16 * s2 + 8 * hb);
          }
      __builtin_amdgcn_sched_barrier(0);
#pragma unroll
      for (int ksub = 0; ksub < 2; ++ksub)
#pragma unroll
        for (int s = 0; s < 6; ++s) st[ksub] = __builtin_amdgcn_mfma_f32_32x32x16_bf16(kf[ksub][s], qf[s], st[ksub], 0, 0, 0);
      if (k0 + 63 > qw0) {
        const int qpos = qw0 + l32;
#pragma unroll
        for (int ksub = 0; ksub < 2; ++ksub)
#pragma unroll
          for (int r = 0; r < 16; ++r) { const int key = k0 + ksub * 32 + (r & 3) + 8 * (r >> 2) + 4 * hb; if (key > qpos) st[ksub][r] = -1e30f; }
      }
      if (shift > 0.f) {
#pragma unroll
        for (int r = 0; r < 16; ++r) { st[0][r] -= shift; st[1][r] -= shift; }
      }
#pragma unroll
      for (int ksub = 0; ksub < 2; ++ksub) {
        float rs = 0.f;
#pragma unroll
        for (int r = 0; r < 16; ++r) { st[ksub][r] = __builtin_amdgcn_exp2f(st[ksub][r]); rs += st[ksub][r]; }
        lrun += rs;
#pragma unroll
        for (int s2 = 0; s2 < 2; ++s2) {
          const bf16x8 pf = pack8(st[ksub], s2);
#pragma unroll
          for (int dt = 0; dt < 2; ++dt) ot[dt] = __builtin_amdgcn_mfma_f32_32x32x16_bf16(vf[ksub][s2][dt], pf, ot[dt], 0, 0, 0);
        }
      }
    }
  };
  __syncthreads();
  gload(sA, 0); gload(sB, 64);
  lstore(sA, 0); lstore(sB, 1);
  gload(sA, 128); gload(sB, 192);
  __syncthreads();
  for (int kt = 0; kt < nkt; kt += 2) {
    compute(kt);
    compute(kt + 1);
    if (kt + 2 < nkt) { lstore(sA, (kt + 2) & 3); lstore(sB, (kt + 3) & 3); }
    if (kt + 4 < nkt) { gload(sA, (kt + 4) * 64); gload(sB, (kt + 5) * 64); }
    __syncthreads();
  }
  lrun += __shfl_xor(lrun, 32);
  const float inv = 1.f / lrun;
  bf16_t* op = OA + (tb + qw0 + l32) * ZLD + h * 64;
#pragma unroll
  for (int dt = 0; dt < 2; ++dt)
#pragma unroll
    for (int g4 = 0; g4 < 4; ++g4) {
      f32x4 v; v[0] = ot[dt][g4 * 4 + 0] * inv; v[1] = ot[dt][g4 * 4 + 1] * inv; v[2] = ot[dt][g4 * 4 + 2] * inv; v[3] = ot[dt][g4 * 4 + 3] * inv;
      store4bf(op + dt * 32 + 8 * g4 + 4 * hb, v);
    }
}

#ifndef PROBE_A
#define PROBE_A -1
#define PROBE_B -1
#endif
DI void mark(int k) {
  if (PROBE_A >= 0) {
    extern __shared__ __attribute__((aligned(16))) unsigned char smem[];
    if (blockIdx.x == 0 && threadIdx.x == 0) ((volatile unsigned long long*)(smem + LDS_UNIT_OFF - 8 * 33))[k] = wall_clock64();
  }
}
constexpr int N_PH_LAYER = 11;
DI int next_unit(unsigned* ctr) {
  extern __shared__ __attribute__((aligned(16))) unsigned char smem[];
  volatile int* su = (volatile int*)(smem + LDS_UNIT_OFF);
  __syncthreads();
  if (threadIdx.x == 0) *su = (int)atomicAdd(ctr, 1u);
  __syncthreads();
  return *su;
}

DI void run_phase(const Ctx& c, int k) {
  unsigned char* ws = c.ws;
  bf16_t* Z = (bf16_t*)(ws + OFF_Z); bf16_t* H = (bf16_t*)(ws + OFF_H); bf16_t* W = (bf16_t*)(ws + OFF_W); bf16_t* UA = (bf16_t*)(ws + OFF_UA);
  const int G = gridDim.x, vcu = vcu_id();
  const float* xsrc = (c.layer == 0) ? c.in[0] : c.out;
  switch (k) {
    case 0: {
      if (c.layer == 0) mark(0);
      rmsnorm_rows(xsrc, c.inp(1, 1024), H);
      if (c.layer == 0) mark(1);
      if (c.layer == 0) rope_table(c);
      if (c.layer == 0) mark(2);
      if (c.layer == 0) mark(3);
      unsigned* ctr = (unsigned*)(ws + OFF_CTL) + 4 + c.layer;
      for (;;) {
        const int u = next_unit(ctr);
        if (u >= 578 + 256) break;
        if (u >= 578) s5_mats_unit(c, u - 578);
        else if (u < 368) xpose_tile(c.inp(2, (size_t)1024 * DIN), 1024, DIN, W + W_IN, nullptr, u);
        else if (u < 386) xpose_tile(c.inp(4, 384 * 768), 384, 768, W + W_UQ, c.inp(3, 384), u - 368);
        else if (u < 402) xpose_tile(c.inp(6, 256 * 1024), 256, 1024, W + W_UKV, c.inp(5, 256), u - 386);
        else if (u < 418) xpose_tile(c.inp(20, 512 * 512), 512, 512, W + W_GLU, nullptr, u - 402);
        else if (u < 514) { const int v = u - 418, br = v >> 5; xpose_tile(c.inp(22 + br, 512 * 1024), 512, 1024, W + W_BR + (size_t)br * 1024 * 512, nullptr, v & 31); }
        else xpose_tile(c.inp(26, 1024 * 1024), 1024, 1024, W + W_OUT, nullptr, u - 514);
      }
      if (c.layer == 0) mark(4);
    } break;
    case 1: {
      const EpiG1 e{Z, UA};
      gemm_phase<1024, 1024, 1024>(H, W + W_IN, 128 * 11, 11, e);
    } break;
    case 2: {
      for (int u = vcu; u < 896 + 256 + 2048; u += G) {
        if (u < 384) { const EpiP2 e{0, (bf16_t*)(ws + OFF_QRAW), 768, nullptr}; gemm_tile<ZLD, 384, 384>(Z + C_CQ, W + W_UQ, (u / 3) * 256, (u % 3) * 256, e); }
        else if (u < 896) { const int v = u - 384; const EpiP2 e{0, (bf16_t*)(ws + OFF_KVRAW), 1024, nullptr}; gemm_tile<ZLD, 256, 256>(Z + C_CKV, W + W_UKV, (v / 4) * 256, (v % 4) * 256, e); }
        else if (u < 1152) { const int v = u - 896, g = v >> 3, pm = v & 7; const EpiP2 e{1, nullptr, 0, (float*)(ws + OFF_EOA) + (size_t)g * 2048 * 128};
          gemm_tile<384, 256, 256>(UA + (size_t)g * 2048 * 384, (const bf16_t*)(ws + OFF_MATS) + (size_t)g * 65536, pm * 256, 0, e); }
        else gla_pass1(c, u - 1152);
      }
    } break;
    case 3: {
      if (c.layer == 0) mark(5);
      if (blockIdx.x < 128) s5_scan(c); else gla_scan(c, 128, G - 128);
      if (c.layer == 0) mark(6);
      unsigned* ctr = (unsigned*)(ws + OFF_CTL) + 2 + c.layer;
      for (int u = blockIdx.x; u < 2048; u += G) mla_finalize_unit(c, u);
      if (c.layer == 0) mark(7);
    } break;
    case 4: {
      unsigned* ctr = (unsigned*)(ws + OFF_CTL) + c.layer;
      {
        const int xcd = blockIdx.x & 7;
        unsigned* cx = (unsigned*)(ws + OFF_CTL) + 16 + c.layer * 8 + xcd;
        for (;;) { const int u = next_unit(cx); if (u >= 128) break; attn_unit(c, (xcd * 4 + (u >> 5)) * 32 + (31 - (u & 31))); }
      }
      for (;;) {
        const int u = next_unit(ctr);
        if (u >= 256 + 2048) break;
        if (u < 256) { const int g = u >> 3, pm = u & 7; const EpiS5Y e{Z, g};
          gemm_tile<384, 384, 384>(UA + (size_t)g * 2048 * 384, (const bf16_t*)(ws + OFF_MY) + (size_t)g * 256 * 384, pm * 256, 0, e); }
        else gla_pass3(c, u - 256);
      }
    } break;
    case 5: {
      const EpiGLU e{Z, c.inp(21, 512)};
      gemm_phase<ZLD, 512, 512>(Z + C_SU, W + W_GLU, 256, 2, e);
    } break;
    case 6: {
      uint2* scr = (uint2*)(ws + OFF_SCR) + (size_t)blockIdx.x * 16384;
      bf16_t* M = (bf16_t*)(ws + OFF_MERGED);
      int u = vcu;
      if (u < 512) {
        asm volatile("s_waitcnt vmcnt(0) lgkmcnt(0)" ::: "memory");
        __builtin_amdgcn_s_barrier();
        gemm_issue<ZLD, 512>(Z, W + W_BR, (u / 4) * 256, (u % 4) * 256);
        for (; u < 512; u += G) {
          const int brow = (u / 4) * 256, bcol = (u % 4) * 256;
          for (int br = 0; br < 3; ++br) {
            int tidx; asm volatile("v_mov_b32 %0, %1" : "=v"(tidx) : "v"(threadIdx.x));
            const int wid = tidx >> 6, lane = tidx & 63;
            const bf16_t* Wg = W + W_IN + (size_t)(ZLD + br * 1024) * 1024;
            const bf16_t* Wb = W + W_BR + (size_t)br * 1024 * 512;
            const bf16_t* Ab = Z + (br == 0 ? 0 : (br == 1 ? C_GV : C_GR));
            const bf16_t* Abn = Z + (br == 0 ? C_GV : (br == 1 ? C_GR : 0));
            {
              f32x4 acc[2][2][4][2];
              gemm_main<ZLD, 512, 512>(Ab, Wb, brow, bcol, acc);
              gemm_issue<1024, 1024>(H, Wg, brow, bcol);
              const EpiP6 e0{0, scr, M, c.inp(25, 3072) + br * 1024, br};
              e0(acc, brow, bcol, wid >> 2, wid & 3, lane & 15, lane >> 4);
            }
            {
              f32x4 acc[2][2][4][2];
              gemm_main<1024, 1024, 1024>(H, Wg, brow, bcol, acc);
              if (br < 2) gemm_issue<ZLD, 512>(Abn, Wb + 1024 * 512, brow, bcol);
              else if (u + G < 512) gemm_issue<ZLD, 512>(Abn, W + W_BR, ((u + G) / 4) * 256, ((u + G) % 4) * 256);
              const EpiP6 e1{1, scr, M, c.inp(25, 3072) + br * 1024, br};
              e1(acc, brow, bcol, wid >> 2, wid & 3, lane & 15, lane >> 4);
            }
          }
        }
      }
    } break;
    case 7: {
      const EpiResid e{xsrc, c.out};
      gemm_phase<1024, 1024, 1024>((const bf16_t*)(ws + OFF_MERGED), W + W_OUT, 512, 4, e);
    } break;
    case 8: {
      rmsnorm_rows(c.out, c.inp(27, 1024), H);
      for (int u = vcu; u < 512; u += G) {
        if (u < 256) xpose_tile(c.inp(28, (size_t)1024 * 4096), 1024, 4096, (bf16_t*)(ws + OFF_WFF1), nullptr, u);
        else xpose_tile(c.inp(29, (size_t)4096 * 1024), 4096, 1024, (bf16_t*)(ws + OFF_WFF2), nullptr, u - 256);
      }
    } break;
    case 9: {
      const EpiRelu2 e{(bf16_t*)(ws + OFF_FFH)};
      gemm_phase<1024, 1024, 1024>(H, (const bf16_t*)(ws + OFF_WFF1), 128 * 16, 16, e);
    } break;
    case 10: {
      const EpiResid e{c.out, c.out};
      gemm_phase<4096, 4096, 4096>((const bf16_t*)(ws + OFF_FFH), (const bf16_t*)(ws + OFF_WFF2), 512, 4, e);
    } break;
  }
}

DI void grid_barrier(unsigned* ctr, unsigned target) {
  asm volatile("s_waitcnt vmcnt(0)" ::: "memory");
  __syncthreads();
  if (threadIdx.x == 0) {
    __builtin_amdgcn_fence(__ATOMIC_RELEASE, "agent");
    asm volatile("s_waitcnt vmcnt(0)" ::: "memory");
    __hip_atomic_fetch_add(ctr, 1u, __ATOMIC_RELAXED, __HIP_MEMORY_SCOPE_AGENT);
    while (__hip_atomic_load(ctr, __ATOMIC_RELAXED, __HIP_MEMORY_SCOPE_AGENT) < target) __builtin_amdgcn_s_sleep(1);
    __builtin_amdgcn_fence(__ATOMIC_ACQUIRE, "agent");
    asm volatile("s_waitcnt vmcnt(0)" ::: "memory");
  }
  __syncthreads();
}

__global__ void __launch_bounds__(NTHR) mega(Params p) {
  cg::grid_group grid = cg::this_grid();
  Ctx c{p, p.in, p.out, p.ws, 0};
  const int lo = p.ph_lo, hi = p.ph_hi;
  unsigned* bar = (unsigned*)(p.ws + OFF_CTL) + 64;
  const unsigned G_ = gridDim.x;
#define PH(k) if (lo <= (k) && (k) < hi) { c.layer = (k) / N_PH_LAYER; run_phase(c, (k) % N_PH_LAYER); \
    if ((k) + 1 < hi) { if ((k) == lo) grid.sync(); else grid_barrier(bar, (unsigned)((k) - lo) * G_); } }
  PH(0) PH(1) PH(2) PH(3) PH(4) PH(5) PH(6) PH(7) PH(8) PH(9) PH(10)
  PH(11) PH(12) PH(13) PH(14) PH(15) PH(16) PH(17) PH(18) PH(19) PH(20) PH(21)
#undef PH
  if (PROBE_A >= 0 && blockIdx.x == 0) {
    extern __shared__ __attribute__((aligned(16))) unsigned char smem[];
    volatile unsigned long long* mk = (volatile unsigned long long*)(smem + LDS_UNIT_OFF - 8 * 33);
    const unsigned long long dt = mk[PROBE_B] - mk[PROBE_A];
    const unsigned long long t0 = wall_clock64(); while (wall_clock64() - t0 < dt * 4ull) { __builtin_amdgcn_s_sleep(8); }
  }
}

#ifndef MULTI_LAUNCH
#define MULTI_LAUNCH 0
#endif

extern "C" void kernel_launch(void* const* d_in, const int* in_sizes, int n_in,
                              void* d_out, int out_size, void* d_ws, size_t ws_size,
                              hipStream_t stream) {
  static int grid_blocks = 0;
  if (!grid_blocks) {
    if (n_in != 30 || out_size != T_ * D_ || ws_size < WS_END) { fprintf(stderr, "kernel_launch: unexpected shapes n_in=%d out=%d ws=%zu (need %zu)\n", n_in, out_size, ws_size, (size_t)WS_END); grid_blocks = -1; return; }
    int dev = 0, cus = 0, per_cu = 0;
    hipGetDevice(&dev);
    hipDeviceGetAttribute(&cus, hipDeviceAttributeMultiprocessorCount, dev);
    hipFuncSetAttribute((const void*)mega, hipFuncAttributeMaxDynamicSharedMemorySize, LDS_BYTES);
    hipOccupancyMaxActiveBlocksPerMultiprocessor(&per_cu, (const void*)mega, NTHR, LDS_BYTES);
    fprintf(stderr, "cus=%d per_cu=%d ws_size=%zu\n", cus, per_cu, ws_size);
    if (per_cu < 1) { fprintf(stderr, "kernel_launch: occupancy query says 0 blocks/CU\n"); grid_blocks = -1; return; }
    grid_blocks = cus;
  }
  if (grid_blocks < 0) return;
  hipMemsetAsync((char*)d_ws + OFF_CTL, 0, 4096, stream);
  Params p{};
  for (int i = 0; i < 30; ++i) p.in[i] = (const float*)d_in[i];
  p.out = (float*)d_out; p.ws = (unsigned char*)d_ws;
#if MULTI_LAUNCH
  for (int ph = 0; ph < 2 * N_PH_LAYER; ++ph) {
    p.ph_lo = ph; p.ph_hi = ph + 1;
    hipLaunchKernelGGL(mega, dim3(grid_blocks), dim3(NTHR), LDS_BYTES, stream, p);
  }
#else
  p.ph_lo = 0; p.ph_hi = 2 * N_PH_LAYER;
  void* args[] = {&p};
  hipError_t e = hipLaunchCooperativeKernel((void*)mega, dim3(grid_blocks), dim3(NTHR), args, LDS_BYTES, stream);
  if (e != hipSuccess) fprintf(stderr, "coop launch failed: %s\n", hipGetErrorString(e));
#endif
}
```
